# Optimizing an MI355X kernel written in HIP

```python
import jax, jax.numpy as jnp
from jax import lax
import numpy as np

D_MODEL = 1024
BATCH = 4
SEQ = 8192
DEPTH = 1

GRID_W = 64
CTX_LEN = 256
D_FF = 2816
MACARON_WEIGHT = 0.5
S5_WIDTH = 512
S5_GROUP = 16
S5_GROUPS = S5_WIDTH // S5_GROUP
S5_STATE = 64
GLA_HEADS = 4
GLA_DK = 64
GLA_DV = 128
GLA_KEY = GLA_HEADS * GLA_DK
GLA_VAL = GLA_HEADS * GLA_DV
GLA_GATE_RANK = 16
GLA_GATE_NORM = 16.0
GLA_CHUNK = 64
N_DIR = 2
N_BRANCH = 2
N_MOD = 9
RMS_EPS = 1e-6
D_IN = S5_WIDTH + 2 * GLA_KEY + 2 * GLA_VAL + N_DIR * GLA_GATE_RANK + N_BRANCH * D_MODEL

kernel_name = 'hybrid_s5_gla_macaron_dit_layer'

f32 = jnp.float32


def rms_norm(x, g):
    xf = x.astype(f32)
    y = xf * lax.rsqrt(jnp.mean(xf * xf, axis=-1, keepdims=True) + RMS_EPS)
    return (y * g.astype(f32)).astype(x.dtype)


def modulate(h, shift, scale):
    return h * (1 + scale) + shift


def swiglu(h, w_gate, w_up, w_down):
    return (jax.nn.silu(h @ w_gate) * (h @ w_up)) @ w_down


def ffn_sublayer(t, shift, scale, gate, norm_g, w_gate, w_up, w_down):
    h = modulate(rms_norm(t, norm_g), shift, scale)
    return t + gate * (MACARON_WEIGHT * swiglu(h, w_gate, w_up, w_down))


def to_col_major(t, rows):
    b, l, ch = t.shape
    return t.reshape(b, rows, GRID_W, ch).swapaxes(1, 2).reshape(b, l, ch)


def from_col_major(t, rows):
    b, l, ch = t.shape
    return t.reshape(b, GRID_W, rows, ch).swapaxes(1, 2).reshape(b, l, ch)


def _linear_recurrence(e1, e2):
    a1, b1 = e1
    a2, b2 = e2
    return a1 * a2, a2 * b1 + b2


def s5_scan(bu, lam_bar, h0):
    bu = bu.at[:, 0].add(lam_bar * h0)
    a = jnp.broadcast_to(lam_bar, bu.shape)
    _, h = lax.associative_scan(_linear_recurrence, (a, bu), axis=1)
    return h


def s5_discretise(lam_re, lam_im, log_dt, b_re, b_im):
    lam = lax.complex(jnp.minimum(lam_re.astype(f32), -1e-4), lam_im.astype(f32))
    dt = jnp.exp(log_dt.astype(f32))[:, None]
    lam_bar = jnp.exp(lam * dt)
    b = lax.complex(b_re.astype(f32), b_im.astype(f32))
    b_bar = ((lam_bar - 1.0) / lam)[..., None] * b
    return lam_bar, b_bar


def s5_branch(u_lat, u_ctx, lam_re, lam_im, log_dt, b_re, b_im, c_re, c_im, d_skip, glu_w, glu_b, need_ctx):
    def grouped(u):
        b, l, _ = u.shape
        return u.astype(f32).reshape(b, l, S5_GROUPS, S5_GROUP)

    def finish(y, u):
        b, l = u.shape[:2]
        y = y.reshape(b, l, S5_WIDTH) + d_skip.astype(f32) * u.astype(f32)
        y = jax.nn.gelu(y)
        y = y * jax.nn.sigmoid(y @ glu_w.astype(f32) + glu_b.astype(f32))
        return y.astype(u.dtype)

    bsz = u_lat.shape[0]
    ul, uc = grouped(u_lat), grouped(u_ctx)
    y_l = jnp.zeros(ul.shape, f32)
    y_c = jnp.zeros(uc.shape, f32)
    for d in range(N_DIR):
        lam_bar, b_bar = s5_discretise(lam_re[d], lam_im[d], log_dt[d], b_re[d], b_im[d])
        c_mat = lax.complex(c_re[d].astype(f32), c_im[d].astype(f32))
        bu_l = jnp.einsum('blgc,gpc->blgp', ul.astype(jnp.complex64), b_bar)
        bu_c = jnp.einsum('blgc,gpc->blgp', uc.astype(jnp.complex64), b_bar)
        if d == 1:
            bu_l, bu_c = jnp.flip(bu_l, 1), jnp.flip(bu_c, 1)
        h_c = s5_scan(bu_c, lam_bar, jnp.zeros((bsz, S5_GROUPS, S5_STATE), jnp.complex64))
        h_l = s5_scan(bu_l, lam_bar, h_c[:, -1])
        r_l = jnp.einsum('blgp,gcp->blgc', h_l, c_mat).real
        y_l = y_l + (jnp.flip(r_l, 1) if d == 1 else r_l)
        if need_ctx:
            r_c = jnp.einsum('blgp,gcp->blgc', h_c, c_mat).real
            y_c = y_c + (jnp.flip(r_c, 1) if d == 1 else r_c)
    return finish(y_l, u_lat), (finish(y_c, u_ctx) if need_ctx else None)


def gla_chunked(q, k, v, g, s0):
    bsz, nh, l, dk = q.shape
    dv = v.shape[-1]
    n = l // GLA_CHUNK
    q, k, g = [t.reshape(bsz, nh, n, GLA_CHUNK, dk) for t in (q, k, g)]
    v = v.reshape(bsz, nh, n, GLA_CHUNK, dv)
    gc = jnp.cumsum(g, axis=3)
    g_ref = gc[:, :, :, GLA_CHUNK // 2:GLA_CHUNK // 2 + 1]
    g_last = gc[:, :, :, -1:]
    scores = jnp.einsum('bhnid,bhnjd->bhnij', q * jnp.exp(gc - g_ref), k * jnp.exp(g_ref - gc))
    upto_i = jnp.tril(jnp.ones((GLA_CHUNK, GLA_CHUNK), dtype=bool))
    scores = jnp.where(upto_i, scores, 0.0)
    o_intra = jnp.einsum('bhnij,bhnje->bhnie', scores, v)
    kv = jnp.einsum('bhnjd,bhnje->bhnde', k * jnp.exp(g_last - gc), v)
    decay = jnp.exp(g_last[:, :, :, 0])

    def step(s, inp):
        dec, kv_n = inp
        return dec[..., None] * s + kv_n, s

    s_final, s_start = lax.scan(step, s0, (jnp.moveaxis(decay, 2, 0), jnp.moveaxis(kv, 2, 0)))
    s_start = jnp.moveaxis(s_start, 0, 2)
    o_inter = jnp.einsum('bhnid,bhnde->bhnie', q * jnp.exp(gc), s_start)
    return (o_intra + o_inter).reshape(bsz, nh, l, dv), s_final


def gla_branch(q_l, k_l, v_l, r_l, glr_l, q_c, k_c, v_c, r_c, glr_c, gate_up, gate_b, norm_g, need_ctx):
    def heads(t, dh):
        b, l, _ = t.shape
        return t.astype(f32).reshape(b, l, GLA_HEADS, dh).transpose(0, 2, 1, 3)

    def log_decay(glr, d):
        z = glr[..., d * GLA_GATE_RANK:(d + 1) * GLA_GATE_RANK] @ gate_up[d] + gate_b[d]
        return heads(jax.nn.log_sigmoid(z.astype(f32)) / GLA_GATE_NORM, GLA_DK)

    def readout(o, r):
        o = o.transpose(0, 2, 1, 3)
        o = o * lax.rsqrt(jnp.mean(o * o, axis=-1, keepdims=True) + RMS_EPS)
        o = o * norm_g.astype(f32).reshape(GLA_HEADS, GLA_DV)
        b, l = o.shape[:2]
        return (o.reshape(b, l, GLA_VAL) * jax.nn.silu(r.astype(f32))).astype(r.dtype)

    scale = GLA_DK ** -0.5
    lat = (heads(q_l, GLA_DK) * scale, heads(k_l, GLA_DK), heads(v_l, GLA_DV))
    cx = (heads(q_c, GLA_DK) * scale, heads(k_c, GLA_DK), heads(v_c, GLA_DV))
    bsz = q_l.shape[0]
    o_l = jnp.zeros(lat[2].shape, f32)
    o_c = jnp.zeros(cx[2].shape, f32)
    for d in range(N_DIR):
        seq_l = lat + (log_decay(glr_l, d),)
        seq_c = cx + (log_decay(glr_c, d),)
        if d == 1:
            seq_l = tuple(jnp.flip(t, 2) for t in seq_l)
            seq_c = tuple(jnp.flip(t, 2) for t in seq_c)
        oc_d, s_ctx = gla_chunked(*seq_c, jnp.zeros((bsz, GLA_HEADS, GLA_DK, GLA_DV), f32))
        ol_d, _ = gla_chunked(*seq_l, s_ctx)
        o_l = o_l + (jnp.flip(ol_d, 2) if d == 1 else ol_d)
        if need_ctx:
            o_c = o_c + (jnp.flip(oc_d, 2) if d == 1 else oc_d)
    return readout(o_l, r_l), (readout(o_c, r_c) if need_ctx else None)


def token_mixing(h_lat, h_ctx, w_in, s5_lambda_re, s5_lambda_im, s5_log_dt, s5_b_re, s5_b_im, s5_c_re, s5_c_im,
                 s5_d, s5_glu_w, s5_glu_b, s5_out, gla_gate_up, gla_gate_b, gla_norm, gla_out, w_o, rows, need_ctx):
    sizes = (S5_WIDTH, GLA_KEY, GLA_KEY, GLA_VAL, GLA_VAL, N_DIR * GLA_GATE_RANK, D_MODEL, D_MODEL)
    points = np.cumsum(sizes)[:-1].tolist()
    u_l, q_l, k_l, v_l, r_l, glr_l, ga_l, gb_l = jnp.split(h_lat @ w_in, points, axis=-1)
    u_c, q_c, k_c, v_c, r_c, glr_c, ga_c, gb_c = jnp.split(h_ctx @ w_in, points, axis=-1)
    ya_l, ya_c = s5_branch(u_l, u_c, s5_lambda_re, s5_lambda_im, s5_log_dt, s5_b_re, s5_b_im,
                           s5_c_re, s5_c_im, s5_d, s5_glu_w, s5_glu_b, need_ctx)
    q_l, k_l, v_l, r_l, glr_l = [to_col_major(t, rows) for t in (q_l, k_l, v_l, r_l, glr_l)]
    yb_l, yb_c = gla_branch(q_l, k_l, v_l, r_l, glr_l, q_c, k_c, v_c, r_c, glr_c,
                            gla_gate_up, gla_gate_b, gla_norm, need_ctx)
    yb_l = from_col_major(yb_l, rows)

    def merge(ya, yb, ga, gb):
        return (jax.nn.sigmoid(ga) * (ya @ s5_out) + jax.nn.sigmoid(gb) * (yb @ gla_out)) @ w_o

    y_ctx = merge(ya_c, yb_c, ga_c, gb_c) if need_ctx else None
    return merge(ya_l, yb_l, ga_l, gb_l), y_ctx


def setup_inputs(seed: int = 0) -> dict:
    key = jax.random.key(seed)
    ks = iter(jax.random.split(key, 40))

    def nrm(shape, scale):
        return jax.random.normal(next(ks), shape, f32) * scale

    L, D, F = DEPTH, D_MODEL, D_FF
    G, P, C = S5_GROUPS, S5_STATE, S5_GROUP
    lam_im = jnp.broadcast_to(jnp.pi * jnp.arange(P, dtype=f32), (L, N_DIR, G, P)) + nrm((L, N_DIR, G, P), 0.01)
    log_dt = jax.random.uniform(next(ks), (L, N_DIR, G), f32, float(np.log(1e-3)), float(np.log(1e-1)))
    return {
        'x': nrm((BATCH, SEQ, D), 1.0),
        'c': nrm((BATCH, D), 1.0),
        'ctx': nrm((BATCH, CTX_LEN, D), 1.0),
        'c_ctx': nrm((D,), 1.0),
        'ada_w': nrm((L, D, N_MOD * D), D ** -0.5),
        'ada_b': nrm((L, N_MOD * D), 0.02),
        'ffn1_norm': 1.0 + nrm((L, D), 0.02),
        'ffn1_w_gate': nrm((L, D, F), D ** -0.5),
        'ffn1_w_up': nrm((L, D, F), D ** -0.5),
        'ffn1_w_down': nrm((L, F, D), F ** -0.5),
        'mix_norm': 1.0 + nrm((L, D), 0.02),
        'w_in': nrm((L, D, D_IN), D ** -0.5),
        's5_lambda_re': -0.5 + nrm((L, N_DIR, G, P), 0.01),
        's5_lambda_im': lam_im,
        's5_log_dt': log_dt,
        's5_b_re': nrm((L, N_DIR, G, P, C), (2 * C) ** -0.5),
        's5_b_im': nrm((L, N_DIR, G, P, C), (2 * C) ** -0.5),
        's5_c_re': nrm((L, N_DIR, G, C, P), (2 * P) ** -0.5),
        's5_c_im': nrm((L, N_DIR, G, C, P), (2 * P) ** -0.5),
        's5_d': nrm((L, S5_WIDTH), 1.0),
        's5_glu_w': nrm((L, S5_WIDTH, S5_WIDTH), S5_WIDTH ** -0.5),
        's5_glu_b': nrm((L, S5_WIDTH), 0.02),
        's5_out': nrm((L, S5_WIDTH, D), S5_WIDTH ** -0.5),
        'gla_gate_up': nrm((L, N_DIR, GLA_GATE_RANK, GLA_KEY), GLA_GATE_RANK ** -0.5),
        'gla_gate_b': nrm((L, N_DIR, GLA_KEY), 0.1),
        'gla_norm': 1.0 + nrm((L, GLA_VAL), 0.02),
        'gla_out': nrm((L, GLA_VAL, D), GLA_VAL ** -0.5),
        'w_o': nrm((L, D, D), D ** -0.5),
        'ffn2_norm': 1.0 + nrm((L, D), 0.02),
        'ffn2_w_gate': nrm((L, D, F), D ** -0.5),
        'ffn2_w_up': nrm((L, D, F), D ** -0.5),
        'ffn2_w_down': nrm((L, F, D), F ** -0.5),
        'final_norm': 1.0 + nrm((D,), 0.02),
    }


def reference(x, c, ctx, c_ctx, ada_w, ada_b, ffn1_norm, ffn1_w_gate, ffn1_w_up, ffn1_w_down, mix_norm, w_in,
              s5_lambda_re, s5_lambda_im, s5_log_dt, s5_b_re, s5_b_im, s5_c_re, s5_c_im, s5_d, s5_glu_w, s5_glu_b,
              s5_out, gla_gate_up, gla_gate_b, gla_norm, gla_out, w_o, ffn2_norm, ffn2_w_gate, ffn2_w_up,
              ffn2_w_down, final_norm):
    rows = x.shape[1] // GRID_W
    for i in range(DEPTH):
        last = i == DEPTH - 1
        ml = jnp.split((jax.nn.silu(c) @ ada_w[i] + ada_b[i])[:, None, :], N_MOD, axis=-1)
        mc = jnp.split((jax.nn.silu(c_ctx) @ ada_w[i] + ada_b[i])[None, None, :], N_MOD, axis=-1)
        x = ffn_sublayer(x, ml[0], ml[1], ml[2], ffn1_norm[i], ffn1_w_gate[i], ffn1_w_up[i], ffn1_w_down[i])
        ctx = ffn_sublayer(ctx, mc[0], mc[1], mc[2], ffn1_norm[i], ffn1_w_gate[i], ffn1_w_up[i], ffn1_w_down[i])
        h_lat = modulate(rms_norm(x, mix_norm[i]), ml[3], ml[4])
        h_ctx = modulate(rms_norm(ctx, mix_norm[i]), mc[3], mc[4])
        y_lat, y_ctx = token_mixing(h_lat, h_ctx, w_in[i], s5_lambda_re[i], s5_lambda_im[i], s5_log_dt[i],
                                    s5_b_re[i], s5_b_im[i], s5_c_re[i], s5_c_im[i], s5_d[i], s5_glu_w[i],
                                    s5_glu_b[i], s5_out[i], gla_gate_up[i], gla_gate_b[i], gla_norm[i],
                                    gla_out[i], w_o[i], rows, not last)
        x = x + ml[5] * y_lat
        x = ffn_sublayer(x, ml[6], ml[7], ml[8], ffn2_norm[i], ffn2_w_gate[i], ffn2_w_up[i], ffn2_w_down[i])
        if not last:
            ctx = ctx + mc[5] * y_ctx
            ctx = ffn_sublayer(ctx, mc[6], mc[7], mc[8], ffn2_norm[i], ffn2_w_gate[i], ffn2_w_up[i], ffn2_w_down[i])
    return rms_norm(x, final_norm)
```

```cpp
#include <hip/hip_runtime.h>
#include <hip/hip_cooperative_groups.h>
#include <cstdio>
namespace cg = cooperative_groups;

#ifndef N_LAUNCH_PER_PHASE
#define N_LAUNCH_PER_PHASE 0
#endif

typedef unsigned short bf16_t;
typedef short bf16x8 __attribute__((ext_vector_type(8)));
typedef float f32x4 __attribute__((ext_vector_type(4)));

constexpr int NL = 32768, NC = 1024, NT = 33792, D = 1024, FF = 2816;
constexpr int NPHASE = 16;
constexpr int HALF_LDS = 79872;
constexpr int LDS_BYTES = 2 * HALF_LDS;
constexpr int NTHR = 512;
constexpr int UROWS = 1280;

constexpr size_t SZ_WGU = (size_t)5632 * 1024 * 2, SZ_WDN = (size_t)1024 * 2816 * 2;
constexpr size_t OFF_WGU1 = 0;
constexpr size_t OFF_WDN1 = OFF_WGU1 + SZ_WGU;
constexpr size_t OFF_WGU2 = OFF_WDN1 + SZ_WDN;
constexpr size_t OFF_WDN2 = OFF_WGU2 + SZ_WGU;
constexpr size_t OFF_WIN = OFF_WDN2 + SZ_WDN;
constexpr size_t OFF_WGLU = OFF_WIN + (size_t)4352 * 1024 * 2;
constexpr size_t OFF_WS5O = OFF_WGLU + (size_t)512 * 512 * 2;
constexpr size_t OFF_WGLO = OFF_WS5O + (size_t)1024 * 512 * 2;
constexpr size_t OFF_WWO = OFF_WGLO + (size_t)1024 * 512 * 2;
constexpr size_t OFF_WE = OFF_WWO + (size_t)1024 * 1024 * 2;
constexpr size_t OFF_WY = OFF_WE + (size_t)32 * 256 * 512 * 2;
constexpr size_t OFF_KD = OFF_WY + (size_t)32 * 512 * 768 * 2;
constexpr size_t OFF_LP = OFF_KD + (size_t)2 * 32 * 32 * 256 * 4;
constexpr size_t OFF_BB = OFF_LP + (size_t)2 * 32 * 33 * 64 * 8;
constexpr size_t OFF_MOD = OFF_BB + (size_t)2 * 32 * 64 * 16 * 8;
constexpr size_t OFF_DEC = OFF_MOD + (size_t)5 * 9216 * 4;
constexpr size_t OFF_H = OFF_DEC + (size_t)4224 * 64 * 4;
constexpr size_t OFF_HID = OFF_H + (size_t)NT * 1024 * 2;
constexpr size_t OFF_U = OFF_HID;
constexpr size_t OFF_Q = OFF_U + (size_t)32 * UROWS * 768 * 2;
constexpr size_t OFF_K = OFF_Q + (size_t)NT * 256 * 2;
constexpr size_t OFF_V = OFF_K + (size_t)NT * 256 * 2;
constexpr size_t OFF_R = OFF_V + (size_t)NT * 512 * 2;
constexpr size_t OFF_GLR = OFF_R + (size_t)NT * 512 * 2;
constexpr size_t OFF_XR = OFF_HID + (size_t)NT * 2816 * 2;
constexpr size_t OFF_YB = OFF_XR + (size_t)NT * 1024 * 2;
constexpr size_t OFF_E = OFF_XR + (size_t)NT * 1024 * 4;
constexpr size_t OFF_BAR = OFF_E + (size_t)32 * 1056 * 256 * 4;
constexpr size_t OFF_SS = OFF_BAR + 16384;
constexpr size_t OFF_BW = OFF_SS + 401408;
constexpr size_t WS_END = OFF_BW + 204800;
static_assert(WS_END <= (size_t)536870912, "workspace");
static_assert(OFF_GLR + (size_t)NT * 32 * 2 <= OFF_XR, "alias overflow");

struct Params { const float* in[33]; float* out; unsigned char* ws; int ph_lo, ph_hi; };

typedef float f32x2_t __attribute__((ext_vector_type(2)));
typedef __bf16 bf16x2_t __attribute__((ext_vector_type(2)));
__device__ __forceinline__ unsigned pk2(float a, float b) { const f32x2_t v = {a, b}; const bf16x2_t r = __builtin_convertvector(v, bf16x2_t); return __builtin_bit_cast(unsigned, r); }
__device__ __forceinline__ bf16_t f2bf(float f) { return (bf16_t)(pk2(f, f) & 0xffffu); }
__device__ __forceinline__ float bf2f(bf16_t h) { return __uint_as_float(((unsigned)h) << 16); }
__device__ __forceinline__ float bflo(unsigned u) { return __uint_as_float(u << 16); }
__device__ __forceinline__ float bfhi(unsigned u) { return __uint_as_float(u & 0xffff0000u); }
__device__ __forceinline__ float rcpf_(float x) { return __builtin_amdgcn_rcpf(x); }
__device__ __forceinline__ float sigm(float x) { return rcpf_(1.f + __expf(-x)); }
__device__ __forceinline__ float siluf_(float x) { return x * sigm(x); }
__device__ __forceinline__ float gelu_tanh(float x) { float y = 0.7978845608028654f * (x + 0.044715f * x * x * x); float t = 1.f - 2.f * rcpf_(1.f + __expf(2.f * y)); return 0.5f * x * (1.f + t); }
__device__ __forceinline__ float wave_sum(float v) {
#pragma unroll
    for (int o = 1; o < 64; o <<= 1) v += __shfl_xor(v, o);
    return v;
}
__device__ __forceinline__ void store_bf4(bf16_t* p, f32x4 v) { uint2 o; o.x = pk2(v[0], v[1]); o.y = pk2(v[2], v[3]); *(uint2*)p = o; }
__device__ __forceinline__ f32x4 load_bf4(const bf16_t* p) { uint2 u = *(const uint2*)p; f32x4 v; v[0] = bflo(u.x); v[1] = bfhi(u.x); v[2] = bflo(u.y); v[3] = bfhi(u.y); return v; }

constexpr int LROW = 72;
namespace pg8 {
#define PG8_LAS __attribute__((address_space(3)))
constexpr int BM = 256, BK = 64, HALF = 128, HTB = HALF * BK * 2, STAGE_BYTES = 8 * HTB;
__device__ __forceinline__ int lds_byte(int r, int c) { const int st = (r >> 4) * 2 + (c >> 5), rr = r & 15, cc = c & 31, ob = rr * 64 + cc * 2; return st * 1024 + (ob ^ (((ob >> 9) & 1) << 5)); }
__device__ __forceinline__ void stage_rc(int b, int& R, int& C) { const int st = b / 1024, sb = b % 1024, swz = sb ^ (((sb >> 9) & 1) << 5); R = (st >> 1) * 16 + swz / 64; C = (st & 1) * 32 + (swz % 64) / 2; }
struct Unit { int pm, pn, g, part; };
struct GemmD { const bf16_t* A; const bf16_t* Bt; int lda, ldb, K, nM, nN, nG; size_t gsA, gsB; int permA; const bf16_t* A2; const bf16_t* Bt2; int dual; };
__device__ __forceinline__ int perm32(int rho) { const int n = rho >> 4, i = rho & 15; return 8 * (i >> 2) + 4 * n + (i & 3); }
struct EpiNoMid { static constexpr bool PERM = false; __device__ __forceinline__ void mid(f32x4 (&)[2][2][4][2], const Unit&, int, int, int, int) const {} };
__device__ __forceinline__ bool unit_at(const GemmD& d, int i, Unit& u) {
    const long L = (long)(d.dual ? (i >> 1) : i) * gridDim.x + blockIdx.x; const int per = d.nM * d.nN;
    u.part = d.dual ? (i & 1) : 0;
    if (L >= (long)per * d.nG) return false;
    if (d.nG == 1) {
        int wgid = (int)L; const int nwg = per;
        { const int q = nwg / 8, r = nwg % 8, xcd = wgid % 8, off = wgid / 8; wgid = (xcd < r ? xcd * (q + 1) : r * (q + 1) + (xcd - r) * q) + off; }
        const int nig = 4 * d.nN, gid = wgid / nig, fm = gid * 4, gsz = (d.nM - fm) < 4 ? (d.nM - fm) : 4;
        u.pm = fm + ((wgid % nig) % gsz); u.pn = (wgid % nig) / gsz; u.g = 0;
    } else if ((d.nG & 7) == 0) {
        const int x = (int)(L & 7), j = (int)(L >> 3), gpx = d.nG >> 3;
        u.g = x * gpx + j / per; const int w = j % per; u.pm = w / d.nN; u.pn = w % d.nN;
    } else { u.g = (int)(L / per); const int w = (int)(L % per); u.pm = w / d.nN; u.pn = w % d.nN; }
    return true;
}
__device__ __forceinline__ const char* a_base(const GemmD& d, const Unit& u) {
    const size_t row0 = d.permA ? (size_t)(((u.pm >> 5) << 13) + 4 * (u.pm & 31)) : (size_t)u.pm * 256;
    return (const char*)(((d.dual && u.part) ? d.A2 : d.A) + (size_t)u.g * d.gsA + row0 * d.lda);
}
__device__ __forceinline__ const char* b_base(const GemmD& d, const Unit& u) { return (const char*)(((d.dual && u.part) ? d.Bt2 : d.Bt) + (size_t)u.g * d.gsB + (size_t)u.pn * 256 * d.ldb); }

template <class Epi>
__device__ __forceinline__ void gemm_phase(PG8_LAS unsigned char* lds, const GemmD g, const Epi& E) {
    const int tid = threadIdx.x, wid = __builtin_amdgcn_readfirstlane(tid >> 6), lane = tid & 63, wr = wid >> 2, wc = wid & 3, fr = lane & 15, fq = lane >> 4;
    const int K = g.K, nt = K / BK;
    unsigned voffA[2], voffB[2];
#pragma unroll
    for (int i = 0; i < 2; ++i) { int R, C; stage_rc(tid * 16 + i * 8192, R, C);
        const int Ra = g.permA ? (((R & 63) << 7) + (R >> 6)) : R;
        const int Rb = Epi::PERM ? ((R & ~31) + perm32(R & 31)) : R;
        voffA[i] = (unsigned)(Ra * g.lda + C) * 2u; voffB[i] = (unsigned)(Rb * g.ldb + C) * 2u; }
    const size_t kstep = (size_t)(BK * 2);
    const size_t hstepA = g.permA ? (size_t)2 * g.lda * 2 : (size_t)HALF * g.lda * 2;
    const size_t hstepB = (size_t)HALF * g.ldb * 2;
    const unsigned ldsw = (unsigned)wid * 1024u;
    const int aoff = lds_byte(wr * 64 + fr, fq * 8), boff = lds_byte(wc * 32 + fr, fq * 8);
#define PG8_SA(b, h) (((b) * 2 + (h)) * HTB)
#define PG8_SB(b, h) ((4 + (b) * 2 + (h)) * HTB)
#define PG8_STAGE(bufoff, gbase, voff) do { _Pragma("unroll") for (int _i = 0; _i < 2; ++_i) \
        __builtin_amdgcn_global_load_lds((const unsigned*)((const char*)(gbase) + (voff)[_i]), (PG8_LAS unsigned*)(lds + (bufoff) + ldsw + _i * 8192), 16, 0, 0); } while (0)
#define PG8_LDA(dst, b, h) do { _Pragma("unroll") for (int m = 0; m < 4; ++m) _Pragma("unroll") for (int k = 0; k < 2; ++k) dst[m][k] = *(const PG8_LAS bf16x8*)(lds + PG8_SA(b, h) + aoff + m * 2048 + k * 1024); } while (0)
#define PG8_LDB(dst, b, h) do { _Pragma("unroll") for (int n = 0; n < 2; ++n) _Pragma("unroll") for (int k = 0; k < 2; ++k) dst[n][k] = *(const PG8_LAS bf16x8*)(lds + PG8_SB(b, h) + boff + n * 2048 + k * 1024); } while (0)
#define PG8_MMA(ai, bj, At, Bt) do { __builtin_amdgcn_s_setprio(1); _Pragma("unroll") for (int m = 0; m < 4; ++m) _Pragma("unroll") for (int n = 0; n < 2; ++n) _Pragma("unroll") for (int k = 0; k < 2; ++k) \
        acc[ai][bj][m][n] = __builtin_amdgcn_mfma_f32_16x16x32_bf16(Bt[n][k], At[m][k], acc[ai][bj][m][n], 0, 0, 0); __builtin_amdgcn_s_setprio(0); } while (0)
#define PG8_WAIT_V(n) asm volatile("s_waitcnt vmcnt(" #n ")" ::: "memory")
#define PG8_WAIT_L(n) asm volatile("s_waitcnt lgkmcnt(" #n ")" ::: "memory")
#define PG8_BAR __builtin_amdgcn_s_barrier()
#define PG8_SCHED __builtin_amdgcn_sched_barrier(0)
    Unit cur, nxt; int ui = 0;
    if (!unit_at(g, 0, cur)) return;
    f32x4 acc[2][2][4][2];
#pragma unroll
    for (int a = 0; a < 2; ++a)
#pragma unroll
        for (int b = 0; b < 2; ++b)
#pragma unroll
            for (int m = 0; m < 4; ++m)
#pragma unroll
                for (int n = 0; n < 2; ++n) acc[a][b][m][n] = (f32x4){0.f, 0.f, 0.f, 0.f};
    bf16x8 At[4][2], B0[2][2], B1[2][2];
    const char* cA = a_base(g, cur); const char* cB = b_base(g, cur);
    PG8_STAGE(PG8_SB(0, 0), cB, voffB); PG8_STAGE(PG8_SA(0, 0), cA, voffA); PG8_STAGE(PG8_SB(0, 1), cB + hstepB, voffB); PG8_STAGE(PG8_SA(0, 1), cA + hstepA, voffA);
    if (wr == 1) PG8_BAR;
    PG8_WAIT_V(4); PG8_BAR;
    PG8_STAGE(PG8_SB(1, 0), cB + kstep, voffB); PG8_STAGE(PG8_SA(1, 0), cA + kstep, voffA); PG8_STAGE(PG8_SB(1, 1), cB + hstepB + kstep, voffB);
    PG8_WAIT_V(6); PG8_BAR;
    for (;;) {
        const bool has_next = unit_at(g, ui + 1, nxt);
        const char* nA = has_next ? a_base(g, nxt) : cA; const char* nB = has_next ? b_base(g, nxt) : cB;
        for (int t = 0; t < nt; t += 2) {
            const bool last = (t == nt - 2);
            const char* a1 = cA + (size_t)(t + 1) * kstep;
            const char* a2 = last ? nA : cA + (size_t)(t + 2) * kstep; const char* b2 = last ? nB : cB + (size_t)(t + 2) * kstep;
            const char* a3 = a2 + kstep; const char* b3 = b2 + kstep;
            PG8_LDB(B0, 0, 0); PG8_SCHED; PG8_LDA(At, 0, 0); PG8_STAGE(PG8_SA(1, 1), a1 + hstepA, voffA);
            PG8_WAIT_L(8); PG8_BAR; PG8_WAIT_L(0); PG8_MMA(0, 0, At, B0); PG8_BAR; PG8_SCHED;
            PG8_LDB(B1, 0, 1); PG8_STAGE(PG8_SB(0, 0), b2, voffB);
            PG8_BAR; PG8_WAIT_L(0); PG8_MMA(0, 1, At, B1); PG8_BAR;
            PG8_LDA(At, 0, 1); PG8_STAGE(PG8_SA(0, 0), a2, voffA);
            PG8_BAR; PG8_WAIT_L(0); PG8_MMA(1, 0, At, B0); PG8_BAR; PG8_SCHED;
            PG8_STAGE(PG8_SB(0, 1), b2 + hstepB, voffB);
            PG8_WAIT_V(6); PG8_BAR; PG8_MMA(1, 1, At, B1); PG8_BAR;
            PG8_LDB(B0, 1, 0); PG8_SCHED; PG8_LDA(At, 1, 0); PG8_STAGE(PG8_SA(0, 1), a2 + hstepA, voffA);
            PG8_WAIT_L(8); PG8_BAR; PG8_WAIT_L(0); PG8_MMA(0, 0, At, B0); PG8_BAR; PG8_SCHED;
            PG8_LDB(B1, 1, 1); PG8_STAGE(PG8_SB(1, 0), b3, voffB);
            PG8_BAR; PG8_WAIT_L(0); PG8_MMA(0, 1, At, B1); PG8_BAR;
            PG8_LDA(At, 1, 1); PG8_STAGE(PG8_SA(1, 0), a3, voffA);
            PG8_BAR; PG8_WAIT_L(0); PG8_MMA(1, 0, At, B0); PG8_BAR; PG8_SCHED;
            PG8_STAGE(PG8_SB(1, 1), b3 + hstepB, voffB);
            PG8_WAIT_V(6); PG8_BAR; PG8_MMA(1, 1, At, B1); PG8_BAR;
        }
        const bool midp = g.dual && cur.part == 0;
        if (midp) E.mid(acc, cur, wr, wc, fr, fq); else E(acc, cur, wr, wc, fr, fq);
        if (!has_next) break;
        if (!midp)
#pragma unroll
        for (int a = 0; a < 2; ++a)
#pragma unroll
            for (int b = 0; b < 2; ++b)
#pragma unroll
                for (int m = 0; m < 4; ++m)
#pragma unroll
                    for (int n = 0; n < 2; ++n) acc[a][b][m][n] = (f32x4){0.f, 0.f, 0.f, 0.f};
        cur = nxt; cA = nA; cB = nB; ++ui;
    }
    PG8_WAIT_V(0);
    if (wr == 0) PG8_BAR;
    PG8_BAR;
#undef PG8_SA
#undef PG8_SB
#undef PG8_STAGE
#undef PG8_LDA
#undef PG8_LDB
#undef PG8_MMA
#undef PG8_WAIT_V
#undef PG8_WAIT_L
#undef PG8_BAR
#undef PG8_SCHED
}
}
using pg8::Unit; using pg8::GemmD;
typedef f32x4 AccT[2][2][4][2];
#define EPI_LOOP _Pragma("unroll") for (int ai = 0; ai < 2; ++ai) _Pragma("unroll") for (int bj = 0; bj < 2; ++bj) _Pragma("unroll") for (int mm = 0; mm < 4; ++mm) _Pragma("unroll") for (int nn = 0; nn < 2; ++nn) { \
    const int m = 256 * u.pm + 128 * ai + 64 * wr + 16 * mm + fr; const int n = 256 * u.pn + 128 * bj + 32 * wc + 16 * nn + 4 * fq; const f32x4 v = acc[ai][bj][mm][nn];
#define EPI_LOOP_END }
#define EPI_LOOP_NV _Pragma("unroll") for (int ai = 0; ai < 2; ++ai) _Pragma("unroll") for (int bj = 0; bj < 2; ++bj) _Pragma("unroll") for (int mm = 0; mm < 4; ++mm) _Pragma("unroll") for (int nn = 0; nn < 2; ++nn) { \
    const int m = 256 * u.pm + 128 * ai + 64 * wr + 16 * mm + fr; const int n = 256 * u.pn + 128 * bj + 32 * wc + 16 * nn + 4 * fq;

__device__ __forceinline__ int map_row(int mode, int n) {
    if (mode == 1) return ((n >> 7) << 8) + (n & 127);
    if (mode == 2) return ((n >> 7) << 8) + 128 + (n & 127);
    if (mode == 3) {
        if (n < 2048) return n;
        if (n < 2080) return 4096 + (n - 2048);
        if (n < 3104) { const int j = n - 2080; return 2048 + ((j >> 4) << 5) + (((j >> 2) & 3) << 3) + (j & 3); }
        { const int j = n - 3104; return 2048 + ((j >> 4) << 5) + (((j >> 2) & 3) << 3) + 4 + (j & 3); }
    }
    return n;
}
struct TItem { const float* src; bf16_t* dst; int K, mode, n0; };
__device__ __forceinline__ void transpose_load(const TItem& t, int N, float (&v)[8]) {
#pragma unroll
    for (int i = 0; i < 8; ++i) v[i] = t.src[(size_t)(8 * i) * N];
}
__device__ __forceinline__ void transpose_store(const TItem& t, const float (&v)[8], float* scr) {
    const int tid = threadIdx.x & 255;
#pragma unroll
    for (int i = 0; i < 8; ++i) scr[((tid >> 5) + 8 * i) * 33 + (tid & 31)] = v[i];
    __syncthreads();
    const int n = tid >> 3, kc = (tid & 7) * 8;
    const float* s = scr + kc * 33 + n;
    uint4 o; o.x = pk2(s[0], s[33]); o.y = pk2(s[66], s[99]); o.z = pk2(s[132], s[165]); o.w = pk2(s[198], s[231]);
    const int nd = map_row(t.mode, t.n0 + n);
    *(uint4*)(t.dst + (size_t)nd * t.K) = o;
    __syncthreads();
}
__device__ __forceinline__ void ada_item(const Params& P, int item, float* sm) {
    float* sv = sm; float* red = sm + 5 * 1024;
    const int tid = threadIdx.x & 255;
    for (int e = tid; e < 5 * 1024; e += 256) { const int r = e >> 10, k = e & 1023; const float c = r < 4 ? P.in[1][r * 1024 + k] : P.in[3][k]; sv[e] = siluf_(c); }
    __syncthreads();
    const int cgp = tid & 15, kg = tid >> 4, n0 = item * 64;
    f32x4 a[5];
#pragma unroll
    for (int r = 0; r < 5; ++r) a[r] = (f32x4){0.f, 0.f, 0.f, 0.f};
    const float* wp = P.in[4] + (size_t)(kg * 64) * 9216 + n0 + cgp * 4;
#pragma unroll 16
    for (int kk = 0; kk < 64; ++kk) {
        const f32x4 w4 = *(const f32x4*)(wp + (size_t)kk * 9216);
#pragma unroll
        for (int r = 0; r < 5; ++r) { const float s = sv[r * 1024 + kg * 64 + kk]; a[r] += w4 * s; }
    }
#pragma unroll
    for (int r = 0; r < 5; ++r) *(f32x4*)(red + (kg * 5 + r) * 64 + cgp * 4) = a[r];
    __syncthreads();
    for (int e = tid; e < 320; e += 256) {
        const int r = e >> 6, col = e & 63; float s = P.in[5][n0 + col];
#pragma unroll
        for (int g = 0; g < 16; ++g) s += red[(g * 5 + r) * 64 + col];
        ((float*)(P.ws + OFF_MOD))[r * 9216 + n0 + col] = s;
    }
    __syncthreads();
}

__device__ __forceinline__ float2 cmul(float2 a, float2 b) { return make_float2(a.x * b.x - a.y * b.y, a.x * b.y + a.y * b.x); }

__device__ __forceinline__ void phase0(const Params& P, unsigned char* smem) {
    const int hb = threadIdx.x >> 8;
    float* scr = (float*)(smem + hb * HALF_LDS);
    struct TW { int in; int K, N; size_t off; int mode; };
    const TW tw[13] = {
        {7, 1024, 2816, OFF_WGU1, 1}, {8, 1024, 2816, OFF_WGU1, 2}, {9, 2816, 1024, OFF_WDN1, 0},
        {29, 1024, 2816, OFF_WGU2, 1}, {30, 1024, 2816, OFF_WGU2, 2}, {31, 2816, 1024, OFF_WDN2, 0},
        {11, 1024, 4128, OFF_WIN, 3}, {20, 512, 512, OFF_WGLU, 0}, {22, 512, 1024, OFF_WS5O, 0}, {26, 512, 1024, OFF_WGLO, 0}, {27, 1024, 1024, OFF_WWO, 0},
        {0, 0, 0, 0, 0}, {0, 0, 0, 0, 0}};
    int total = 0;
#pragma unroll
    for (int i = 0; i < 11; ++i) total += (tw[i].K >> 6) * (tw[i].N >> 5);
    const int n_ada = 144;
    for (int base = blockIdx.x * 2; base < n_ada; base += gridDim.x * 2) ada_item(P, base + hb, scr);
    auto lookup = [&](int it, TItem& t, int& N) {
        int r = it < total ? it : total - 1;
        t.src = nullptr; t.dst = nullptr; t.K = 0; t.mode = 0; t.n0 = 0; N = 0;
#pragma unroll
        for (int i = 0; i < 11; ++i) {
            const int cnt = (tw[i].K >> 6) * (tw[i].N >> 5);
            if (r >= 0 && r < cnt) {
                const int nblk = tw[i].N >> 5, kb = r / nblk, nb = r - kb * nblk, k0 = kb * 64, n0 = nb * 32, tid = threadIdx.x & 255;
                N = tw[i].N; t.K = tw[i].K; t.mode = tw[i].mode; t.n0 = n0;
                t.src = P.in[tw[i].in] + (size_t)(k0 + (tid >> 5)) * tw[i].N + n0 + (tid & 31);
                t.dst = (bf16_t*)(P.ws + tw[i].off) + k0 + (tid & 7) * 8;
            }
            r -= cnt;
        }
    };
    {
        const int stride = gridDim.x * 2;
        int it = blockIdx.x * 2 + hb;
        TItem cur, nxt; int Nc = 0, Nn = 0; float vn[8];
        if (blockIdx.x * 2 < total) { lookup(it, nxt, Nn); transpose_load(nxt, Nn, vn); }
        for (int base = blockIdx.x * 2; base < total; base += stride) {
            float v[8];
#pragma unroll
            for (int i = 0; i < 8; ++i) v[i] = vn[i];
            cur = nxt; Nc = Nn;
            if (base + stride < total) { lookup(it + stride, nxt, Nn); transpose_load(nxt, Nn, vn); }
            transpose_store(cur, v, scr);
            it += stride;
        }
    }
    const int gtid = blockIdx.x * NTHR + threadIdx.x, gsz = gridDim.x * NTHR;
    for (int e = gtid; e < NT + 2 * NL; e += gsz) ((float*)(P.ws + OFF_SS))[e] = 0.f;
    float2* LP = (float2*)(P.ws + OFF_LP); float2* BB = (float2*)(P.ws + OFF_BB);
    for (int e = gtid; e < 2 * 32 * 33 * 64; e += gsz) {
        const int p = e & 63, tau = (e >> 6) % 33, dg = e / (33 * 64);
        const float lre = fminf(P.in[12][dg * 64 + p], -1e-4f), lim = P.in[13][dg * 64 + p], dt = expf(P.in[14][dg]);
        const float mag = expf(lre * dt * (float)tau), ang = (lim * dt) * (float)tau;
        float sn, cs; sincosf(ang, &sn, &cs);
        LP[e] = make_float2(mag * cs, mag * sn);
    }
    for (int e = gtid; e < 2 * 32 * 64 * 16; e += gsz) {
        const int dgp = e >> 4;
        const int dg = dgp >> 6;
        const float lre = fminf(P.in[12][dgp], -1e-4f), lim = P.in[13][dgp], dt = expf(P.in[14][dg]);
        const float mag = expf(lre * dt), ang = lim * dt;
        float sn, cs; sincosf(ang, &sn, &cs);
        const float ar = mag * cs - 1.f, ai = mag * sn;
        const float den = lre * lre + lim * lim;
        const float qr = (ar * lre + ai * lim) / den, qi = (ai * lre - ar * lim) / den;
        BB[e] = cmul(make_float2(qr, qi), make_float2(P.in[15][e], P.in[16][e]));
    }
}

__device__ __forceinline__ void norm_row_pre(const f32x4 (&v)[4], const float* __restrict__ g, const float* __restrict__ shift, const float* __restrict__ scale, bf16_t* __restrict__ dst, int lane) {
    float ss = 0.f;
#pragma unroll
    for (int j = 0; j < 4; ++j) ss += v[j][0] * v[j][0] + v[j][1] * v[j][1] + v[j][2] * v[j][2] + v[j][3] * v[j][3];
    ss = wave_sum(ss);
    const float rstd = rsqrtf(ss * (1.f / 1024.f) + 1e-6f);
#pragma unroll
    for (int j = 0; j < 4; ++j) {
        const int c4 = lane + 64 * j;
        const f32x4 g4 = ((const f32x4*)g)[c4], sh = ((const f32x4*)shift)[c4], sc = ((const f32x4*)scale)[c4];
        f32x4 h = (v[j] * rstd) * g4; h = h * (sc + 1.f) + sh;
        store_bf4(dst + c4 * 4, h);
    }
}
__device__ __forceinline__ void norm_row(const float* __restrict__ src, const float* __restrict__ g, const float* __restrict__ shift, const float* __restrict__ scale, bf16_t* __restrict__ dst, int lane) {
    f32x4 v[4]; float ss = 0.f;
#pragma unroll
    for (int j = 0; j < 4; ++j) { v[j] = ((const f32x4*)src)[lane + 64 * j]; ss += v[j][0] * v[j][0] + v[j][1] * v[j][1] + v[j][2] * v[j][2] + v[j][3] * v[j][3]; }
    ss = wave_sum(ss);
    const float rstd = rsqrtf(ss * (1.f / 1024.f) + 1e-6f);
#pragma unroll
    for (int j = 0; j < 4; ++j) {
        const int c4 = lane + 64 * j;
        const f32x4 g4 = ((const f32x4*)g)[c4], sh = ((const f32x4*)shift)[c4], sc = ((const f32x4*)scale)[c4];
        f32x4 h = (v[j] * rstd) * g4; h = h * (sc + 1.f) + sh;
        store_bf4(dst + c4 * 4, h);
    }
}

__device__ __forceinline__ void phase1(const Params& P) {
    const int lane = threadIdx.x & 63, w = threadIdx.x >> 6;
    const float* mod = (const float*)(P.ws + OFF_MOD);
    bf16_t* H = (bf16_t*)(P.ws + OFF_H);
    {
        const int stride = gridDim.x * 8;
        int row = blockIdx.x * 8 + w;
        f32x4 vn[4];
        if (row < NT) { const float* src = row < NL ? P.in[0] + (size_t)row * 1024 : P.in[2] + (size_t)(row - NL) * 1024;
#pragma unroll
            for (int j = 0; j < 4; ++j) vn[j] = ((const f32x4*)src)[lane + 64 * j]; }
        while (row < NT) {
            f32x4 v[4];
#pragma unroll
            for (int j = 0; j < 4; ++j) v[j] = vn[j];
            const int nrow = row + stride;
            if (nrow < NT) { const float* src = nrow < NL ? P.in[0] + (size_t)nrow * 1024 : P.in[2] + (size_t)(nrow - NL) * 1024;
#pragma unroll
                for (int j = 0; j < 4; ++j) vn[j] = ((const f32x4*)src)[lane + 64 * j]; }
            const int mr = row < NL ? (row >> 13) : 4;
            norm_row_pre(v, P.in[6], mod + mr * 9216 + 0, mod + mr * 9216 + 1024, H + (size_t)row * 1024, lane);
            if (row >= NL) {
#pragma unroll
                for (int j = 0; j < 4; ++j) ((f32x4*)((float*)(P.ws + OFF_E) + (size_t)(row - NL) * 1024))[lane + 64 * j] = v[j];
            }
            row = nrow;
        }
    }
    for (int r0 = blockIdx.x * 32 + w * 4; r0 < 4352 + 5632; r0 += gridDim.x * 32)
    for (int r = r0; r < r0 + 4; ++r) {
        const bool first = r < 4352;
        const bf16_t* wt = first ? (const bf16_t*)(P.ws + OFF_WIN) + (size_t)r * 1024 : (const bf16_t*)(P.ws + OFF_WGU2) + (size_t)(r - 4352) * 1024;
        const float* sh = mod + (first ? 3 : 6) * 1024 + lane * 16;
        const uint4 w0 = *(const uint4*)(wt + lane * 16), w1 = *(const uint4*)(wt + lane * 16 + 8);
        const float wv[16] = {bflo(w0.x), bfhi(w0.x), bflo(w0.y), bfhi(w0.y), bflo(w0.z), bfhi(w0.z), bflo(w0.w), bfhi(w0.w),
                              bflo(w1.x), bfhi(w1.x), bflo(w1.y), bfhi(w1.y), bflo(w1.z), bfhi(w1.z), bflo(w1.w), bfhi(w1.w)};
        float* BW = (float*)(P.ws + OFF_BW);
#pragma unroll
        for (int mr = 0; mr < 5; ++mr) {
            float a = 0.f;
#pragma unroll
            for (int q = 0; q < 4; ++q) { const f32x4 s4 = *(const f32x4*)(sh + mr * 9216 + q * 4); a += s4[0] * wv[q * 4] + s4[1] * wv[q * 4 + 1] + s4[2] * wv[q * 4 + 2] + s4[3] * wv[q * 4 + 3]; }
            a = wave_sum(a);
            if (lane == 0) { if (first) BW[mr * 4352 + r] = a; else BW[5 * 4352 + mr * 5632 + (r - 4352)] = a; }
        }
    }
    const int gtid = blockIdx.x * NTHR + threadIdx.x, gsz = gridDim.x * NTHR;
    const float2* LP = (const float2*)(P.ws + OFF_LP); const float2* BB = (const float2*)(P.ws + OFF_BB);
    float* KD = (float*)(P.ws + OFF_KD);
    for (int e = gtid; e < 2 * 32 * 32 * 256; e += gsz) {
        const int cp = e & 15, c = (e >> 4) & 15, tau = (e >> 8) & 31, dg = e >> 13;
        float s = 0.f;
        for (int p = 0; p < 64; ++p) {
            const float2 C = make_float2(P.in[17][(dg * 16 + c) * 64 + p], P.in[18][(dg * 16 + c) * 64 + p]);
            const float2 z = cmul(LP[(dg * 33 + tau) * 64 + p], BB[(dg * 64 + p) * 16 + cp]);
            s += C.x * z.x - C.y * z.y;
        }
        KD[e] = s;
    }
    bf16_t* WE = (bf16_t*)(P.ws + OFF_WE);
    for (int e = gtid; e < 32 * 256 * 512; e += gsz) {
        const int k = e & 511, n = (e >> 9) & 255, g = e >> 17;
        const int s = k >> 4, cp = k & 15, d = n >> 7, ri = (n >> 6) & 1, p = n & 63, dg = d * 32 + g;
        const int tau = d == 0 ? 31 - s : s;
        const float2 z = cmul(LP[(dg * 33 + tau) * 64 + p], BB[(dg * 64 + p) * 16 + cp]);
        WE[e] = f2bf(ri ? z.y : z.x);
    }
    bf16_t* WY = (bf16_t*)(P.ws + OFF_WY);
    for (int e = gtid; e < 32 * 512 * 256; e += gsz) {
        const int kk = e & 255, n = (e >> 8) & 511, g = e >> 17;
        const int t = n >> 4, c = n & 15, d = kk >> 7, ri = (kk >> 6) & 1, p = kk & 63, dg = d * 32 + g;
        const int tau = d == 0 ? t + 1 : 32 - t;
        const float2 C = make_float2(P.in[17][(dg * 16 + c) * 64 + p], P.in[18][(dg * 16 + c) * 64 + p]);
        const float2 z = cmul(C, LP[(dg * 33 + tau) * 64 + p]);
        WY[((size_t)g * 512 + n) * 768 + 512 + kk] = f2bf(ri ? -z.y : z.x);
    }
}

__device__ __forceinline__ void phase4(const Params& P) {
    const int lane = threadIdx.x & 63, w = threadIdx.x >> 6;
    const float* mod = (const float*)(P.ws + OFF_MOD);
    bf16_t* H = (bf16_t*)(P.ws + OFF_H);
    const float* XRC = (const float*)(P.ws + OFF_E);
    float* ss2 = (float*)(P.ws + OFF_SS);
    for (int r0 = blockIdx.x * 32 + w * 4; r0 < NC; r0 += gridDim.x * 32)
    for (int r = r0; r < r0 + 4; ++r) {
        const float* src = XRC + (size_t)r * 1024;
        float ss = 0.f;
#pragma unroll
        for (int j = 0; j < 4; ++j) {
            const int c4 = lane + 64 * j;
            const f32x4 v = ((const f32x4*)src)[c4];
            ss += v[0] * v[0] + v[1] * v[1] + v[2] * v[2] + v[3] * v[3];
            const f32x4 g4 = ((const f32x4*)P.in[10])[c4], sc = ((const f32x4*)(mod + 4 * 9216 + 4 * 1024))[c4];
            store_bf4(H + (size_t)(NL + r) * 1024 + c4 * 4, v * (g4 * (sc + 1.f)));
        }
        ss = wave_sum(ss);
        if (lane == 0) ss2[NL + r] = ss;
    }
    const int gtid = blockIdx.x * NTHR + threadIdx.x, gsz = gridDim.x * NTHR;
    const float* KD = (const float*)(P.ws + OFF_KD);
    bf16_t* WY = (bf16_t*)(P.ws + OFF_WY);
    for (int e = gtid; e < 32 * 512 * 512; e += gsz) {
        const int k = e & 511, n = (e >> 9) & 511, g = e >> 18;
        const int t = n >> 4, c = n & 15, s = k >> 4, cp = k & 15;
        float v = 0.f;
        if (s <= t) v += KD[(((0 * 32 + g) * 32 + (t - s)) * 16 + c) * 16 + cp];
        if (s >= t) v += KD[(((1 * 32 + g) * 32 + (s - t)) * 16 + c) * 16 + cp];
        WY[((size_t)g * 512 + n) * 768 + k] = f2bf(v);
    }
}

__device__ __forceinline__ void phase15(const Params& P) {
    const int lane = threadIdx.x & 63, w = threadIdx.x >> 6;
    const float* ss4 = (const float*)(P.ws + OFF_SS) + NT + NL;
    const int stride = gridDim.x * 8;
    int row = blockIdx.x * 8 + w;
    f32x4 vn[4]; float sn = 0.f;
    if (row < NL) { sn = ss4[row];
#pragma unroll
        for (int j = 0; j < 4; ++j) vn[j] = ((const f32x4*)(P.out + (size_t)row * 1024))[lane + 64 * j]; }
    f32x4 fn[4];
#pragma unroll
    for (int j = 0; j < 4; ++j) fn[j] = ((const f32x4*)P.in[32])[lane + 64 * j];
    while (row < NL) {
        f32x4 v[4]; const float sc = sn;
#pragma unroll
        for (int j = 0; j < 4; ++j) v[j] = vn[j];
        const int nrow = row + stride;
        if (nrow < NL) { sn = ss4[nrow];
#pragma unroll
            for (int j = 0; j < 4; ++j) vn[j] = ((const f32x4*)(P.out + (size_t)nrow * 1024))[lane + 64 * j]; }
        const float rstd = rsqrtf(sc * (1.f / 1024.f) + 1e-6f);
        f32x4* o = (f32x4*)(P.out + (size_t)row * 1024);
#pragma unroll
        for (int j = 0; j < 4; ++j) o[lane + 64 * j] = (v[j] * rstd) * fn[j];
        row = nrow;
    }
}

template <int NORM> struct EpiFfnUp : pg8::EpiNoMid {
    static constexpr bool PERM = true;
    bf16_t* HID; const float* ss; const float* BW;
    __device__ __forceinline__ void operator()(const AccT& acc, const Unit& u, int wr, int wc, int fr, int fq) const {
        f32x4 bwg[2], bwu[2]; float rstd[2][4];
        if (NORM) {
            const float* bw = BW + ((256 * u.pm) >> 13) * 5632 + 256 * u.pn + 32 * wc + 8 * fq;
#pragma unroll
            for (int nn = 0; nn < 2; ++nn) { bwg[nn] = *(const f32x4*)(bw + 4 * nn); bwu[nn] = *(const f32x4*)(bw + 128 + 4 * nn); }
#pragma unroll
            for (int ai = 0; ai < 2; ++ai)
#pragma unroll
                for (int mm = 0; mm < 4; ++mm) rstd[ai][mm] = rsqrtf(ss[256 * u.pm + 128 * ai + 64 * wr + 16 * mm + fr] * (1.f / 1024.f) + 1e-6f);
        }
        const int oc = 128 * u.pn + 32 * wc + 8 * fq;
#pragma unroll
        for (int ai = 0; ai < 2; ++ai)
#pragma unroll
            for (int mm = 0; mm < 4; ++mm) {
                const int m = 256 * u.pm + 128 * ai + 64 * wr + 16 * mm + fr;
                f32x4 o[2];
#pragma unroll
                for (int nn = 0; nn < 2; ++nn) {
                    f32x4 g = acc[ai][0][mm][nn], uu = acc[ai][1][mm][nn];
                    if (NORM) { g = g * rstd[ai][mm] + bwg[nn]; uu = uu * rstd[ai][mm] + bwu[nn]; }
#pragma unroll
                    for (int r = 0; r < 4; ++r) o[nn][r] = siluf_(g[r]) * uu[r];
                }
                *(uint4*)(HID + (size_t)m * FF + oc) = make_uint4(pk2(o[0][0], o[0][1]), pk2(o[0][2], o[0][3]), pk2(o[1][0], o[1][1]), pk2(o[1][2], o[1][3]));
            }
    }
};
template <int MODE> struct EpiRes : pg8::EpiNoMid {
    static constexpr bool PERM = true;
    const float* x; bf16_t* XRb; float* out; bf16_t* Hn; const float* mod; const float* gnext; float* ss;
    __device__ __forceinline__ void operator()(const AccT& acc, const Unit& u, int wr, int wc, int fr, int fq) const {
        constexpr int GJ = MODE == 0 ? 2 : (MODE == 1 ? 5 : 8), SJ = MODE == 0 ? 4 : 7;
        constexpr float COEF = MODE == 1 ? 1.f : 0.5f;
        const float* mb = mod + ((256 * u.pm) >> 13) * 9216;
        const int nb = 256 * u.pn + 32 * wc + 8 * fq;
        f32x4 gate[2][2]; uint2 gmp[2][2];
#pragma unroll
        for (int bj = 0; bj < 2; ++bj)
#pragma unroll
            for (int nn = 0; nn < 2; ++nn) {
                const int n = nb + 128 * bj + 4 * nn;
                gate[bj][nn] = *(const f32x4*)(mb + GJ * 1024 + n) * COEF;
                if (MODE < 2) { const f32x4 t = *(const f32x4*)(gnext + n) * (*(const f32x4*)(mb + SJ * 1024 + n) + 1.f); gmp[bj][nn] = make_uint2(pk2(t[0], t[1]), pk2(t[2], t[3])); }
            }
#pragma unroll
        for (int ai = 0; ai < 2; ++ai)
#pragma unroll
        for (int mh = 0; mh < 2; ++mh) {
            const size_t rb = (size_t)(256 * u.pm + 128 * ai + 64 * wr + 32 * mh + fr) * 1024 + nb;
            f32x4 xf[MODE == 0 ? 2 : 1][2][2]; uint4 xh[MODE == 0 ? 1 : 2][2];
#pragma unroll
            for (int mm = 0; mm < 2; ++mm)
#pragma unroll
                for (int bj = 0; bj < 2; ++bj) {
                    const size_t idx = rb + (size_t)mm * 16 * 1024 + 128 * bj;
                    if (MODE == 0) { xf[mm][bj][0] = *(const f32x4*)(x + idx); xf[mm][bj][1] = *(const f32x4*)(x + idx + 4); }
                    else xh[mm][bj] = *(const uint4*)(XRb + idx);
                }
#pragma unroll
            for (int mm = 0; mm < 2; ++mm) {
                float part = 0.f;
#pragma unroll
                for (int bj = 0; bj < 2; ++bj) {
                    const size_t idx = rb + (size_t)mm * 16 * 1024 + 128 * bj;
                    f32x4 x0, x1;
                    if (MODE == 0) { x0 = xf[mm][bj][0]; x1 = xf[mm][bj][1]; }
                    else { const uint4 h4 = xh[mm][bj]; x0 = (f32x4){bflo(h4.x), bfhi(h4.x), bflo(h4.y), bfhi(h4.y)}; x1 = (f32x4){bflo(h4.z), bfhi(h4.z), bflo(h4.w), bfhi(h4.w)}; }
                    const f32x4 n0 = x0 + gate[bj][0] * acc[ai][bj][2 * mh + mm][0], n1 = x1 + gate[bj][1] * acc[ai][bj][2 * mh + mm][1];
                    part += (n0[0] * n0[0] + n0[1] * n0[1] + n0[2] * n0[2] + n0[3] * n0[3]) + (n1[0] * n1[0] + n1[1] * n1[1] + n1[2] * n1[2] + n1[3] * n1[3]);
                    if (MODE < 2) {
                        *(uint4*)(XRb + idx) = make_uint4(pk2(n0[0], n0[1]), pk2(n0[2], n0[3]), pk2(n1[0], n1[1]), pk2(n1[2], n1[3]));
                        const f32x4 g0 = {bflo(gmp[bj][0].x), bfhi(gmp[bj][0].x), bflo(gmp[bj][0].y), bfhi(gmp[bj][0].y)}, g1 = {bflo(gmp[bj][1].x), bfhi(gmp[bj][1].x), bflo(gmp[bj][1].y), bfhi(gmp[bj][1].y)};
                        const f32x4 h0 = n0 * g0, h1 = n1 * g1;
                        *(uint4*)(Hn + idx) = make_uint4(pk2(h0[0], h0[1]), pk2(h0[2], h0[3]), pk2(h1[0], h1[1]), pk2(h1[2], h1[3]));
                    } else { *(f32x4*)(out + idx) = n0; *(f32x4*)(out + idx + 4) = n1; }
                }
                part += __shfl_xor(part, 16); part += __shfl_xor(part, 32);
                if (fq == 0) (void)__hip_atomic_fetch_add(ss + 256 * u.pm + 128 * ai + 64 * wr + 32 * mh + 16 * mm + fr, part, __ATOMIC_RELAXED, __HIP_MEMORY_SCOPE_AGENT);
            }
        }
    }
};
template <int NORM>
__device__ __forceinline__ void phase_ffn_up(const Params& P, PG8_LAS unsigned char* lds, size_t off_w, int M) {
    GemmD g{}; g.A = (const bf16_t*)(P.ws + OFF_H); g.Bt = (const bf16_t*)(P.ws + off_w); g.lda = 1024; g.ldb = 1024; g.K = 1024; g.nM = M >> 8; g.nN = 22; g.nG = 1;
    EpiFfnUp<NORM> E; E.HID = (bf16_t*)(P.ws + OFF_HID); E.ss = (const float*)(P.ws + OFF_SS) + NT; E.BW = (const float*)(P.ws + OFF_BW) + 5 * 4352;
    pg8::gemm_phase(lds, g, E);
}
struct EpiFfnDownCtx : pg8::EpiNoMid {
    float* XR; const float* mod;
    __device__ __forceinline__ void operator()(const AccT& acc, const Unit& u, int wr, int wc, int fr, int fq) const {
#pragma unroll
        for (int bj = 0; bj < 2; ++bj)
#pragma unroll
            for (int nn = 0; nn < 2; ++nn) {
                const int n = 256 * u.pn + 128 * bj + 32 * wc + 16 * nn + 4 * fq;
                const f32x4 gt = *(const f32x4*)(mod + 4 * 9216 + 2 * 1024 + n) * 0.5f;
                float* xb = XR + (size_t)(256 * u.pm + 64 * wr + fr) * 1024 + n;
#pragma unroll
                for (int ai = 0; ai < 2; ++ai)
#pragma unroll
                    for (int mm = 0; mm < 4; ++mm) {
                        float* xp = xb + (size_t)(128 * ai + 16 * mm) * 1024;
                        const f32x4 v = acc[ai][bj][mm][nn] * gt;
#pragma unroll
                        for (int r = 0; r < 4; ++r) (void)__hip_atomic_fetch_add(xp + r, v[r], __ATOMIC_RELAXED, __HIP_MEMORY_SCOPE_AGENT);
                    }
                asm volatile("" ::: "memory");
            }
    }
};
template <int FIRST>
__device__ __forceinline__ void phase_ffn_down(const Params& P, PG8_LAS unsigned char* lds, size_t off_w) {
    GemmD g{}; g.A = (const bf16_t*)(P.ws + OFF_HID); g.Bt = (const bf16_t*)(P.ws + off_w); g.lda = FF; g.ldb = FF; g.K = FF; g.nM = NL >> 8; g.nN = 4; g.nG = 1;
    EpiRes<FIRST ? 0 : 2> E; E.x = P.in[0]; E.XRb = (bf16_t*)(P.ws + OFF_XR); E.out = P.out; E.Hn = (bf16_t*)(P.ws + OFF_H); E.mod = (const float*)(P.ws + OFF_MOD);
    E.gnext = P.in[10]; E.ss = (float*)(P.ws + OFF_SS) + (FIRST ? 0 : NT + NL);
    pg8::gemm_phase(lds, g, E);
    if (FIRST) {
        GemmD c{}; c.A = (const bf16_t*)(P.ws + OFF_HID) + (size_t)NL * FF; c.Bt = g.Bt; c.lda = FF; c.ldb = FF; c.K = 256; c.nM = 4; c.nN = 4; c.nG = 11; c.gsA = 256; c.gsB = 256;
        EpiFfnDownCtx EC; EC.XR = (float*)(P.ws + OFF_E); EC.mod = E.mod;
        pg8::gemm_phase(lds, c, EC);
    }
}
__device__ __forceinline__ uint4 pack8(f32x4 a, f32x4 b) { return make_uint4(pk2(a[0], a[1]), pk2(a[2], a[3]), pk2(b[0], b[1]), pk2(b[2], b[3])); }
struct EpiWin : pg8::EpiNoMid {
    static constexpr bool PERM = true;
    bf16_t *U, *Q, *Kb, *V, *R, *GLR, *GA, *GB; const float* ss; const float* BW;
    __device__ __forceinline__ void operator()(const AccT& acc, const Unit& u, int wr, int wc, int fr, int fq) const {
        f32x4 bias[2][2]; float rstd[2][4];
        const int m0 = 256 * u.pm, nb = 256 * u.pn + 32 * wc + 8 * fq;
        {
            const float* bw = BW + (m0 < NL ? (m0 >> 13) : 4) * 4352 + nb;
#pragma unroll
            for (int bj = 0; bj < 2; ++bj)
#pragma unroll
                for (int nn = 0; nn < 2; ++nn) bias[bj][nn] = *(const f32x4*)(bw + 128 * bj + 4 * nn);
#pragma unroll
            for (int ai = 0; ai < 2; ++ai)
#pragma unroll
                for (int mm = 0; mm < 4; ++mm) rstd[ai][mm] = rsqrtf(ss[m0 + 128 * ai + 64 * wr + 16 * mm + fr] * (1.f / 1024.f) + 1e-6f);
        }
#pragma unroll
        for (int ai = 0; ai < 2; ++ai)
#pragma unroll
            for (int mm = 0; mm < 4; ++mm) {
                const int m = m0 + 128 * ai + 64 * wr + 16 * mm + fr;
                const bool lat = m < NL;
                const int b = lat ? (m >> 13) : ((m - NL) >> 8), l = lat ? (m & 8191) : ((m - NL) & 255);
                const int rcm = lat ? (b << 13) + ((l & 63) << 7) + (l >> 6) : m;
#pragma unroll
                for (int bj = 0; bj < 2; ++bj) {
                    const int n = nb + 128 * bj;
                    const f32x4 v0 = acc[ai][bj][mm][0] * rstd[ai][mm] + bias[bj][0], v1 = acc[ai][bj][mm][1] * rstd[ai][mm] + bias[bj][1];
                    if (n < 512) {
                        const int g = n >> 4, urow = lat ? (b << 8) + (l >> 5) : 1024 + (b << 3) + (l >> 5), t = l & 31;
                        *(uint4*)(U + ((size_t)g * UROWS + urow) * 768 + t * 16 + (n & 15)) = pack8(v0, v1);
                    } else if (n < 768) { *(uint4*)(Q + (size_t)rcm * 256 + (n - 512)) = pack8(v0 * 0.125f, v1 * 0.125f); }
                    else if (n < 1024) { *(uint4*)(Kb + (size_t)rcm * 256 + (n - 768)) = pack8(v0, v1); }
                    else if (n < 1536) { *(uint4*)(V + (size_t)rcm * 512 + (n - 1024)) = pack8(v0, v1); }
                    else if (n < 2048) { *(uint4*)(R + (size_t)rcm * 512 + (n - 1536)) = pack8(v0, v1); }
                    else if (n < 4096) {
                        if (lat) {
                            const int j0 = ((256 * u.pn + 128 * bj + 32 * wc - 2048) >> 1) + 4 * fq;
                            f32x4 sa, rt;
#pragma unroll
                            for (int r = 0; r < 4; ++r) { const float ea = 1.f + __expf(-v0[r]), eb = 1.f + __expf(-v1[r]); sa[r] = rcpf_(ea); rt[r] = ea * rcpf_(eb); }
                            store_bf4(GA + (size_t)m * 1024 + j0, sa);
                            store_bf4(GB + (size_t)m * 1024 + j0, rt);
                        }
                    }
                    else if (n < 4128) { *(uint4*)(GLR + (size_t)rcm * 32 + (n - 4096)) = pack8(v0, v1); }
                }
            }
    }
};
__device__ __forceinline__ void phase5(const Params& P, PG8_LAS unsigned char* lds) {
    GemmD g{}; g.A = (const bf16_t*)(P.ws + OFF_H); g.Bt = (const bf16_t*)(P.ws + OFF_WIN); g.lda = 1024; g.ldb = 1024; g.K = 1024; g.nM = NT >> 8; g.nN = 17; g.nG = 1;
    EpiWin E; E.U = (bf16_t*)(P.ws + OFF_U); E.Q = (bf16_t*)(P.ws + OFF_Q); E.Kb = (bf16_t*)(P.ws + OFF_K); E.V = (bf16_t*)(P.ws + OFF_V); E.R = (bf16_t*)(P.ws + OFF_R);
    E.GLR = (bf16_t*)(P.ws + OFF_GLR); E.GA = (bf16_t*)P.out; E.GB = E.GA + (size_t)NL * 1024; E.ss = (const float*)(P.ws + OFF_SS); E.BW = (const float*)(P.ws + OFF_BW);
    pg8::gemm_phase(lds, g, E);
}

__device__ __forceinline__ float logsig(float z) { return fminf(z, 0.f) - __logf(1.f + __expf(-fabsf(z))); }

struct VRegs { uint4 a0, a1, b0, b1; };
__device__ __forceinline__ VRegs load_v_regs(const bf16_t* __restrict__ Vg, int t) {
    const int ip = t & 31, c = t >> 5; VRegs r;
    const bf16_t* p = Vg + (size_t)(2 * ip) * 512 + c * 16;
    r.a0 = *(const uint4*)p; r.a1 = *(const uint4*)(p + 8); r.b0 = *(const uint4*)(p + 512); r.b1 = *(const uint4*)(p + 520);
    return r;
}
__device__ __forceinline__ void store_vt(const VRegs& r, bf16_t* sVt, int t) {
    const int ip = t & 31, c = t >> 5;
    const unsigned ua[8] = {r.a0.x, r.a0.y, r.a0.z, r.a0.w, r.a1.x, r.a1.y, r.a1.z, r.a1.w};
    const unsigned ub[8] = {r.b0.x, r.b0.y, r.b0.z, r.b0.w, r.b1.x, r.b1.y, r.b1.z, r.b1.w};
    unsigned* base = (unsigned*)(sVt + (c * 16) * LROW + 2 * ip);
#pragma unroll
    for (int e = 0; e < 8; ++e) {
        base[(2 * e) * (LROW / 2)] = (ua[e] & 0xffffu) | (ub[e] << 16);
        base[(2 * e + 1) * (LROW / 2)] = (ua[e] >> 16) | (ub[e] & 0xffff0000u);
    }
}
__device__ __forceinline__ float gate_prefix(const Params& P, const float* sGLRd  , int stride, int d, int h, int dk, int part, float (&pre)[16]) {
    float gu[16];
#pragma unroll
    for (int j = 0; j < 16; ++j) gu[j] = P.in[23][(d * 16 + j) * 256 + h * 64 + dk];
    const float gb = P.in[24][d * 256 + h * 64 + dk];
#pragma unroll
    for (int ii = 0; ii < 16; ++ii) {
        const float* gl = sGLRd + (part * 16 + ii) * stride;
        float z = gb;
#pragma unroll
        for (int j4 = 0; j4 < 4; ++j4) { const f32x4 x = *(const f32x4*)(gl + j4 * 4); z += x[0] * gu[j4 * 4] + x[1] * gu[j4 * 4 + 1] + x[2] * gu[j4 * 4 + 2] + x[3] * gu[j4 * 4 + 3]; }
        pre[ii] = logsig(z) * (1.f / 16.f);
    }
    if (d == 0) {
#pragma unroll
        for (int ii = 1; ii < 16; ++ii) pre[ii] += pre[ii - 1];
        return pre[15];
    } else {
#pragma unroll
        for (int ii = 14; ii >= 0; --ii) pre[ii] += pre[ii + 1];
        return pre[0];
    }
}

__device__ __forceinline__ void gla_a_item(const Params& P, int item, unsigned char* smem) {
    float* sGLR = (float*)smem;
    float* sPart = (float*)(smem + 4096);
    bf16_t* sKDt = (bf16_t*)(smem + 5120);
    bf16_t* sVt = (bf16_t*)(smem + 5120 + 9216);
    const int n = item % 132, d = (item / 132) & 1, h = (item / 264) & 3, b = item / 1056;
    const int rowbase = n < 4 ? NL + b * 256 + n * 64 : b * 8192 + (n - 4) * 64;
    const bf16_t* Kb = (const bf16_t*)(P.ws + OFF_K); const bf16_t* V = (const bf16_t*)(P.ws + OFF_V); const bf16_t* GLR = (const bf16_t*)(P.ws + OFF_GLR);
    const int tid = threadIdx.x & 255, lane = tid & 63, w = tid >> 6, dk = tid & 63, part = tid >> 6;
    const VRegs vr = load_v_regs(V + (size_t)rowbase * 512 + h * 128, tid);
    const f32x4 gl4 = load_bf4(GLR + (size_t)(rowbase + (tid >> 2)) * 32 + d * 16 + (tid & 3) * 4);
    float kk[16];
#pragma unroll
    for (int ii = 0; ii < 16; ++ii) kk[ii] = bf2f(Kb[(size_t)(rowbase + part * 16 + ii) * 256 + h * 64 + dk]);
    *(f32x4*)(sGLR + (tid >> 2) * 16 + (tid & 3) * 4) = gl4;
    store_vt(vr, sVt, tid);
    __syncthreads();
    float pre[16];
    const float tot = gate_prefix(P, sGLR, 16, d, h, dk, part, pre);
    sPart[part * 64 + dk] = tot;
    __syncthreads();
    const float t0 = sPart[dk], t1 = sPart[64 + dk], t2 = sPart[128 + dk], t3 = sPart[192 + dk];
    const float gtot = (t0 + t1) + (t2 + t3);
    float off;
    if (d == 0) off = part == 0 ? 0.f : (part == 1 ? t0 : (part == 2 ? t0 + t1 : t0 + t1 + t2));
    else off = part == 3 ? 0.f : (part == 2 ? t3 : (part == 1 ? t3 + t2 : t3 + t2 + t1));
    unsigned pk[8];
#pragma unroll
    for (int e = 0; e < 8; ++e) pk[e] = pk2(kk[2 * e] * __expf(gtot - (off + pre[2 * e])), kk[2 * e + 1] * __expf(gtot - (off + pre[2 * e + 1])));
    *(uint4*)(sKDt + dk * LROW + part * 16) = make_uint4(pk[0], pk[1], pk[2], pk[3]);
    *(uint4*)(sKDt + dk * LROW + part * 16 + 8) = make_uint4(pk[4], pk[5], pk[6], pk[7]);
    if (part == 0) ((float*)(P.ws + OFF_DEC))[(size_t)item * 64 + dk] = __expf(gtot);
    __syncthreads();
    bf16_t* KVt = (bf16_t*)(P.ws + OFF_H) + (size_t)item * 8192;
    const int fr = lane & 15, fq = lane >> 4;
#pragma unroll
    for (int dvt = 0; dvt < 2; ++dvt) {
        f32x4 acc[4];
#pragma unroll
        for (int dkt = 0; dkt < 4; ++dkt) acc[dkt] = (f32x4){0.f, 0.f, 0.f, 0.f};
#pragma unroll
        for (int ks = 0; ks < 2; ++ks) {
            const bf16x8 vb = *(const bf16x8*)(sVt + (w * 32 + dvt * 16 + fr) * LROW + ks * 32 + fq * 8);
#pragma unroll
            for (int dkt = 0; dkt < 4; ++dkt) {
                const bf16x8 ka = *(const bf16x8*)(sKDt + (dkt * 16 + fr) * LROW + ks * 32 + fq * 8);
                acc[dkt] = __builtin_amdgcn_mfma_f32_16x16x32_bf16(ka, vb, acc[dkt], 0, 0, 0);
            }
        }
#pragma unroll
        for (int dkt = 0; dkt < 4; ++dkt) store_bf4(KVt + (size_t)(w * 32 + dvt * 16 + fr) * 64 + dkt * 16 + fq * 4, acc[dkt]);
    }
    __syncthreads();
}

__device__ __forceinline__ void gla_scan_item(const Params& P, int item) {
    const int gid = item * NTHR + threadIdx.x, seq = gid >> 11, e = gid & 2047, dv = e >> 4, dk4 = (e & 15) * 4, d = seq & 1;
    bf16_t* base = (bf16_t*)(P.ws + OFF_H) + (size_t)seq * 132 * 8192 + dv * 64 + dk4;
    const float* decb = (const float*)(P.ws + OFF_DEC) + (size_t)seq * 132 * 64 + dk4;
    f32x4 S = (f32x4){0.f, 0.f, 0.f, 0.f};
    for (int s0 = 0; s0 < 132; s0 += 12) {
        uint2 kvr[12]; f32x4 dec[12];
#pragma unroll
        for (int q = 0; q < 12; ++q) {
            const int step = s0 + q, n = d == 0 ? step : (step < 4 ? 3 - step : 135 - step);
            kvr[q] = *(const uint2*)(base + (size_t)n * 8192); dec[q] = *(const f32x4*)(decb + n * 64);
        }
#pragma unroll
        for (int q = 0; q < 12; ++q) {
            const int step = s0 + q, n = d == 0 ? step : (step < 4 ? 3 - step : 135 - step);
            if (n >= 4) store_bf4(base + (size_t)n * 8192, S);
            f32x4 kv; kv[0] = bflo(kvr[q].x); kv[1] = bfhi(kvr[q].x); kv[2] = bflo(kvr[q].y); kv[3] = bfhi(kvr[q].y);
            S = dec[q] * S + kv;
        }
    }
}

__device__ __forceinline__ void gla_c_item(const Params& P, int item, unsigned char* smem) {
    float* sGLR = (float*)smem;
    float* sPart = (float*)(smem + 8192);
    bf16_t* sQD = (bf16_t*)(smem + 10240);
    bf16_t* sKD = (bf16_t*)(smem + 10240 + 9216);
    bf16_t* sQG = (bf16_t*)(smem + 10240 + 2 * 9216);
    bf16_t* sP = (bf16_t*)(smem + 10240 + 2 * 9216 + 17408);
    bf16_t* sVt = (bf16_t*)(smem + 10240 + 3 * 9216 + 17408);
    const int m = item & 127, h = (item >> 7) & 3, b = item >> 9;
    const int rowbase = b * 8192 + m * 64;
    const bf16_t* Q = (const bf16_t*)(P.ws + OFF_Q); const bf16_t* Kb = (const bf16_t*)(P.ws + OFF_K);
    bf16_t* V = (bf16_t*)(P.ws + OFF_V); const bf16_t* R = (const bf16_t*)(P.ws + OFF_R); const bf16_t* GLR = (const bf16_t*)(P.ws + OFF_GLR);
    const int tid = threadIdx.x & 255, lane = tid & 63, w = tid >> 6, fr = lane & 15, fq = lane >> 4, dk = tid & 63, part = tid >> 6;
    const VRegs vr = load_v_regs(V + (size_t)rowbase * 512 + h * 128, tid);
    const uint4 gl8 = *(const uint4*)(GLR + (size_t)(rowbase + (tid >> 2)) * 32 + (tid & 3) * 8);
    float qq[16], kk[16];
#pragma unroll
    for (int ii = 0; ii < 16; ++ii) { qq[ii] = bf2f(Q[(size_t)(rowbase + part * 16 + ii) * 256 + h * 64 + dk]); kk[ii] = bf2f(Kb[(size_t)(rowbase + part * 16 + ii) * 256 + h * 64 + dk]); }
    {
        float* gp = sGLR + (tid >> 2) * 32 + (tid & 3) * 8;
        *(f32x4*)gp = (f32x4){bflo(gl8.x), bfhi(gl8.x), bflo(gl8.y), bfhi(gl8.y)};
        *(f32x4*)(gp + 4) = (f32x4){bflo(gl8.z), bfhi(gl8.z), bflo(gl8.w), bfhi(gl8.w)};
    }
    store_vt(vr, sVt, tid);
    __syncthreads();
    float gc0[16], gc1[16];
    { const float tot0 = gate_prefix(P, sGLR, 32, 0, h, dk, part, gc0); const float tot1 = gate_prefix(P, sGLR + 16, 32, 1, h, dk, part, gc1);
      sPart[part * 64 + dk] = tot0; sPart[256 + part * 64 + dk] = tot1; }
    __syncthreads();
    float gref0, gref1;
    {
        const float a0 = sPart[dk], a1 = sPart[64 + dk], a2 = sPart[128 + dk];
        const float c1 = sPart[256 + 64 + dk], c2 = sPart[256 + 128 + dk], c3 = sPart[256 + 192 + dk];
        const float off0 = part == 0 ? 0.f : (part == 1 ? a0 : (part == 2 ? a0 + a1 : a0 + a1 + a2));
        const float off1 = part == 3 ? 0.f : (part == 2 ? c3 : (part == 1 ? c3 + c2 : c3 + c2 + c1));
        gref0 = a0 + a1; gref1 = c3 + c2;
#pragma unroll
        for (int ii = 0; ii < 16; ++ii) { gc0[ii] += off0; gc1[ii] += off1; }
    }
    f32x4 pacc[4];
#pragma unroll
    for (int jt = 0; jt < 4; ++jt) pacc[jt] = (f32x4){0.f, 0.f, 0.f, 0.f};
#pragma unroll
    for (int d = 0; d < 2; ++d) {
        const float gref = d == 0 ? gref0 : gref1;
#pragma unroll
        for (int ii = 0; ii < 16; ++ii) {
            const int i = part * 16 + ii;
            const float gc = d == 0 ? gc0[ii] : gc1[ii];
            sQD[i * LROW + dk] = f2bf(qq[ii] * __expf(gc - gref));
            sKD[i * LROW + dk] = f2bf(kk[ii] * __expf(gref - gc));
            sQG[i * 136 + d * 64 + dk] = f2bf(qq[ii] * __expf(gc));
        }
        __syncthreads();
#pragma unroll
        for (int jt = 0; jt < 4; ++jt) {
            f32x4 sc = (f32x4){0.f, 0.f, 0.f, 0.f};
#pragma unroll
            for (int ks = 0; ks < 2; ++ks) {
                const bf16x8 a = *(const bf16x8*)(sQD + (16 * w + fr) * LROW + ks * 32 + fq * 8);
                const bf16x8 bb = *(const bf16x8*)(sKD + (jt * 16 + fr) * LROW + ks * 32 + fq * 8);
                sc = __builtin_amdgcn_mfma_f32_16x16x32_bf16(a, bb, sc, 0, 0, 0);
            }
#pragma unroll
            for (int r = 0; r < 4; ++r) {
                const int i = 16 * w + fq * 4 + r, j = jt * 16 + fr;
                const bool keep = d == 0 ? (j <= i) : (j >= i);
                pacc[jt][r] += keep ? sc[r] : 0.f;
            }
        }
        if (d == 0) __syncthreads();
    }
#pragma unroll
    for (int jt = 0; jt < 4; ++jt)
#pragma unroll
        for (int r = 0; r < 4; ++r) sP[(16 * w + fq * 4 + r) * LROW + jt * 16 + fr] = f2bf(pacc[jt][r]);
    const bf16_t* SS0 = (const bf16_t*)(P.ws + OFF_H) + ((size_t)(((b * 4 + h) * 2 + 0) * 132 + 4 + m)) * 8192;
    const bf16_t* SS1 = (const bf16_t*)(P.ws + OFF_H) + ((size_t)(((b * 4 + h) * 2 + 1) * 132 + 4 + m)) * 8192;
    const int i_out = 16 * w + fr;
    const int tok_out = b * 8192 + ((m & 1) * 64 + i_out) * 64 + (m >> 1);
    bf16_t* YB = (bf16_t*)(P.ws + OFF_YB);
    uint2 rgr[8];
#pragma unroll
    for (int dvt = 0; dvt < 8; ++dvt) rgr[dvt] = *(const uint2*)(R + (size_t)(rowbase + i_out) * 512 + h * 128 + dvt * 16 + fq * 4);
    __syncthreads();
    f32x4 oacc[8];
#pragma unroll
    for (int dvt = 0; dvt < 8; ++dvt) oacc[dvt] = (f32x4){0.f, 0.f, 0.f, 0.f};
#pragma unroll
    for (int ks = 0; ks < 4; ++ks) {
        const bf16x8 qb = *(const bf16x8*)(sQG + (16 * w + fr) * 136 + ks * 32 + fq * 8);
        const bf16_t* SS = (ks >> 1) ? SS1 : SS0;
#pragma unroll
        for (int dvt = 0; dvt < 8; ++dvt) {
            const bf16x8 sa = *(const bf16x8*)(SS + (size_t)(dvt * 16 + fr) * 64 + (ks & 1) * 32 + fq * 8);
            oacc[dvt] = __builtin_amdgcn_mfma_f32_16x16x32_bf16(sa, qb, oacc[dvt], 0, 0, 0);
        }
    }
#pragma unroll
    for (int ks = 0; ks < 2; ++ks) {
        const bf16x8 pb = *(const bf16x8*)(sP + (16 * w + fr) * LROW + ks * 32 + fq * 8);
#pragma unroll
        for (int dvt = 0; dvt < 8; ++dvt) {
            const bf16x8 va = *(const bf16x8*)(sVt + (dvt * 16 + fr) * LROW + ks * 32 + fq * 8);
            oacc[dvt] = __builtin_amdgcn_mfma_f32_16x16x32_bf16(va, pb, oacc[dvt], 0, 0, 0);
        }
    }
    float ss = 0.f;
#pragma unroll
    for (int dvt = 0; dvt < 8; ++dvt)
#pragma unroll
        for (int r = 0; r < 4; ++r) ss += oacc[dvt][r] * oacc[dvt][r];
    ss += __shfl_xor(ss, 16); ss += __shfl_xor(ss, 32);
    const float rinv = rsqrtf(ss * (1.f / 128.f) + 1e-6f);
#pragma unroll
    for (int dvt = 0; dvt < 8; ++dvt) {
        const int dv = dvt * 16 + fq * 4;
        const float rg[4] = {bflo(rgr[dvt].x), bfhi(rgr[dvt].x), bflo(rgr[dvt].y), bfhi(rgr[dvt].y)};
        const f32x4 ng = *(const f32x4*)(P.in[25] + h * 128 + dv);
        f32x4 o;
#pragma unroll
        for (int r = 0; r < 4; ++r) o[r] = oacc[dvt][r] * rinv * ng[r] * siluf_(rg[r]);
        store_bf4(YB + (size_t)tok_out * 512 + h * 128 + dv, o);
    }
    __syncthreads();
}

struct EpiE : pg8::EpiNoMid {
    float* E;
    __device__ __forceinline__ void operator()(const AccT& acc, const Unit& u, int wr, int wc, int fr, int fq) const {
        EPI_LOOP
            if (m < 1056) *(f32x4*)(E + ((size_t)u.g * 1056 + m) * 256 + n) = v;
        EPI_LOOP_END
    }
};
__device__ __forceinline__ void phase6(const Params& P, unsigned char* smem) {
    const int hb = threadIdx.x >> 8;
    for (int base = blockIdx.x * 2; base < 4224; base += gridDim.x * 2) gla_a_item(P, base + hb, smem + hb * HALF_LDS);
    GemmD g{}; g.A = (const bf16_t*)(P.ws + OFF_U); g.Bt = (const bf16_t*)(P.ws + OFF_WE); g.lda = 768; g.ldb = 512; g.K = 512; g.nM = 5; g.nN = 1; g.nG = 32;
    g.gsA = (size_t)UROWS * 768; g.gsB = (size_t)256 * 512;
    EpiE E; E.E = (float*)(P.ws + OFF_E);
    pg8::gemm_phase((PG8_LAS unsigned char*)smem, g, E);
}
__device__ __forceinline__ void s5_carry_item(const Params& P, int item) {
    const int id = item * NTHR + threadIdx.x, p = id & 63, d = (id >> 6) & 1, b = (id >> 7) & 3, g = id >> 9;
    const float2 lamT = ((const float2*)(P.ws + OFF_LP))[((d * 32 + g) * 33 + 32) * 64 + p];
    const float* Eg = (const float*)(P.ws + OFF_E) + (size_t)g * 1056 * 256;
    bf16_t* Ug = (bf16_t*)(P.ws + OFF_U) + (size_t)g * UROWS * 768;
    const int cre = d * 128 + p, cim = d * 128 + 64 + p;
    float2 hh = make_float2(0.f, 0.f);
    {
        float2 e[8];
#pragma unroll
        for (int s = 0; s < 8; ++s) { const int n = d == 0 ? s : 7 - s, row = 1024 + b * 8 + n; e[s] = make_float2(Eg[(size_t)row * 256 + cre], Eg[(size_t)row * 256 + cim]); }
#pragma unroll
        for (int s = 0; s < 8; ++s) { const float2 t = cmul(lamT, hh); hh = make_float2(t.x + e[s].x, t.y + e[s].y); }
    }
    for (int s0 = 0; s0 < 256; s0 += 16) {
        float2 e[16];
#pragma unroll
        for (int q = 0; q < 16; ++q) { const int s = s0 + q, n = d == 0 ? s : 255 - s, row = b * 256 + n; e[q] = make_float2(Eg[(size_t)row * 256 + cre], Eg[(size_t)row * 256 + cim]); }
#pragma unroll
        for (int q = 0; q < 16; ++q) {
            const int s = s0 + q, n = d == 0 ? s : 255 - s, row = b * 256 + n;
            Ug[(size_t)row * 768 + 512 + cre] = f2bf(hh.x); Ug[(size_t)row * 768 + 512 + cim] = f2bf(hh.y);
            const float2 t = cmul(lamT, hh); hh = make_float2(t.x + e[q].x, t.y + e[q].y);
        }
    }
}
__device__ __forceinline__ void phase7(const Params& P) {
    for (int it = blockIdx.x; it < 32 + 128; it += gridDim.x) {
        if (it < 32) s5_carry_item(P, it); else gla_scan_item(P, it - 32);
    }
}
struct EpiY : pg8::EpiNoMid {
    static constexpr bool PERM = true;
    const bf16_t* U; const float* dskip; bf16_t* YG;
    __device__ __forceinline__ void operator()(const AccT& acc, const Unit& u, int wr, int wc, int fr, int fq) const {
        const int nb = 256 * u.pn + 32 * wc + 8 * fq, c0 = 8 * (fq & 1);
        const f32x4 ds0 = *(const f32x4*)(dskip + u.g * 16 + c0), ds1 = *(const f32x4*)(dskip + u.g * 16 + c0 + 4);
#pragma unroll
        for (int ai = 0; ai < 2; ++ai) {
            const int mb = 256 * u.pm + 128 * ai + 64 * wr + fr;
            uint4 ur[4][2];
#pragma unroll
            for (int mm = 0; mm < 4; ++mm)
#pragma unroll
                for (int bj = 0; bj < 2; ++bj) ur[mm][bj] = *(const uint4*)(U + ((size_t)u.g * UROWS + mb + 16 * mm) * 768 + nb + 128 * bj);
#pragma unroll
            for (int mm = 0; mm < 4; ++mm)
#pragma unroll
                for (int bj = 0; bj < 2; ++bj) {
                    const int m = mb + 16 * mm, n = nb + 128 * bj;
                    const int b = m >> 8, nch = m & 255, t = n >> 4;
                    const uint4 uu = ur[mm][bj];
                    const f32x4 v0 = acc[ai][bj][mm][0], v1 = acc[ai][bj][mm][1];
                    const f32x4 o0 = {gelu_tanh(v0[0] + ds0[0] * bflo(uu.x)), gelu_tanh(v0[1] + ds0[1] * bfhi(uu.x)), gelu_tanh(v0[2] + ds0[2] * bflo(uu.y)), gelu_tanh(v0[3] + ds0[3] * bfhi(uu.y))};
                    const f32x4 o1 = {gelu_tanh(v1[0] + ds1[0] * bflo(uu.z)), gelu_tanh(v1[1] + ds1[1] * bfhi(uu.z)), gelu_tanh(v1[2] + ds1[2] * bflo(uu.w)), gelu_tanh(v1[3] + ds1[3] * bfhi(uu.w))};
                    *(uint4*)(YG + ((size_t)(b * 8192 + nch * 32 + t)) * 512 + u.g * 16 + c0) = pack8(o0, o1);
                }
        }
    }
};
__device__ __forceinline__ void phase8(const Params& P, unsigned char* smem) {
    const int hb = threadIdx.x >> 8;
    for (int base = blockIdx.x * 2; base < 2048; base += gridDim.x * 2) gla_c_item(P, base + hb, smem + hb * HALF_LDS);
    GemmD g{}; g.A = (const bf16_t*)(P.ws + OFF_U); g.Bt = (const bf16_t*)(P.ws + OFF_WY); g.lda = 768; g.ldb = 768; g.K = 768; g.nM = 4; g.nN = 2; g.nG = 32;
    g.gsA = (size_t)UROWS * 768; g.gsB = (size_t)512 * 768;
    EpiY E; E.U = (const bf16_t*)(P.ws + OFF_U); E.dskip = P.in[19]; E.YG = (bf16_t*)(P.ws + OFF_E);
    pg8::gemm_phase((PG8_LAS unsigned char*)smem, g, E);
}

struct EpiGlu : pg8::EpiNoMid {
    static constexpr bool PERM = true;
    const bf16_t* YG; const float* bias; bf16_t* YA;
    __device__ __forceinline__ void operator()(const AccT& acc, const Unit& u, int wr, int wc, int fr, int fq) const {
        const int nb = 256 * u.pn + 32 * wc + 8 * fq;
        f32x4 bb[2][2];
#pragma unroll
        for (int bj = 0; bj < 2; ++bj)
#pragma unroll
            for (int nn = 0; nn < 2; ++nn) bb[bj][nn] = *(const f32x4*)(bias + nb + 128 * bj + 4 * nn);
#pragma unroll
        for (int ai = 0; ai < 2; ++ai) {
            const size_t rb = (size_t)(256 * u.pm + 128 * ai + 64 * wr + fr) * 512 + nb;
            uint4 yr[4][2];
#pragma unroll
            for (int mm = 0; mm < 4; ++mm)
#pragma unroll
                for (int bj = 0; bj < 2; ++bj) yr[mm][bj] = *(const uint4*)(YG + rb + (size_t)mm * 16 * 512 + 128 * bj);
#pragma unroll
            for (int mm = 0; mm < 4; ++mm)
#pragma unroll
                for (int bj = 0; bj < 2; ++bj) {
                    const uint4 y = yr[mm][bj]; const f32x4 v0 = acc[ai][bj][mm][0] + bb[bj][0], v1 = acc[ai][bj][mm][1] + bb[bj][1];
                    const f32x4 o0 = {bflo(y.x) * sigm(v0[0]), bfhi(y.x) * sigm(v0[1]), bflo(y.y) * sigm(v0[2]), bfhi(y.y) * sigm(v0[3])};
                    const f32x4 o1 = {bflo(y.z) * sigm(v1[0]), bfhi(y.z) * sigm(v1[1]), bflo(y.w) * sigm(v1[2]), bfhi(y.w) * sigm(v1[3])};
                    *(uint4*)(YA + rb + (size_t)mm * 16 * 512 + 128 * bj) = pack8(o0, o1);
                }
        }
    }
};
__device__ __forceinline__ void phase9(const Params& P, PG8_LAS unsigned char* lds) {
    GemmD g{}; g.A = (const bf16_t*)(P.ws + OFF_E); g.Bt = (const bf16_t*)(P.ws + OFF_WGLU); g.lda = 512; g.ldb = 512; g.K = 512; g.nM = NL >> 8; g.nN = 2; g.nG = 1;
    EpiGlu E; E.YG = (const bf16_t*)(P.ws + OFF_E); E.bias = P.in[21]; E.YA = (bf16_t*)(P.ws + OFF_U);
    pg8::gemm_phase(lds, g, E);
}
struct EpiMerge {
    static constexpr bool PERM = true;
    const bf16_t* GA; const bf16_t* GB; bf16_t* H;
    __device__ __forceinline__ void mid(f32x4 (&acc)[2][2][4][2], const Unit& u, int wr, int wc, int fr, int fq) const {
        const int nb = 256 * u.pn + 32 * wc + 8 * fq;
#pragma unroll
        for (int ai = 0; ai < 2; ++ai) {
            const size_t rb = (size_t)(256 * u.pm + 128 * ai + 64 * wr + fr) * 1024 + nb;
            uint4 br[4][2];
#pragma unroll
            for (int mm = 0; mm < 4; ++mm)
#pragma unroll
                for (int bj = 0; bj < 2; ++bj) br[mm][bj] = *(const uint4*)(GB + rb + (size_t)mm * 16 * 1024 + 128 * bj);
#pragma unroll
            for (int mm = 0; mm < 4; ++mm)
#pragma unroll
                for (int bj = 0; bj < 2; ++bj) {
                    const uint4 b4 = br[mm][bj];
                    f32x4& v0 = acc[ai][bj][mm][0]; f32x4& v1 = acc[ai][bj][mm][1];
                    v0[0] *= bflo(b4.x); v0[1] *= bfhi(b4.x); v0[2] *= bflo(b4.y); v0[3] *= bfhi(b4.y);
                    v1[0] *= bflo(b4.z); v1[1] *= bfhi(b4.z); v1[2] *= bflo(b4.w); v1[3] *= bfhi(b4.w);
                }
        }
    }
    __device__ __forceinline__ void operator()(const AccT& acc, const Unit& u, int wr, int wc, int fr, int fq) const {
        const int nb = 256 * u.pn + 32 * wc + 8 * fq;
#pragma unroll
        for (int ai = 0; ai < 2; ++ai) {
            const size_t rb = (size_t)(256 * u.pm + 128 * ai + 64 * wr + fr) * 1024 + nb;
            uint4 gr[4][2];
#pragma unroll
            for (int mm = 0; mm < 4; ++mm)
#pragma unroll
                for (int bj = 0; bj < 2; ++bj) gr[mm][bj] = *(const uint4*)(GA + rb + (size_t)mm * 16 * 1024 + 128 * bj);
#pragma unroll
            for (int mm = 0; mm < 4; ++mm)
#pragma unroll
                for (int bj = 0; bj < 2; ++bj) {
                    const uint4 g4 = gr[mm][bj]; const f32x4 v0 = acc[ai][bj][mm][0], v1 = acc[ai][bj][mm][1];
                    uint4 o;
                    o.x = pk2(bflo(g4.x) * v0[0], bfhi(g4.x) * v0[1]); o.y = pk2(bflo(g4.y) * v0[2], bfhi(g4.y) * v0[3]);
                    o.z = pk2(bflo(g4.z) * v1[0], bfhi(g4.z) * v1[1]); o.w = pk2(bflo(g4.w) * v1[2], bfhi(g4.w) * v1[3]);
                    *(uint4*)(H + rb + (size_t)mm * 16 * 1024 + 128 * bj) = o;
                }
        }
    }
};
__device__ __forceinline__ void phase10(const Params& P, PG8_LAS unsigned char* lds) {
    GemmD g{}; g.A = (const bf16_t*)(P.ws + OFF_YB); g.Bt = (const bf16_t*)(P.ws + OFF_WGLO); g.A2 = (const bf16_t*)(P.ws + OFF_U); g.Bt2 = (const bf16_t*)(P.ws + OFF_WS5O); g.dual = 1;
    g.lda = 512; g.ldb = 512; g.K = 512; g.nM = NL >> 8; g.nN = 4; g.nG = 1;
    EpiMerge E; E.GA = (const bf16_t*)P.out; E.GB = E.GA + (size_t)NL * 1024; E.H = (bf16_t*)(P.ws + OFF_H);
    pg8::gemm_phase(lds, g, E);
}
__device__ __forceinline__ void phase11(const Params& P, PG8_LAS unsigned char* lds) {
    GemmD g{}; g.A = (const bf16_t*)(P.ws + OFF_H); g.Bt = (const bf16_t*)(P.ws + OFF_WWO); g.lda = 1024; g.ldb = 1024; g.K = 1024; g.nM = NL >> 8; g.nN = 4; g.nG = 1;
    EpiRes<1> E; E.x = nullptr; E.XRb = (bf16_t*)(P.ws + OFF_XR); E.out = nullptr; E.Hn = (bf16_t*)P.out; E.mod = (const float*)(P.ws + OFF_MOD);
    E.gnext = P.in[28]; E.ss = (float*)(P.ws + OFF_SS) + NT;
    pg8::gemm_phase(lds, g, E);
}

__device__ __forceinline__ void phase_ffn_up13(const Params& P, PG8_LAS unsigned char* lds) {
    GemmD g{}; g.A = (const bf16_t*)P.out; g.Bt = (const bf16_t*)(P.ws + OFF_WGU2); g.lda = 1024; g.ldb = 1024; g.K = 1024; g.nM = NL >> 8; g.nN = 22; g.nG = 1;
    EpiFfnUp<1> E; E.HID = (bf16_t*)(P.ws + OFF_HID); E.ss = (const float*)(P.ws + OFF_SS) + NT; E.BW = (const float*)(P.ws + OFF_BW) + 5 * 4352;
    pg8::gemm_phase(lds, g, E);
}

#define XB_TMO      128
#define XB_XCNT(j)  (256  + 64 * (j))
#define XB_XSUB(j)  (1280 + 64 * (j))
#define XB_XGEN(j)  (2304 + 64 * (j))
#define XB_TOP      3328
#define XB_TOPGEN   3392
#define XCD_BAR_WORDS 3456
#define XB_SPIN_CAP (1u << 18)
#define LAS3 __attribute__((address_space(3)))
__device__ __forceinline__ unsigned xb_ld(unsigned* p)              { return __hip_atomic_load(p, __ATOMIC_RELAXED, __HIP_MEMORY_SCOPE_AGENT); }
__device__ __forceinline__ unsigned xb_add(unsigned* p, unsigned v) { return __hip_atomic_fetch_add(p, v, __ATOMIC_RELAXED, __HIP_MEMORY_SCOPE_AGENT); }
__device__ __forceinline__ unsigned xb_xcc_id() { return (unsigned)__builtin_amdgcn_s_getreg((3 << 11) | 20) & 0xFu; }
#define XB_SPIN(cond, bar) do { unsigned _sp = 0; while (cond) { __builtin_amdgcn_s_sleep(1); \
    if ((++_sp & 255u) == 0u) { if (xb_ld(&(bar)[XB_TMO])) break; if (_sp > XB_SPIN_CAP) { atomicAdd(&(bar)[XB_TMO], 1u); break; } } } } while (0)
struct XcdBarrier { unsigned* bar; unsigned x; volatile LAS3 unsigned* st; };
__device__ __forceinline__ XcdBarrier xcd_barrier_post(unsigned* bar, volatile LAS3 unsigned* st) {
    XcdBarrier b; b.bar = bar; b.x = xb_xcc_id(); b.st = st;
    if (threadIdx.x == 0) (void)xb_add(&bar[XB_XCNT(b.x)], 1u);
    return b;
}
__device__ __forceinline__ void xcd_barrier_complete(unsigned* bar, unsigned x, unsigned& nloc, unsigned& nx) {
    const unsigned G = gridDim.x * gridDim.y * gridDim.z;
    unsigned sum, cnt, mine, sp = 0u;
    for (;;) {
        sum = 0u; cnt = 0u; mine = 0u;
#pragma unroll
        for (unsigned j = 0; j < 16; ++j) { const unsigned c = xb_ld(&bar[XB_XCNT(j)]); sum += c; cnt += (c > 0u) ? 1u : 0u; mine = (j == x) ? c : mine; }
        if (sum == G) break;
        __builtin_amdgcn_s_sleep(1);
        if ((++sp & 255u) == 0u) { if (xb_ld(&bar[XB_TMO])) break; if (sp > XB_SPIN_CAP) { atomicAdd(&bar[XB_TMO], 1u); break; } }
    }
    nloc = mine > 0u ? mine : 1u; nx = cnt > 0u ? cnt : 1u;
}
__device__ __forceinline__ void xcd_barrier(const XcdBarrier& b) {
    asm volatile("s_waitcnt vmcnt(0)" ::: "memory");
    __syncthreads();
    if (threadIdx.x == 0) {
        unsigned* bar = b.bar;
        __builtin_amdgcn_s_waitcnt(0);
        unsigned nloc = b.st[0], nx = b.st[1];
        if (nloc == 0u) { xcd_barrier_complete(bar, b.x, nloc, nx); b.st[0] = nloc; b.st[1] = nx; }
        const unsigned old = xb_add(&bar[XB_XSUB(b.x)], 1u);
        const unsigned gen = old / nloc;
        if (old + 1u == (gen + 1u) * nloc) {
            __builtin_amdgcn_fence(__ATOMIC_RELEASE, "agent");
            asm volatile("s_waitcnt vmcnt(0)" ::: "memory");
            const unsigned og = xb_add(&bar[XB_TOP], 1u);
            const unsigned tg = og / nx;
            if (og + 1u == (tg + 1u) * nx) xb_add(&bar[XB_TOPGEN], 1u);
            else XB_SPIN(xb_ld(&bar[XB_TOPGEN]) == tg, bar);
            __builtin_amdgcn_fence(__ATOMIC_ACQUIRE, "agent");
            xb_add(&bar[XB_XGEN(b.x)], 1u);
            asm volatile("s_waitcnt vmcnt(0)" ::: "memory");
        } else {
            XB_SPIN(xb_ld(&bar[XB_XGEN(b.x)]) == gen, bar);
            __builtin_amdgcn_fence(__ATOMIC_ACQUIRE, "agent");
            asm volatile("s_waitcnt vmcnt(0)" ::: "memory");
        }
    }
    __syncthreads();
}

__global__ void __launch_bounds__(512, 2) mega(Params P) {
    extern __shared__ __attribute__((aligned(16))) unsigned char smem[];
    cg::grid_group grid = cg::this_grid();
    PG8_LAS unsigned char* lds = (PG8_LAS unsigned char*)smem;
    __shared__ uint4 xb_words;
    unsigned* bar = (unsigned*)(P.ws + OFF_BAR);
    if (threadIdx.x == 0) xb_words = make_uint4(0u, 0u, 0u, 0u);
    if (blockIdx.x == 0 && P.ph_lo == 0) { for (int i = threadIdx.x; i < XCD_BAR_WORDS; i += NTHR) bar[i] = 0u; }
    __syncthreads();
    XcdBarrier xb; xb.bar = bar; xb.x = 0; xb.st = (volatile LAS3 unsigned*)&xb_words;
#ifndef PHMASK
#define PHMASK 0xFFFF
#endif
#define PHOK(n) ((PHMASK >> n) & 1)
#define RUN(n, call) if (PHOK(n) && P.ph_lo <= n && n < P.ph_hi) { call; if (n + 1 < P.ph_hi) { if (n == 0) { grid.sync(); xb = xcd_barrier_post(bar, (volatile LAS3 unsigned*)&xb_words); } else xcd_barrier(xb); } }
    RUN(0, phase0(P, smem))
    RUN(1, phase1(P))
    RUN(2, phase_ffn_up<0>(P, lds, OFF_WGU1, NT))
    RUN(3, phase_ffn_down<1>(P, lds, OFF_WDN1))
    RUN(4, phase4(P))
    RUN(5, phase5(P, lds))
    RUN(6, phase6(P, smem))
    RUN(7, phase7(P))
    RUN(8, phase8(P, smem))
    RUN(9, phase9(P, lds))
    RUN(10, phase10(P, lds))
    RUN(11, phase11(P, lds))
    RUN(13, phase_ffn_up13(P, lds))
    RUN(14, phase_ffn_down<0>(P, lds, OFF_WDN2))
    RUN(15, phase15(P))
}

extern "C" void kernel_launch(void* const* d_in, const int* in_sizes, int n_in, void* d_out, int out_size, void* d_ws, size_t ws_size, hipStream_t stream) {
    static int grid_blocks = 0;
    if (grid_blocks == 0) {
        if (n_in != 33 || ws_size < WS_END) { fprintf(stderr, "kernel_launch: unexpected n_in %d / ws_size %zu (need %zu)\n", n_in, ws_size, (size_t)WS_END); grid_blocks = -1; return; }
        int dev = 0, cus = 0, per_cu = 0;
        hipGetDevice(&dev);
        hipDeviceGetAttribute(&cus, hipDeviceAttributeMultiprocessorCount, dev);
        hipFuncSetAttribute((const void*)mega, hipFuncAttributeMaxDynamicSharedMemorySize, LDS_BYTES);
        hipOccupancyMaxActiveBlocksPerMultiprocessor(&per_cu, (const void*)mega, NTHR, LDS_BYTES);
        if (per_cu < 1) per_cu = 1;
        if (per_cu > 1) per_cu = 1;
        grid_blocks = cus * per_cu;
        fprintf(stderr, "kernel_launch: cus %d per_cu %d grid %d\n", cus, per_cu, grid_blocks);
    }
    if (grid_blocks < 0) return;
    Params p{};
    for (int i = 0; i < 33; ++i) p.in[i] = (const float*)d_in[i];
    p.out = (float*)d_out; p.ws = (unsigned char*)d_ws;
#if N_LAUNCH_PER_PHASE
    for (int ph = 0; ph < NPHASE; ++ph) {
        p.ph_lo = ph; p.ph_hi = ph + 1;
        void* args[] = {&p};
        hipError_t e = hipLaunchCooperativeKernel((const void*)mega, dim3(grid_blocks), dim3(NTHR), args, LDS_BYTES, stream);
        if (e != hipSuccess) { fprintf(stderr, "cooperative launch failed: %s\n", hipGetErrorString(e)); break; }
    }
#else
    p.ph_lo = 0; p.ph_hi = NPHASE;
    void* args[] = {&p};
    hipError_t e = hipLaunchCooperativeKernel((const void*)mega, dim3(grid_blocks), dim3(NTHR), args, LDS_BYTES, stream);
    if (e != hipSuccess) fprintf(stderr, "cooperative launch failed: %s\n", hipGetErrorString(e));
#endif
}
```

```cpp
#include <hip/hip_runtime.h>
#include <hip/hip_cooperative_groups.h>
#include <cstdio>
namespace cg = cooperative_groups;

#ifndef N_LAUNCH_PER_PHASE
#define N_LAUNCH_PER_PHASE 0
#endif

typedef unsigned short bf16_t;
typedef short bf16x8 __attribute__((ext_vector_type(8)));
typedef float f32x4 __attribute__((ext_vector_type(4)));

constexpr int NL = 32768, NC = 1024, NT = 33792, D = 1024, FF = 2816;
constexpr int NPHASE = 16;
constexpr int HALF_LDS = 79872;
constexpr int LDS_BYTES = 2 * HALF_LDS;
constexpr int NTHR = 512;
constexpr int UROWS = 1280;

constexpr size_t SZ_WGU = (size_t)5632 * 1024 * 2, SZ_WDN = (size_t)1024 * 2816 * 2;
constexpr size_t OFF_WGU1 = 0;
constexpr size_t OFF_WDN1 = OFF_WGU1 + SZ_WGU;
constexpr size_t OFF_WGU2 = OFF_WDN1 + SZ_WDN;
constexpr size_t OFF_WDN2 = OFF_WGU2 + SZ_WGU;
constexpr size_t OFF_WIN = OFF_WDN2 + SZ_WDN;
constexpr size_t OFF_WGLU = OFF_WIN + (size_t)4352 * 1024 * 2;
constexpr size_t OFF_WS5O = OFF_WGLU + (size_t)512 * 512 * 2;
constexpr size_t OFF_WGLO = OFF_WS5O + (size_t)1024 * 512 * 2;
constexpr size_t OFF_WWO = OFF_WGLO + (size_t)1024 * 512 * 2;
constexpr size_t OFF_WE = OFF_WWO + (size_t)1024 * 1024 * 2;
constexpr size_t OFF_WY = OFF_WE + (size_t)32 * 256 * 512 * 2;
constexpr size_t OFF_KD = OFF_WY + (size_t)32 * 512 * 768 * 2;
constexpr size_t OFF_LP = OFF_KD + (size_t)2 * 32 * 32 * 256 * 4;
constexpr size_t OFF_BB = OFF_LP + (size_t)2 * 32 * 33 * 64 * 8;
constexpr size_t OFF_MOD = OFF_BB + (size_t)2 * 32 * 64 * 16 * 8;
constexpr size_t OFF_DEC = OFF_MOD + (size_t)5 * 9216 * 4;
constexpr size_t OFF_H = OFF_DEC + (size_t)4224 * 64 * 4;
constexpr size_t OFF_HID = OFF_H + (size_t)NT * 1024 * 2;
constexpr size_t OFF_U = OFF_HID;
constexpr size_t OFF_Q = OFF_U + (size_t)32 * UROWS * 768 * 2;
constexpr size_t OFF_K = OFF_Q + (size_t)NT * 256 * 2;
constexpr size_t OFF_V = OFF_K + (size_t)NT * 256 * 2;
constexpr size_t OFF_R = OFF_V + (size_t)NT * 512 * 2;
constexpr size_t OFF_GLR = OFF_R + (size_t)NT * 512 * 2;
constexpr size_t OFF_XR = OFF_HID + (size_t)NT * 2816 * 2;
constexpr size_t OFF_YB = OFF_XR + (size_t)NT * 1024 * 2;
constexpr size_t OFF_E = OFF_XR + (size_t)NT * 1024 * 4;
constexpr size_t OFF_BAR = OFF_E + (size_t)32 * 1056 * 256 * 4;
constexpr size_t OFF_SS = OFF_BAR + 16384;
constexpr size_t OFF_BW = OFF_SS + 401408;
constexpr size_t WS_END = OFF_BW + 204800;
static_assert(WS_END <= (size_t)536870912, "workspace");
static_assert(OFF_GLR + (size_t)NT * 32 * 2 <= OFF_XR, "alias overflow");

struct Params { const float* in[33]; float* out; unsigned char* ws; int ph_lo, ph_hi; };

typedef float f32x2_t __attribute__((ext_vector_type(2)));
typedef __bf16 bf16x2_t __attribute__((ext_vector_type(2)));
__device__ __forceinline__ unsigned pk2(float a, float b) { const f32x2_t v = {a, b}; const bf16x2_t r = __builtin_convertvector(v, bf16x2_t); return __builtin_bit_cast(unsigned, r); }
__device__ __forceinline__ bf16_t f2bf(float f) { return (bf16_t)(pk2(f, f) & 0xffffu); }
__device__ __forceinline__ float bf2f(bf16_t h) { return __uint_as_float(((unsigned)h) << 16); }
__device__ __forceinline__ float bflo(unsigned u) { return __uint_as_float(u << 16); }
__device__ __forceinline__ float bfhi(unsigned u) { return __uint_as_float(u & 0xffff0000u); }
__device__ __forceinline__ float rcpf_(float x) { return __builtin_amdgcn_rcpf(x); }
__device__ __forceinline__ float sigm(float x) { return rcpf_(1.f + __expf(-x)); }
__device__ __forceinline__ float siluf_(float x) { return x * sigm(x); }
__device__ __forceinline__ float gelu_tanh(float x) { float y = 0.7978845608028654f * (x + 0.044715f * x * x * x); float t = 1.f - 2.f * rcpf_(1.f + __expf(2.f * y)); return 0.5f * x * (1.f + t); }
__device__ __forceinline__ float wave_sum(float v) {
#pragma unroll
    for (int o = 1; o < 64; o <<= 1) v += __shfl_xor(v, o);
    return v;
}
__device__ __forceinline__ void store_bf4(bf16_t* p, f32x4 v) { uint2 o; o.x = pk2(v[0], v[1]); o.y = pk2(v[2], v[3]); *(uint2*)p = o; }
__device__ __forceinline__ f32x4 load_bf4(const bf16_t* p) { uint2 u = *(const uint2*)p; f32x4 v; v[0] = bflo(u.x); v[1] = bfhi(u.x); v[2] = bflo(u.y); v[3] = bfhi(u.y); return v; }

constexpr int LROW = 72;
namespace pg8 {
#define PG8_LAS __attribute__((address_space(3)))
constexpr int BM = 256, BK = 64, HALF = 128, HTB = HALF * BK * 2, STAGE_BYTES = 8 * HTB;
__device__ __forceinline__ int lds_byte(int r, int c) { const int st = (r >> 4) * 2 + (c >> 5), rr = r & 15, cc = c & 31, ob = rr * 64 + cc * 2; return st * 1024 + (ob ^ (((ob >> 9) & 1) << 5)); }
__device__ __forceinline__ void stage_rc(int b, int& R, int& C) { const int st = b / 1024, sb = b % 1024, swz = sb ^ (((sb >> 9) & 1) << 5); R = (st >> 1) * 16 + swz / 64; C = (st & 1) * 32 + (swz % 64) / 2; }
struct Unit { int pm, pn, g, part; };
struct GemmD { const bf16_t* A; const bf16_t* Bt; int lda, ldb, K, nM, nN, nG; size_t gsA, gsB; int permA; const bf16_t* A2; const bf16_t* Bt2; int dual; };
__device__ __forceinline__ int perm32(int rho) { const int n = rho >> 4, i = rho & 15; return 8 * (i >> 2) + 4 * n + (i & 3); }
struct EpiNoMid { static constexpr bool PERM = false; __device__ __forceinline__ void mid(f32x4 (&)[2][2][4][2], const Unit&, int, int, int, int) const {} };
__device__ __forceinline__ bool unit_at(const GemmD& d, int i, Unit& u) {
    const long L = (long)(d.dual ? (i >> 1) : i) * gridDim.x + blockIdx.x; const int per = d.nM * d.nN;
    u.part = d.dual ? (i & 1) : 0;
    if (L >= (long)per * d.nG) return false;
    if (d.nG == 1) {
        int wgid = (int)L; const int nwg = per;
        { const int q = nwg / 8, r = nwg % 8, xcd = wgid % 8, off = wgid / 8; wgid = (xcd < r ? xcd * (q + 1) : r * (q + 1) + (xcd - r) * q) + off; }
        const int nig = 8 * d.nN, gid = wgid / nig, fm = gid * 8, gsz = (d.nM - fm) < 8 ? (d.nM - fm) : 8;
        u.pm = fm + ((wgid % nig) % gsz); u.pn = (wgid % nig) / gsz; u.g = 0;
    } else if ((d.nG & 7) == 0) {
        const int x = (int)(L & 7), j = (int)(L >> 3), gpx = d.nG >> 3;
        u.g = x * gpx + j / per; const int w = j % per; u.pm = w / d.nN; u.pn = w % d.nN;
    } else { u.g = (int)(L / per); const int w = (int)(L % per); u.pm = w / d.nN; u.pn = w % d.nN; }
    return true;
}
__device__ __forceinline__ const char* a_base(const GemmD& d, const Unit& u) {
    const size_t row0 = d.permA ? (size_t)(((u.pm >> 5) << 13) + 4 * (u.pm & 31)) : (size_t)u.pm * 256;
    return (const char*)(((d.dual && u.part) ? d.A2 : d.A) + (size_t)u.g * d.gsA + row0 * d.lda);
}
__device__ __forceinline__ const char* b_base(const GemmD& d, const Unit& u) { return (const char*)(((d.dual && u.part) ? d.Bt2 : d.Bt) + (size_t)u.g * d.gsB + (size_t)u.pn * 256 * d.ldb); }

template <class Epi>
__device__ __forceinline__ void gemm_phase(PG8_LAS unsigned char* lds, const GemmD g, const Epi& E) {
    const int tid = threadIdx.x, wid = __builtin_amdgcn_readfirstlane(tid >> 6), lane = tid & 63, wr = wid >> 2, wc = wid & 3, fr = lane & 15, fq = lane >> 4;
    const int K = g.K, nt = K / BK;
    unsigned voffA[2], voffB[2];
#pragma unroll
    for (int i = 0; i < 2; ++i) { int R, C; stage_rc(tid * 16 + i * 8192, R, C);
        const int Ra = g.permA ? (((R & 63) << 7) + (R >> 6)) : R;
        const int Rb = Epi::PERM ? ((R & ~31) + perm32(R & 31)) : R;
        voffA[i] = (unsigned)(Ra * g.lda + C) * 2u; voffB[i] = (unsigned)(Rb * g.ldb + C) * 2u; }
    const size_t kstep = (size_t)(BK * 2);
    const size_t hstepA = g.permA ? (size_t)2 * g.lda * 2 : (size_t)HALF * g.lda * 2;
    const size_t hstepB = (size_t)HALF * g.ldb * 2;
    const unsigned ldsw = (unsigned)wid * 1024u;
    const int aoff = lds_byte(wr * 64 + fr, fq * 8), boff = lds_byte(wc * 32 + fr, fq * 8);
#define PG8_SA(b, h) (((b) * 2 + (h)) * HTB)
#define PG8_SB(b, h) ((4 + (b) * 2 + (h)) * HTB)
#define PG8_STAGE(bufoff, gbase, voff) do { _Pragma("unroll") for (int _i = 0; _i < 2; ++_i) \
        __builtin_amdgcn_global_load_lds((const unsigned*)((const char*)(gbase) + (voff)[_i]), (PG8_LAS unsigned*)(lds + (bufoff) + ldsw + _i * 8192), 16, 0, 0); } while (0)
#define PG8_LDA(dst, b, h) do { _Pragma("unroll") for (int m = 0; m < 4; ++m) _Pragma("unroll") for (int k = 0; k < 2; ++k) dst[m][k] = *(const PG8_LAS bf16x8*)(lds + PG8_SA(b, h) + aoff + m * 2048 + k * 1024); } while (0)
#define PG8_LDB(dst, b, h) do { _Pragma("unroll") for (int n = 0; n < 2; ++n) _Pragma("unroll") for (int k = 0; k < 2; ++k) dst[n][k] = *(const PG8_LAS bf16x8*)(lds + PG8_SB(b, h) + boff + n * 2048 + k * 1024); } while (0)
#define PG8_MMA(ai, bj, At, Bt) do { __builtin_amdgcn_s_setprio(1); _Pragma("unroll") for (int m = 0; m < 4; ++m) _Pragma("unroll") for (int n = 0; n < 2; ++n) _Pragma("unroll") for (int k = 0; k < 2; ++k) \
        acc[ai][bj][m][n] = __builtin_amdgcn_mfma_f32_16x16x32_bf16(Bt[n][k], At[m][k], acc[ai][bj][m][n], 0, 0, 0); __builtin_amdgcn_s_setprio(0); } while (0)
#define PG8_WAIT_V(n) asm volatile("s_waitcnt vmcnt(" #n ")" ::: "memory")
#define PG8_WAIT_L(n) asm volatile("s_waitcnt lgkmcnt(" #n ")" ::: "memory")
#define PG8_BAR __builtin_amdgcn_s_barrier()
#define PG8_SCHED __builtin_amdgcn_sched_barrier(0)
    Unit cur, nxt; int ui = 0;
    if (!unit_at(g, 0, cur)) return;
    f32x4 acc[2][2][4][2];
#pragma unroll
    for (int a = 0; a < 2; ++a)
#pragma unroll
        for (int b = 0; b < 2; ++b)
#pragma unroll
            for (int m = 0; m < 4; ++m)
#pragma unroll
                for (int n = 0; n < 2; ++n) acc[a][b][m][n] = (f32x4){0.f, 0.f, 0.f, 0.f};
    bf16x8 At[4][2], B0[2][2], B1[2][2];
    const char* cA = a_base(g, cur); const char* cB = b_base(g, cur);
    PG8_STAGE(PG8_SB(0, 0), cB, voffB); PG8_STAGE(PG8_SA(0, 0), cA, voffA); PG8_STAGE(PG8_SB(0, 1), cB + hstepB, voffB); PG8_STAGE(PG8_SA(0, 1), cA + hstepA, voffA);
    if (wr == 1) PG8_BAR;
    PG8_WAIT_V(4); PG8_BAR;
    PG8_STAGE(PG8_SB(1, 0), cB + kstep, voffB); PG8_STAGE(PG8_SA(1, 0), cA + kstep, voffA); PG8_STAGE(PG8_SB(1, 1), cB + hstepB + kstep, voffB);
    PG8_WAIT_V(6); PG8_BAR;
    for (;;) {
        const bool has_next = unit_at(g, ui + 1, nxt);
        const char* nA = has_next ? a_base(g, nxt) : cA; const char* nB = has_next ? b_base(g, nxt) : cB;
        for (int t = 0; t < nt; t += 2) {
            const bool last = (t == nt - 2);
            const char* a1 = cA + (size_t)(t + 1) * kstep;
            const char* a2 = last ? nA : cA + (size_t)(t + 2) * kstep; const char* b2 = last ? nB : cB + (size_t)(t + 2) * kstep;
            const char* a3 = a2 + kstep; const char* b3 = b2 + kstep;
            PG8_LDB(B0, 0, 0); PG8_SCHED; PG8_LDA(At, 0, 0); PG8_STAGE(PG8_SA(1, 1), a1 + hstepA, voffA);
            PG8_WAIT_L(8); PG8_BAR; PG8_WAIT_L(0); PG8_MMA(0, 0, At, B0); PG8_BAR; PG8_SCHED;
            PG8_LDB(B1, 0, 1); PG8_STAGE(PG8_SB(0, 0), b2, voffB);
            PG8_BAR; PG8_WAIT_L(0); PG8_MMA(0, 1, At, B1); PG8_BAR;
            PG8_LDA(At, 0, 1); PG8_STAGE(PG8_SA(0, 0), a2, voffA);
            PG8_BAR; PG8_WAIT_L(0); PG8_MMA(1, 0, At, B0); PG8_BAR; PG8_SCHED;
            PG8_STAGE(PG8_SB(0, 1), b2 + hstepB, voffB);
            PG8_WAIT_V(6); PG8_BAR; PG8_MMA(1, 1, At, B1); PG8_BAR;
            PG8_LDB(B0, 1, 0); PG8_SCHED; PG8_LDA(At, 1, 0); PG8_STAGE(PG8_SA(0, 1), a2 + hstepA, voffA);
            PG8_WAIT_L(8); PG8_BAR; PG8_WAIT_L(0); PG8_MMA(0, 0, At, B0); PG8_BAR; PG8_SCHED;
            PG8_LDB(B1, 1, 1); PG8_STAGE(PG8_SB(1, 0), b3, voffB);
            PG8_BAR; PG8_WAIT_L(0); PG8_MMA(0, 1, At, B1); PG8_BAR;
            PG8_LDA(At, 1, 1); PG8_STAGE(PG8_SA(1, 0), a3, voffA);
            PG8_BAR; PG8_WAIT_L(0); PG8_MMA(1, 0, At, B0); PG8_BAR; PG8_SCHED;
            PG8_STAGE(PG8_SB(1, 1), b3 + hstepB, voffB);
            PG8_WAIT_V(6); PG8_BAR; PG8_MMA(1, 1, At, B1); PG8_BAR;
        }
        const bool midp = g.dual && cur.part == 0;
        if (midp) E.mid(acc, cur, wr, wc, fr, fq); else E(acc, cur, wr, wc, fr, fq);
        if (!has_next) break;
        if (!midp)
#pragma unroll
        for (int a = 0; a < 2; ++a)
#pragma unroll
            for (int b = 0; b < 2; ++b)
#pragma unroll
                for (int m = 0; m < 4; ++m)
#pragma unroll
                    for (int n = 0; n < 2; ++n) acc[a][b][m][n] = (f32x4){0.f, 0.f, 0.f, 0.f};
        cur = nxt; cA = nA; cB = nB; ++ui;
    }
    PG8_WAIT_V(0);
    if (wr == 0) PG8_BAR;
    PG8_BAR;
#undef PG8_SA
#undef PG8_SB
#undef PG8_STAGE
#undef PG8_LDA
#undef PG8_LDB
#undef PG8_MMA
#undef PG8_WAIT_V
#undef PG8_WAIT_L
#undef PG8_BAR
#undef PG8_SCHED
}
}
using pg8::Unit; using pg8::GemmD;
typedef f32x4 AccT[2][2][4][2];
#define EPI_LOOP _Pragma("unroll") for (int ai = 0; ai < 2; ++ai) _Pragma("unroll") for (int bj = 0; bj < 2; ++bj) _Pragma("unroll") for (int mm = 0; mm < 4; ++mm) _Pragma("unroll") for (int nn = 0; nn < 2; ++nn) { \
    const int m = 256 * u.pm + 128 * ai + 64 * wr + 16 * mm + fr; const int n = 256 * u.pn + 128 * bj + 32 * wc + 16 * nn + 4 * fq; const f32x4 v = acc[ai][bj][mm][nn];
#define EPI_LOOP_END }
#define EPI_LOOP_NV _Pragma("unroll") for (int ai = 0; ai < 2; ++ai) _Pragma("unroll") for (int bj = 0; bj < 2; ++bj) _Pragma("unroll") for (int mm = 0; mm < 4; ++mm) _Pragma("unroll") for (int nn = 0; nn < 2; ++nn) { \
    const int m = 256 * u.pm + 128 * ai + 64 * wr + 16 * mm + fr; const int n = 256 * u.pn + 128 * bj + 32 * wc + 16 * nn + 4 * fq;

__device__ __forceinline__ int map_row(int mode, int n) {
    if (mode == 1) return ((n >> 7) << 8) + (n & 127);
    if (mode == 2) return ((n >> 7) << 8) + 128 + (n & 127);
    if (mode == 3) {
        if (n < 2048) return n;
        if (n < 2080) return 4096 + (n - 2048);
        if (n < 3104) { const int j = n - 2080; return 2048 + ((j >> 4) << 5) + (((j >> 2) & 3) << 3) + (j & 3); }
        { const int j = n - 3104; return 2048 + ((j >> 4) << 5) + (((j >> 2) & 3) << 3) + 4 + (j & 3); }
    }
    return n;
}
struct TItem { const float* src; bf16_t* dst; int K, mode, n0; };
__device__ __forceinline__ void transpose_load(const TItem& t, int N, float (&v)[8]) {
#pragma unroll
    for (int i = 0; i < 8; ++i) v[i] = t.src[(size_t)(8 * i) * N];
}
__device__ __forceinline__ void transpose_store(const TItem& t, const float (&v)[8], float* scr) {
    const int tid = threadIdx.x & 255;
#pragma unroll
    for (int i = 0; i < 8; ++i) scr[((tid >> 5) + 8 * i) * 33 + (tid & 31)] = v[i];
    __syncthreads();
    const int n = tid >> 3, kc = (tid & 7) * 8;
    const float* s = scr + kc * 33 + n;
    uint4 o; o.x = pk2(s[0], s[33]); o.y = pk2(s[66], s[99]); o.z = pk2(s[132], s[165]); o.w = pk2(s[198], s[231]);
    const int nd = map_row(t.mode, t.n0 + n);
    *(uint4*)(t.dst + (size_t)nd * t.K) = o;
    __syncthreads();
}
__device__ __forceinline__ void ada_item(const Params& P, int item, float* sm) {
    float* sv = sm; float* red = sm + 5 * 1024;
    const int tid = threadIdx.x & 255;
    for (int e = tid; e < 5 * 1024; e += 256) { const int r = e >> 10, k = e & 1023; const float c = r < 4 ? P.in[1][r * 1024 + k] : P.in[3][k]; sv[e] = siluf_(c); }
    __syncthreads();
    const int cgp = tid & 15, kg = tid >> 4, n0 = item * 64;
    f32x4 a[5];
#pragma unroll
    for (int r = 0; r < 5; ++r) a[r] = (f32x4){0.f, 0.f, 0.f, 0.f};
    const float* wp = P.in[4] + (size_t)(kg * 64) * 9216 + n0 + cgp * 4;
#pragma unroll 16
    for (int kk = 0; kk < 64; ++kk) {
        const f32x4 w4 = *(const f32x4*)(wp + (size_t)kk * 9216);
#pragma unroll
        for (int r = 0; r < 5; ++r) { const float s = sv[r * 1024 + kg * 64 + kk]; a[r] += w4 * s; }
    }
#pragma unroll
    for (int r = 0; r < 5; ++r) *(f32x4*)(red + (kg * 5 + r) * 64 + cgp * 4) = a[r];
    __syncthreads();
    for (int e = tid; e < 320; e += 256) {
        const int r = e >> 6, col = e & 63; float s = P.in[5][n0 + col];
#pragma unroll
        for (int g = 0; g < 16; ++g) s += red[(g * 5 + r) * 64 + col];
        ((float*)(P.ws + OFF_MOD))[r * 9216 + n0 + col] = s;
    }
    __syncthreads();
}

__device__ __forceinline__ float2 cmul(float2 a, float2 b) { return make_float2(a.x * b.x - a.y * b.y, a.x * b.y + a.y * b.x); }

__device__ __forceinline__ void phase0(const Params& P, unsigned char* smem) {
    const int hb = threadIdx.x >> 8;
    float* scr = (float*)(smem + hb * HALF_LDS);
    struct TW { int in; int K, N; size_t off; int mode; };
    const TW tw[13] = {
        {7, 1024, 2816, OFF_WGU1, 1}, {8, 1024, 2816, OFF_WGU1, 2}, {9, 2816, 1024, OFF_WDN1, 0},
        {29, 1024, 2816, OFF_WGU2, 1}, {30, 1024, 2816, OFF_WGU2, 2}, {31, 2816, 1024, OFF_WDN2, 0},
        {11, 1024, 4128, OFF_WIN, 3}, {20, 512, 512, OFF_WGLU, 0}, {22, 512, 1024, OFF_WS5O, 0}, {26, 512, 1024, OFF_WGLO, 0}, {27, 1024, 1024, OFF_WWO, 0},
        {0, 0, 0, 0, 0}, {0, 0, 0, 0, 0}};
    int total = 0;
#pragma unroll
    for (int i = 0; i < 11; ++i) total += (tw[i].K >> 6) * (tw[i].N >> 5);
    const int n_ada = 144;
    for (int base = blockIdx.x * 2; base < n_ada; base += gridDim.x * 2) ada_item(P, base + hb, scr);
    auto lookup = [&](int it, TItem& t, int& N) {
        int r = it < total ? it : total - 1;
        t.src = nullptr; t.dst = nullptr; t.K = 0; t.mode = 0; t.n0 = 0; N = 0;
#pragma unroll
        for (int i = 0; i < 11; ++i) {
            const int cnt = (tw[i].K >> 6) * (tw[i].N >> 5);
            if (r >= 0 && r < cnt) {
                const int nblk = tw[i].N >> 5, kb = r / nblk, nb = r - kb * nblk, k0 = kb * 64, n0 = nb * 32, tid = threadIdx.x & 255;
                N = tw[i].N; t.K = tw[i].K; t.mode = tw[i].mode; t.n0 = n0;
                t.src = P.in[tw[i].in] + (size_t)(k0 + (tid >> 5)) * tw[i].N + n0 + (tid & 31);
                t.dst = (bf16_t*)(P.ws + tw[i].off) + k0 + (tid & 7) * 8;
            }
            r -= cnt;
        }
    };
    {
        const int stride = gridDim.x * 2;
        int it = blockIdx.x * 2 + hb;
        TItem cur, nxt; int Nc = 0, Nn = 0; float vn[8];
        if (blockIdx.x * 2 < total) { lookup(it, nxt, Nn); transpose_load(nxt, Nn, vn); }
        for (int base = blockIdx.x * 2; base < total; base += stride) {
            float v[8];
#pragma unroll
            for (int i = 0; i < 8; ++i) v[i] = vn[i];
            cur = nxt; Nc = Nn;
            if (base + stride < total) { lookup(it + stride, nxt, Nn); transpose_load(nxt, Nn, vn); }
            transpose_store(cur, v, scr);
            it += stride;
        }
    }
    const int gtid = blockIdx.x * NTHR + threadIdx.x, gsz = gridDim.x * NTHR;
    for (int e = gtid; e < NT + 2 * NL; e += gsz) ((float*)(P.ws + OFF_SS))[e] = 0.f;
    float2* LP = (float2*)(P.ws + OFF_LP); float2* BB = (float2*)(P.ws + OFF_BB);
    for (int e = gtid; e < 2 * 32 * 33 * 64; e += gsz) {
        const int p = e & 63, tau = (e >> 6) % 33, dg = e / (33 * 64);
        const float lre = fminf(P.in[12][dg * 64 + p], -1e-4f), lim = P.in[13][dg * 64 + p], dt = expf(P.in[14][dg]);
        const float mag = expf(lre * dt * (float)tau), ang = (lim * dt) * (float)tau;
        float sn, cs; sincosf(ang, &sn, &cs);
        LP[e] = make_float2(mag * cs, mag * sn);
    }
    for (int e = gtid; e < 2 * 32 * 64 * 16; e += gsz) {
        const int dgp = e >> 4;
        const int dg = dgp >> 6;
        const float lre = fminf(P.in[12][dgp], -1e-4f), lim = P.in[13][dgp], dt = expf(P.in[14][dg]);
        const float mag = expf(lre * dt), ang = lim * dt;
        float sn, cs; sincosf(ang, &sn, &cs);
        const float ar = mag * cs - 1.f, ai = mag * sn;
        const float den = lre * lre + lim * lim;
        const float qr = (ar * lre + ai * lim) / den, qi = (ai * lre - ar * lim) / den;
        BB[e] = cmul(make_float2(qr, qi), make_float2(P.in[15][e], P.in[16][e]));
    }
}

__device__ __forceinline__ void norm_row_pre(const f32x4 (&v)[4], const float* __restrict__ g, const float* __restrict__ shift, const float* __restrict__ scale, bf16_t* __restrict__ dst, int lane) {
    float ss = 0.f;
#pragma unroll
    for (int j = 0; j < 4; ++j) ss += v[j][0] * v[j][0] + v[j][1] * v[j][1] + v[j][2] * v[j][2] + v[j][3] * v[j][3];
    ss = wave_sum(ss);
    const float rstd = rsqrtf(ss * (1.f / 1024.f) + 1e-6f);
#pragma unroll
    for (int j = 0; j < 4; ++j) {
        const int c4 = lane + 64 * j;
        const f32x4 g4 = ((const f32x4*)g)[c4], sh = ((const f32x4*)shift)[c4], sc = ((const f32x4*)scale)[c4];
        f32x4 h = (v[j] * rstd) * g4; h = h * (sc + 1.f) + sh;
        store_bf4(dst + c4 * 4, h);
    }
}
__device__ __forceinline__ void norm_row(const float* __restrict__ src, const float* __restrict__ g, const float* __restrict__ shift, const float* __restrict__ scale, bf16_t* __restrict__ dst, int lane) {
    f32x4 v[4]; float ss = 0.f;
#pragma unroll
    for (int j = 0; j < 4; ++j) { v[j] = ((const f32x4*)src)[lane + 64 * j]; ss += v[j][0] * v[j][0] + v[j][1] * v[j][1] + v[j][2] * v[j][2] + v[j][3] * v[j][3]; }
    ss = wave_sum(ss);
    const float rstd = rsqrtf(ss * (1.f / 1024.f) + 1e-6f);
#pragma unroll
    for (int j = 0; j < 4; ++j) {
        const int c4 = lane + 64 * j;
        const f32x4 g4 = ((const f32x4*)g)[c4], sh = ((const f32x4*)shift)[c4], sc = ((const f32x4*)scale)[c4];
        f32x4 h = (v[j] * rstd) * g4; h = h * (sc + 1.f) + sh;
        store_bf4(dst + c4 * 4, h);
    }
}

__device__ __forceinline__ void phase1(const Params& P) {
    const int lane = threadIdx.x & 63, w = threadIdx.x >> 6;
    const float* mod = (const float*)(P.ws + OFF_MOD);
    bf16_t* H = (bf16_t*)(P.ws + OFF_H);
    {
        const int stride = gridDim.x * 8;
        int row = blockIdx.x * 8 + w;
        f32x4 vn[4];
        if (row < NT) { const float* src = row < NL ? P.in[0] + (size_t)row * 1024 : P.in[2] + (size_t)(row - NL) * 1024;
#pragma unroll
            for (int j = 0; j < 4; ++j) vn[j] = ((const f32x4*)src)[lane + 64 * j]; }
        while (row < NT) {
            f32x4 v[4];
#pragma unroll
            for (int j = 0; j < 4; ++j) v[j] = vn[j];
            const int nrow = row + stride;
            if (nrow < NT) { const float* src = nrow < NL ? P.in[0] + (size_t)nrow * 1024 : P.in[2] + (size_t)(nrow - NL) * 1024;
#pragma unroll
                for (int j = 0; j < 4; ++j) vn[j] = ((const f32x4*)src)[lane + 64 * j]; }
            const int mr = row < NL ? (row >> 13) : 4;
            norm_row_pre(v, P.in[6], mod + mr * 9216 + 0, mod + mr * 9216 + 1024, H + (size_t)row * 1024, lane);
            if (row >= NL) {
#pragma unroll
                for (int j = 0; j < 4; ++j) ((f32x4*)((float*)(P.ws + OFF_E) + (size_t)(row - NL) * 1024))[lane + 64 * j] = v[j];
            }
            row = nrow;
        }
    }
    for (int r0 = blockIdx.x * 32 + w * 4; r0 < 4352 + 5632; r0 += gridDim.x * 32)
    for (int r = r0; r < r0 + 4; ++r) {
        const bool first = r < 4352;
        const bf16_t* wt = first ? (const bf16_t*)(P.ws + OFF_WIN) + (size_t)r * 1024 : (const bf16_t*)(P.ws + OFF_WGU2) + (size_t)(r - 4352) * 1024;
        const float* sh = mod + (first ? 3 : 6) * 1024 + lane * 16;
        const uint4 w0 = *(const uint4*)(wt + lane * 16), w1 = *(const uint4*)(wt + lane * 16 + 8);
        const float wv[16] = {bflo(w0.x), bfhi(w0.x), bflo(w0.y), bfhi(w0.y), bflo(w0.z), bfhi(w0.z), bflo(w0.w), bfhi(w0.w),
                              bflo(w1.x), bfhi(w1.x), bflo(w1.y), bfhi(w1.y), bflo(w1.z), bfhi(w1.z), bflo(w1.w), bfhi(w1.w)};
        float* BW = (float*)(P.ws + OFF_BW);
#pragma unroll
        for (int mr = 0; mr < 5; ++mr) {
            float a = 0.f;
#pragma unroll
            for (int q = 0; q < 4; ++q) { const f32x4 s4 = *(const f32x4*)(sh + mr * 9216 + q * 4); a += s4[0] * wv[q * 4] + s4[1] * wv[q * 4 + 1] + s4[2] * wv[q * 4 + 2] + s4[3] * wv[q * 4 + 3]; }
            a = wave_sum(a);
            if (lane == 0) { if (first) BW[mr * 4352 + r] = a; else BW[5 * 4352 + mr * 5632 + (r - 4352)] = a; }
        }
    }
    const int gtid = blockIdx.x * NTHR + threadIdx.x, gsz = gridDim.x * NTHR;
    const float2* LP = (const float2*)(P.ws + OFF_LP); const float2* BB = (const float2*)(P.ws + OFF_BB);
    float* KD = (float*)(P.ws + OFF_KD);
    {
        constexpr int N = 2 * 32 * 32 * 256;
        int e0 = gtid;
        for (; e0 + 3 * gsz < N; e0 += 4 * gsz) {
            float sacc[4] = {0.f, 0.f, 0.f, 0.f};
#pragma unroll 2
            for (int p = 0; p < 64; ++p) {
#pragma unroll
                for (int q = 0; q < 4; ++q) {
                    const int e = e0 + q * gsz;
                    const int cp = e & 15, c = (e >> 4) & 15, tau = (e >> 8) & 31, dg = e >> 13;
                    const float2 C = make_float2(P.in[17][(dg * 16 + c) * 64 + p], P.in[18][(dg * 16 + c) * 64 + p]);
                    const float2 z = cmul(LP[(dg * 33 + tau) * 64 + p], BB[(dg * 64 + p) * 16 + cp]);
                    sacc[q] += C.x * z.x - C.y * z.y;
                }
            }
#pragma unroll
            for (int q = 0; q < 4; ++q) KD[e0 + q * gsz] = sacc[q];
        }
        for (; e0 < N; e0 += gsz) {
            const int e = e0, cp = e & 15, c = (e >> 4) & 15, tau = (e >> 8) & 31, dg = e >> 13;
            float sa = 0.f;
            for (int p = 0; p < 64; ++p) {
                const float2 C = make_float2(P.in[17][(dg * 16 + c) * 64 + p], P.in[18][(dg * 16 + c) * 64 + p]);
                const float2 z = cmul(LP[(dg * 33 + tau) * 64 + p], BB[(dg * 64 + p) * 16 + cp]);
                sa += C.x * z.x - C.y * z.y;
            }
            KD[e] = sa;
        }
    }
    bf16_t* WE = (bf16_t*)(P.ws + OFF_WE);
    auto we_val = [&](int e) -> float {
        const int k = e & 511, n = (e >> 9) & 255, g = e >> 17;
        const int s = k >> 4, cp = k & 15, d = n >> 7, ri = (n >> 6) & 1, p = n & 63, dg = d * 32 + g;
        const int tau = d == 0 ? 31 - s : s;
        const float2 z = cmul(LP[(dg * 33 + tau) * 64 + p], BB[(dg * 64 + p) * 16 + cp]);
        return ri ? z.y : z.x;
    };
    {
        constexpr int N = 32 * 256 * 512;
        int e0 = gtid;
        for (; e0 + 3 * gsz < N; e0 += 4 * gsz) {
            float val[4];
#pragma unroll
            for (int q = 0; q < 4; ++q) val[q] = we_val(e0 + q * gsz);
#pragma unroll
            for (int q = 0; q < 4; ++q) WE[e0 + q * gsz] = f2bf(val[q]);
        }
        for (; e0 < N; e0 += gsz) WE[e0] = f2bf(we_val(e0));
    }
    bf16_t* WY = (bf16_t*)(P.ws + OFF_WY);
    auto po_val = [&](int e) -> float {
        const int kk = e & 255, n = (e >> 8) & 511, g = e >> 17;
        const int t = n >> 4, c = n & 15, d = kk >> 7, ri = (kk >> 6) & 1, p = kk & 63, dg = d * 32 + g;
        const int tau = d == 0 ? t + 1 : 32 - t;
        const float2 C = make_float2(P.in[17][(dg * 16 + c) * 64 + p], P.in[18][(dg * 16 + c) * 64 + p]);
        const float2 z = cmul(C, LP[(dg * 33 + tau) * 64 + p]);
        return ri ? -z.y : z.x;
    };
    auto po_idx = [&](int e) -> size_t { const int kk = e & 255, n = (e >> 8) & 511, g = e >> 17; return ((size_t)g * 512 + n) * 768 + 512 + kk; };
    {
        constexpr int N = 32 * 512 * 256;
        int e0 = gtid;
        for (; e0 + 3 * gsz < N; e0 += 4 * gsz) {
            float val[4];
#pragma unroll
            for (int q = 0; q < 4; ++q) val[q] = po_val(e0 + q * gsz);
#pragma unroll
            for (int q = 0; q < 4; ++q) WY[po_idx(e0 + q * gsz)] = f2bf(val[q]);
        }
        for (; e0 < N; e0 += gsz) WY[po_idx(e0)] = f2bf(po_val(e0));
    }
}

__device__ __forceinline__ void phase4(const Params& P) {
    const int lane = threadIdx.x & 63, w = threadIdx.x >> 6;
    const float* mod = (const float*)(P.ws + OFF_MOD);
    bf16_t* H = (bf16_t*)(P.ws + OFF_H);
    const float* XRC = (const float*)(P.ws + OFF_E);
    float* ss2 = (float*)(P.ws + OFF_SS);
    for (int r0 = blockIdx.x * 32 + w * 4; r0 < NC; r0 += gridDim.x * 32)
    for (int r = r0; r < r0 + 4; ++r) {
        const float* src = XRC + (size_t)r * 1024;
        float ss = 0.f;
#pragma unroll
        for (int j = 0; j < 4; ++j) {
            const int c4 = lane + 64 * j;
            const f32x4 v = ((const f32x4*)src)[c4];
            ss += v[0] * v[0] + v[1] * v[1] + v[2] * v[2] + v[3] * v[3];
            const f32x4 g4 = ((const f32x4*)P.in[10])[c4], sc = ((const f32x4*)(mod + 4 * 9216 + 4 * 1024))[c4];
            store_bf4(H + (size_t)(NL + r) * 1024 + c4 * 4, v * (g4 * (sc + 1.f)));
        }
        ss = wave_sum(ss);
        if (lane == 0) ss2[NL + r] = ss;
    }
    const int gtid = blockIdx.x * NTHR + threadIdx.x, gsz = gridDim.x * NTHR;
    const float* KD = (const float*)(P.ws + OFF_KD);
    bf16_t* WY = (bf16_t*)(P.ws + OFF_WY);
    auto kf_val = [&](int e) -> float {
        const int k = e & 511, n = (e >> 9) & 511, g = e >> 18;
        const int t = n >> 4, c = n & 15, s = k >> 4, cp = k & 15;
        const int d0 = t - s, d1 = s - t;
        const float a0 = KD[(((0 * 32 + g) * 32 + (d0 > 0 ? d0 : 0)) * 16 + c) * 16 + cp];
        const float a1 = KD[(((1 * 32 + g) * 32 + (d1 > 0 ? d1 : 0)) * 16 + c) * 16 + cp];
        return (s <= t ? a0 : 0.f) + (s >= t ? a1 : 0.f);
    };
    auto kf_idx = [&](int e) -> size_t { const int k = e & 511, n = (e >> 9) & 511, g = e >> 18; return ((size_t)g * 512 + n) * 768 + k; };
    {
        constexpr int N = 32 * 512 * 512;
        int e0 = gtid;
        for (; e0 + 3 * gsz < N; e0 += 4 * gsz) {
            float val[4];
#pragma unroll
            for (int q = 0; q < 4; ++q) val[q] = kf_val(e0 + q * gsz);
#pragma unroll
            for (int q = 0; q < 4; ++q) WY[kf_idx(e0 + q * gsz)] = f2bf(val[q]);
        }
        for (; e0 < N; e0 += gsz) WY[kf_idx(e0)] = f2bf(kf_val(e0));
    }
}

__device__ __forceinline__ void phase15(const Params& P) {
    const int lane = threadIdx.x & 63, w = threadIdx.x >> 6;
    const float* ss4 = (const float*)(P.ws + OFF_SS) + NT + NL;
    const int stride = gridDim.x * 8;
    int row = blockIdx.x * 8 + w;
    f32x4 vn[4]; float sn = 0.f;
    if (row < NL) { sn = ss4[row];
#pragma unroll
        for (int j = 0; j < 4; ++j) vn[j] = ((const f32x4*)(P.out + (size_t)row * 1024))[lane + 64 * j]; }
    f32x4 fn[4];
#pragma unroll
    for (int j = 0; j < 4; ++j) fn[j] = ((const f32x4*)P.in[32])[lane + 64 * j];
    while (row < NL) {
        f32x4 v[4]; const float sc = sn;
#pragma unroll
        for (int j = 0; j < 4; ++j) v[j] = vn[j];
        const int nrow = row + stride;
        if (nrow < NL) { sn = ss4[nrow];
#pragma unroll
            for (int j = 0; j < 4; ++j) vn[j] = ((const f32x4*)(P.out + (size_t)nrow * 1024))[lane + 64 * j]; }
        const float rstd = rsqrtf(sc * (1.f / 1024.f) + 1e-6f);
        f32x4* o = (f32x4*)(P.out + (size_t)row * 1024);
#pragma unroll
        for (int j = 0; j < 4; ++j) o[lane + 64 * j] = (v[j] * rstd) * fn[j];
        row = nrow;
    }
}

template <int NORM> struct EpiFfnUp : pg8::EpiNoMid {
    static constexpr bool PERM = true;
    bf16_t* HID; const float* ss; const float* BW;
    __device__ __forceinline__ void operator()(const AccT& acc, const Unit& u, int wr, int wc, int fr, int fq) const {
        f32x4 bwg[2], bwu[2]; float rstd[2][4];
        if (NORM) {
            const float* bw = BW + ((256 * u.pm) >> 13) * 5632 + 256 * u.pn + 32 * wc + 8 * fq;
#pragma unroll
            for (int nn = 0; nn < 2; ++nn) { bwg[nn] = *(const f32x4*)(bw + 4 * nn); bwu[nn] = *(const f32x4*)(bw + 128 + 4 * nn); }
#pragma unroll
            for (int ai = 0; ai < 2; ++ai)
#pragma unroll
                for (int mm = 0; mm < 4; ++mm) rstd[ai][mm] = rsqrtf(ss[256 * u.pm + 128 * ai + 64 * wr + 16 * mm + fr] * (1.f / 1024.f) + 1e-6f);
        }
        const int oc = 128 * u.pn + 32 * wc + 8 * fq;
#pragma unroll
        for (int ai = 0; ai < 2; ++ai)
#pragma unroll
            for (int mm = 0; mm < 4; ++mm) {
                const int m = 256 * u.pm + 128 * ai + 64 * wr + 16 * mm + fr;
                f32x4 o[2];
#pragma unroll
                for (int nn = 0; nn < 2; ++nn) {
                    f32x4 g = acc[ai][0][mm][nn], uu = acc[ai][1][mm][nn];
                    if (NORM) { g = g * rstd[ai][mm] + bwg[nn]; uu = uu * rstd[ai][mm] + bwu[nn]; }
#pragma unroll
                    for (int r = 0; r < 4; ++r) o[nn][r] = siluf_(g[r]) * uu[r];
                }
                *(uint4*)(HID + (size_t)m * FF + oc) = make_uint4(pk2(o[0][0], o[0][1]), pk2(o[0][2], o[0][3]), pk2(o[1][0], o[1][1]), pk2(o[1][2], o[1][3]));
            }
    }
};
template <int MODE> struct EpiRes : pg8::EpiNoMid {
    static constexpr bool PERM = true;
    const float* x; bf16_t* XRb; float* out; bf16_t* Hn; const float* mod; const float* gnext; float* ss;
    __device__ __forceinline__ void operator()(const AccT& acc, const Unit& u, int wr, int wc, int fr, int fq) const {
        constexpr int GJ = MODE == 0 ? 2 : (MODE == 1 ? 5 : 8), SJ = MODE == 0 ? 4 : 7;
        constexpr float COEF = MODE == 1 ? 1.f : 0.5f;
        const float* mb = mod + ((256 * u.pm) >> 13) * 9216;
        const int nb = 256 * u.pn + 32 * wc + 8 * fq;
        f32x4 gate[2][2]; uint2 gmp[2][2];
#pragma unroll
        for (int bj = 0; bj < 2; ++bj)
#pragma unroll
            for (int nn = 0; nn < 2; ++nn) {
                const int n = nb + 128 * bj + 4 * nn;
                gate[bj][nn] = *(const f32x4*)(mb + GJ * 1024 + n) * COEF;
                if (MODE < 2) { const f32x4 t = *(const f32x4*)(gnext + n) * (*(const f32x4*)(mb + SJ * 1024 + n) + 1.f); gmp[bj][nn] = make_uint2(pk2(t[0], t[1]), pk2(t[2], t[3])); }
            }
#pragma unroll
        for (int ai = 0; ai < 2; ++ai)
#pragma unroll
        for (int mh = 0; mh < 2; ++mh) {
            const size_t rb = (size_t)(256 * u.pm + 128 * ai + 64 * wr + 32 * mh + fr) * 1024 + nb;
            f32x4 xf[MODE == 0 ? 2 : 1][2][2]; uint4 xh[MODE == 0 ? 1 : 2][2];
#pragma unroll
            for (int mm = 0; mm < 2; ++mm)
#pragma unroll
                for (int bj = 0; bj < 2; ++bj) {
                    const size_t idx = rb + (size_t)mm * 16 * 1024 + 128 * bj;
                    if (MODE == 0) { xf[mm][bj][0] = *(const f32x4*)(x + idx); xf[mm][bj][1] = *(const f32x4*)(x + idx + 4); }
                    else xh[mm][bj] = *(const uint4*)(XRb + idx);
                }
#pragma unroll
            for (int mm = 0; mm < 2; ++mm) {
                float part = 0.f;
#pragma unroll
                for (int bj = 0; bj < 2; ++bj) {
                    const size_t idx = rb + (size_t)mm * 16 * 1024 + 128 * bj;
                    f32x4 x0, x1;
                    if (MODE == 0) { x0 = xf[mm][bj][0]; x1 = xf[mm][bj][1]; }
                    else { const uint4 h4 = xh[mm][bj]; x0 = (f32x4){bflo(h4.x), bfhi(h4.x), bflo(h4.y), bfhi(h4.y)}; x1 = (f32x4){bflo(h4.z), bfhi(h4.z), bflo(h4.w), bfhi(h4.w)}; }
                    const f32x4 n0 = x0 + gate[bj][0] * acc[ai][bj][2 * mh + mm][0], n1 = x1 + gate[bj][1] * acc[ai][bj][2 * mh + mm][1];
                    part += (n0[0] * n0[0] + n0[1] * n0[1] + n0[2] * n0[2] + n0[3] * n0[3]) + (n1[0] * n1[0] + n1[1] * n1[1] + n1[2] * n1[2] + n1[3] * n1[3]);
                    if (MODE < 2) {
                        *(uint4*)(XRb + idx) = make_uint4(pk2(n0[0], n0[1]), pk2(n0[2], n0[3]), pk2(n1[0], n1[1]), pk2(n1[2], n1[3]));
                        const f32x4 g0 = {bflo(gmp[bj][0].x), bfhi(gmp[bj][0].x), bflo(gmp[bj][0].y), bfhi(gmp[bj][0].y)}, g1 = {bflo(gmp[bj][1].x), bfhi(gmp[bj][1].x), bflo(gmp[bj][1].y), bfhi(gmp[bj][1].y)};
                        const f32x4 h0 = n0 * g0, h1 = n1 * g1;
                        *(uint4*)(Hn + idx) = make_uint4(pk2(h0[0], h0[1]), pk2(h0[2], h0[3]), pk2(h1[0], h1[1]), pk2(h1[2], h1[3]));
                    } else { *(f32x4*)(out + idx) = n0; *(f32x4*)(out + idx + 4) = n1; }
                }
                part += __shfl_xor(part, 16); part += __shfl_xor(part, 32);
                if (fq == 0) (void)__hip_atomic_fetch_add(ss + 256 * u.pm + 128 * ai + 64 * wr + 32 * mh + 16 * mm + fr, part, __ATOMIC_RELAXED, __HIP_MEMORY_SCOPE_AGENT);
            }
        }
    }
};
template <int NORM>
__device__ __forceinline__ void phase_ffn_up(const Params& P, PG8_LAS unsigned char* lds, size_t off_w, int M) {
    GemmD g{}; g.A = (const bf16_t*)(P.ws + OFF_H); g.Bt = (const bf16_t*)(P.ws + off_w); g.lda = 1024; g.ldb = 1024; g.K = 1024; g.nM = M >> 8; g.nN = 22; g.nG = 1;
    EpiFfnUp<NORM> E; E.HID = (bf16_t*)(P.ws + OFF_HID); E.ss = (const float*)(P.ws + OFF_SS) + NT; E.BW = (const float*)(P.ws + OFF_BW) + 5 * 4352;
    pg8::gemm_phase(lds, g, E);
}
struct EpiFfnDownCtx : pg8::EpiNoMid {
    float* XR; const float* mod;
    __device__ __forceinline__ void operator()(const AccT& acc, const Unit& u, int wr, int wc, int fr, int fq) const {
#pragma unroll
        for (int bj = 0; bj < 2; ++bj)
#pragma unroll
            for (int nn = 0; nn < 2; ++nn) {
                const int n = 256 * u.pn + 128 * bj + 32 * wc + 16 * nn + 4 * fq;
                const f32x4 gt = *(const f32x4*)(mod + 4 * 9216 + 2 * 1024 + n) * 0.5f;
                float* xb = XR + (size_t)(256 * u.pm + 64 * wr + fr) * 1024 + n;
#pragma unroll
                for (int ai = 0; ai < 2; ++ai)
#pragma unroll
                    for (int mm = 0; mm < 4; ++mm) {
                        float* xp = xb + (size_t)(128 * ai + 16 * mm) * 1024;
                        const f32x4 v = acc[ai][bj][mm][nn] * gt;
#pragma unroll
                        for (int r = 0; r < 4; ++r) (void)__hip_atomic_fetch_add(xp + r, v[r], __ATOMIC_RELAXED, __HIP_MEMORY_SCOPE_AGENT);
                    }
                asm volatile("" ::: "memory");
            }
    }
};
template <int FIRST>
__device__ __forceinline__ void phase_ffn_down(const Params& P, PG8_LAS unsigned char* lds, size_t off_w) {
    GemmD g{}; g.A = (const bf16_t*)(P.ws + OFF_HID); g.Bt = (const bf16_t*)(P.ws + off_w); g.lda = FF; g.ldb = FF; g.K = FF; g.nM = NL >> 8; g.nN = 4; g.nG = 1;
    EpiRes<FIRST ? 0 : 2> E; E.x = P.in[0]; E.XRb = (bf16_t*)(P.ws + OFF_XR); E.out = P.out; E.Hn = (bf16_t*)(P.ws + OFF_H); E.mod = (const float*)(P.ws + OFF_MOD);
    E.gnext = P.in[10]; E.ss = (float*)(P.ws + OFF_SS) + (FIRST ? 0 : NT + NL);
    pg8::gemm_phase(lds, g, E);
    if (FIRST) {
        GemmD c{}; c.A = (const bf16_t*)(P.ws + OFF_HID) + (size_t)NL * FF; c.Bt = g.Bt; c.lda = FF; c.ldb = FF; c.K = 256; c.nM = 4; c.nN = 4; c.nG = 11; c.gsA = 256; c.gsB = 256;
        EpiFfnDownCtx EC; EC.XR = (float*)(P.ws + OFF_E); EC.mod = E.mod;
        pg8::gemm_phase(lds, c, EC);
    }
}
__device__ __forceinline__ uint4 pack8(f32x4 a, f32x4 b) { return make_uint4(pk2(a[0], a[1]), pk2(a[2], a[3]), pk2(b[0], b[1]), pk2(b[2], b[3])); }
struct EpiWin : pg8::EpiNoMid {
    static constexpr bool PERM = true;
    bf16_t *U, *Q, *Kb, *V, *R, *GLR, *GA, *GB; const float* ss; const float* BW;
    __device__ __forceinline__ void operator()(const AccT& acc, const Unit& u, int wr, int wc, int fr, int fq) const {
        f32x4 bias[2][2]; float rstd[2][4];
        const int m0 = 256 * u.pm, nb = 256 * u.pn + 32 * wc + 8 * fq;
        {
            const float* bw = BW + (m0 < NL ? (m0 >> 13) : 4) * 4352 + nb;
#pragma unroll
            for (int bj = 0; bj < 2; ++bj)
#pragma unroll
                for (int nn = 0; nn < 2; ++nn) bias[bj][nn] = *(const f32x4*)(bw + 128 * bj + 4 * nn);
#pragma unroll
            for (int ai = 0; ai < 2; ++ai)
#pragma unroll
                for (int mm = 0; mm < 4; ++mm) rstd[ai][mm] = rsqrtf(ss[m0 + 128 * ai + 64 * wr + 16 * mm + fr] * (1.f / 1024.f) + 1e-6f);
        }
#pragma unroll
        for (int ai = 0; ai < 2; ++ai)
#pragma unroll
            for (int mm = 0; mm < 4; ++mm) {
                const int m = m0 + 128 * ai + 64 * wr + 16 * mm + fr;
                const bool lat = m < NL;
                const int b = lat ? (m >> 13) : ((m - NL) >> 8), l = lat ? (m & 8191) : ((m - NL) & 255);
                const int rcm = lat ? (b << 13) + ((l & 63) << 7) + (l >> 6) : m;
#pragma unroll
                for (int bj = 0; bj < 2; ++bj) {
                    const int n = nb + 128 * bj;
                    const f32x4 v0 = acc[ai][bj][mm][0] * rstd[ai][mm] + bias[bj][0], v1 = acc[ai][bj][mm][1] * rstd[ai][mm] + bias[bj][1];
                    if (n < 512) {
                        const int g = n >> 4, urow = lat ? (b << 8) + (l >> 5) : 1024 + (b << 3) + (l >> 5), t = l & 31;
                        *(uint4*)(U + ((size_t)g * UROWS + urow) * 768 + t * 16 + (n & 15)) = pack8(v0, v1);
                    } else if (n < 768) { *(uint4*)(Q + (size_t)rcm * 256 + (n - 512)) = pack8(v0 * 0.125f, v1 * 0.125f); }
                    else if (n < 1024) { *(uint4*)(Kb + (size_t)rcm * 256 + (n - 768)) = pack8(v0, v1); }
                    else if (n < 1536) { *(uint4*)(V + (size_t)rcm * 512 + (n - 1024)) = pack8(v0, v1); }
                    else if (n < 2048) { *(uint4*)(R + (size_t)rcm * 512 + (n - 1536)) = pack8(v0, v1); }
                    else if (n < 4096) {
                        if (lat) {
                            const int j0 = ((256 * u.pn + 128 * bj + 32 * wc - 2048) >> 1) + 4 * fq;
                            f32x4 sa, rt;
#pragma unroll
                            for (int r = 0; r < 4; ++r) { const float ea = 1.f + __expf(-v0[r]), eb = 1.f + __expf(-v1[r]); sa[r] = rcpf_(ea); rt[r] = ea * rcpf_(eb); }
                            store_bf4(GA + (size_t)m * 1024 + j0, sa);
                            store_bf4(GB + (size_t)m * 1024 + j0, rt);
                        }
                    }
                    else if (n < 4128) { *(uint4*)(GLR + (size_t)rcm * 32 + (n - 4096)) = pack8(v0, v1); }
                }
            }
    }
};
__device__ __forceinline__ void phase5(const Params& P, PG8_LAS unsigned char* lds) {
    GemmD g{}; g.A = (const bf16_t*)(P.ws + OFF_H); g.Bt = (const bf16_t*)(P.ws + OFF_WIN); g.lda = 1024; g.ldb = 1024; g.K = 1024; g.nM = NT >> 8; g.nN = 17; g.nG = 1;
    EpiWin E; E.U = (bf16_t*)(P.ws + OFF_U); E.Q = (bf16_t*)(P.ws + OFF_Q); E.Kb = (bf16_t*)(P.ws + OFF_K); E.V = (bf16_t*)(P.ws + OFF_V); E.R = (bf16_t*)(P.ws + OFF_R);
    E.GLR = (bf16_t*)(P.ws + OFF_GLR); E.GA = (bf16_t*)P.out; E.GB = E.GA + (size_t)NL * 1024; E.ss = (const float*)(P.ws + OFF_SS); E.BW = (const float*)(P.ws + OFF_BW);
    pg8::gemm_phase(lds, g, E);
}

__device__ __forceinline__ float logsig(float z) { return fminf(z, 0.f) - __logf(1.f + __expf(-fabsf(z))); }

struct VRegs { uint4 a0, a1, b0, b1; };
__device__ __forceinline__ VRegs load_v_regs(const bf16_t* __restrict__ Vg, int t) {
    const int ip = t & 31, c = t >> 5; VRegs r;
    const bf16_t* p = Vg + (size_t)(2 * ip) * 512 + c * 16;
    r.a0 = *(const uint4*)p; r.a1 = *(const uint4*)(p + 8); r.b0 = *(const uint4*)(p + 512); r.b1 = *(const uint4*)(p + 520);
    return r;
}
__device__ __forceinline__ void store_vt(const VRegs& r, bf16_t* sVt, int t) {
    const int ip = t & 31, c = t >> 5;
    const unsigned ua[8] = {r.a0.x, r.a0.y, r.a0.z, r.a0.w, r.a1.x, r.a1.y, r.a1.z, r.a1.w};
    const unsigned ub[8] = {r.b0.x, r.b0.y, r.b0.z, r.b0.w, r.b1.x, r.b1.y, r.b1.z, r.b1.w};
    unsigned* base = (unsigned*)(sVt + (c * 16) * LROW + 2 * ip);
#pragma unroll
    for (int e = 0; e < 8; ++e) {
        base[(2 * e) * (LROW / 2)] = (ua[e] & 0xffffu) | (ub[e] << 16);
        base[(2 * e + 1) * (LROW / 2)] = (ua[e] >> 16) | (ub[e] & 0xffff0000u);
    }
}
__device__ __forceinline__ float gate_prefix(const Params& P, const float* sGLRd  , int stride, int d, int h, int dk, int part, float (&pre)[16]) {
    float gu[16];
#pragma unroll
    for (int j = 0; j < 16; ++j) gu[j] = P.in[23][(d * 16 + j) * 256 + h * 64 + dk];
    const float gb = P.in[24][d * 256 + h * 64 + dk];
#pragma unroll
    for (int ii = 0; ii < 16; ++ii) {
        const float* gl = sGLRd + (part * 16 + ii) * stride;
        float z = gb;
#pragma unroll
        for (int j4 = 0; j4 < 4; ++j4) { const f32x4 x = *(const f32x4*)(gl + j4 * 4); z += x[0] * gu[j4 * 4] + x[1] * gu[j4 * 4 + 1] + x[2] * gu[j4 * 4 + 2] + x[3] * gu[j4 * 4 + 3]; }
        pre[ii] = logsig(z) * (1.f / 16.f);
    }
    if (d == 0) {
#pragma unroll
        for (int ii = 1; ii < 16; ++ii) pre[ii] += pre[ii - 1];
        return pre[15];
    } else {
#pragma unroll
        for (int ii = 14; ii >= 0; --ii) pre[ii] += pre[ii + 1];
        return pre[0];
    }
}

__device__ __forceinline__ void gla_a_item(const Params& P, int item, unsigned char* smem) {
    float* sGLR = (float*)smem;
    float* sPart = (float*)(smem + 4096);
    bf16_t* sKDt = (bf16_t*)(smem + 5120);
    bf16_t* sVt = (bf16_t*)(smem + 5120 + 9216);
    const int n = item % 132, d = (item / 132) & 1, h = (item / 264) & 3, b = item / 1056;
    const int rowbase = n < 4 ? NL + b * 256 + n * 64 : b * 8192 + (n - 4) * 64;
    const bf16_t* Kb = (const bf16_t*)(P.ws + OFF_K); const bf16_t* V = (const bf16_t*)(P.ws + OFF_V); const bf16_t* GLR = (const bf16_t*)(P.ws + OFF_GLR);
    const int tid = threadIdx.x & 255, lane = tid & 63, w = tid >> 6, dk = tid & 63, part = tid >> 6;
    const VRegs vr = load_v_regs(V + (size_t)rowbase * 512 + h * 128, tid);
    const f32x4 gl4 = load_bf4(GLR + (size_t)(rowbase + (tid >> 2)) * 32 + d * 16 + (tid & 3) * 4);
    float kk[16];
#pragma unroll
    for (int ii = 0; ii < 16; ++ii) kk[ii] = bf2f(Kb[(size_t)(rowbase + part * 16 + ii) * 256 + h * 64 + dk]);
    *(f32x4*)(sGLR + (tid >> 2) * 16 + (tid & 3) * 4) = gl4;
    store_vt(vr, sVt, tid);
    __syncthreads();
    float pre[16];
    const float tot = gate_prefix(P, sGLR, 16, d, h, dk, part, pre);
    sPart[part * 64 + dk] = tot;
    __syncthreads();
    const float t0 = sPart[dk], t1 = sPart[64 + dk], t2 = sPart[128 + dk], t3 = sPart[192 + dk];
    const float gtot = (t0 + t1) + (t2 + t3);
    float off;
    if (d == 0) off = part == 0 ? 0.f : (part == 1 ? t0 : (part == 2 ? t0 + t1 : t0 + t1 + t2));
    else off = part == 3 ? 0.f : (part == 2 ? t3 : (part == 1 ? t3 + t2 : t3 + t2 + t1));
    unsigned pk[8];
#pragma unroll
    for (int e = 0; e < 8; ++e) pk[e] = pk2(kk[2 * e] * __expf(gtot - (off + pre[2 * e])), kk[2 * e + 1] * __expf(gtot - (off + pre[2 * e + 1])));
    *(uint4*)(sKDt + dk * LROW + part * 16) = make_uint4(pk[0], pk[1], pk[2], pk[3]);
    *(uint4*)(sKDt + dk * LROW + part * 16 + 8) = make_uint4(pk[4], pk[5], pk[6], pk[7]);
    if (part == 0) ((float*)(P.ws + OFF_DEC))[(size_t)item * 64 + dk] = __expf(gtot);
    __syncthreads();
    bf16_t* KVt = (bf16_t*)(P.ws + OFF_H) + (size_t)item * 8192;
    const int fr = lane & 15, fq = lane >> 4;
#pragma unroll
    for (int dvt = 0; dvt < 2; ++dvt) {
        f32x4 acc[4];
#pragma unroll
        for (int dkt = 0; dkt < 4; ++dkt) acc[dkt] = (f32x4){0.f, 0.f, 0.f, 0.f};
#pragma unroll
        for (int ks = 0; ks < 2; ++ks) {
            const bf16x8 vb = *(const bf16x8*)(sVt + (w * 32 + dvt * 16 + fr) * LROW + ks * 32 + fq * 8);
#pragma unroll
            for (int dkt = 0; dkt < 4; ++dkt) {
                const bf16x8 ka = *(const bf16x8*)(sKDt + (dkt * 16 + fr) * LROW + ks * 32 + fq * 8);
                acc[dkt] = __builtin_amdgcn_mfma_f32_16x16x32_bf16(ka, vb, acc[dkt], 0, 0, 0);
            }
        }
#pragma unroll
        for (int dkt = 0; dkt < 4; ++dkt) store_bf4(KVt + (size_t)(w * 32 + dvt * 16 + fr) * 64 + dkt * 16 + fq * 4, acc[dkt]);
    }
    __syncthreads();
}

__device__ __forceinline__ void gla_scan_item(const Params& P, int item) {
    const int gid = item * NTHR + threadIdx.x, seq = gid >> 11, e = gid & 2047, dv = e >> 4, dk4 = (e & 15) * 4, d = seq & 1;
    bf16_t* base = (bf16_t*)(P.ws + OFF_H) + (size_t)seq * 132 * 8192 + dv * 64 + dk4;
    const float* decb = (const float*)(P.ws + OFF_DEC) + (size_t)seq * 132 * 64 + dk4;
    f32x4 S = (f32x4){0.f, 0.f, 0.f, 0.f};
    for (int s0 = 0; s0 < 132; s0 += 12) {
        uint2 kvr[12]; f32x4 dec[12];
#pragma unroll
        for (int q = 0; q < 12; ++q) {
            const int step = s0 + q, n = d == 0 ? step : (step < 4 ? 3 - step : 135 - step);
            kvr[q] = *(const uint2*)(base + (size_t)n * 8192); dec[q] = *(const f32x4*)(decb + n * 64);
        }
#pragma unroll
        for (int q = 0; q < 12; ++q) {
            const int step = s0 + q, n = d == 0 ? step : (step < 4 ? 3 - step : 135 - step);
            if (n >= 4) store_bf4(base + (size_t)n * 8192, S);
            f32x4 kv; kv[0] = bflo(kvr[q].x); kv[1] = bfhi(kvr[q].x); kv[2] = bflo(kvr[q].y); kv[3] = bfhi(kvr[q].y);
            S = dec[q] * S + kv;
        }
    }
}

__device__ __forceinline__ void gla_c_item(const Params& P, int item, unsigned char* smem) {
    float* sGLR = (float*)smem;
    float* sPart = (float*)(smem + 8192);
    bf16_t* sQD = (bf16_t*)(smem + 10240);
    bf16_t* sKD = (bf16_t*)(smem + 10240 + 9216);
    bf16_t* sQG = (bf16_t*)(smem + 10240 + 2 * 9216);
    bf16_t* sP = (bf16_t*)(smem + 10240 + 2 * 9216 + 17408);
    bf16_t* sVt = (bf16_t*)(smem + 10240 + 3 * 9216 + 17408);
    const int m = item & 127, h = (item >> 7) & 3, b = item >> 9;
    const int rowbase = b * 8192 + m * 64;
    const bf16_t* Q = (const bf16_t*)(P.ws + OFF_Q); const bf16_t* Kb = (const bf16_t*)(P.ws + OFF_K);
    bf16_t* V = (bf16_t*)(P.ws + OFF_V); const bf16_t* R = (const bf16_t*)(P.ws + OFF_R); const bf16_t* GLR = (const bf16_t*)(P.ws + OFF_GLR);
    const int tid = threadIdx.x & 255, lane = tid & 63, w = tid >> 6, fr = lane & 15, fq = lane >> 4, dk = tid & 63, part = tid >> 6;
    const VRegs vr = load_v_regs(V + (size_t)rowbase * 512 + h * 128, tid);
    const uint4 gl8 = *(const uint4*)(GLR + (size_t)(rowbase + (tid >> 2)) * 32 + (tid & 3) * 8);
    float qq[16], kk[16];
#pragma unroll
    for (int ii = 0; ii < 16; ++ii) { qq[ii] = bf2f(Q[(size_t)(rowbase + part * 16 + ii) * 256 + h * 64 + dk]); kk[ii] = bf2f(Kb[(size_t)(rowbase + part * 16 + ii) * 256 + h * 64 + dk]); }
    {
        float* gp = sGLR + (tid >> 2) * 32 + (tid & 3) * 8;
        *(f32x4*)gp = (f32x4){bflo(gl8.x), bfhi(gl8.x), bflo(gl8.y), bfhi(gl8.y)};
        *(f32x4*)(gp + 4) = (f32x4){bflo(gl8.z), bfhi(gl8.z), bflo(gl8.w), bfhi(gl8.w)};
    }
    store_vt(vr, sVt, tid);
    __syncthreads();
    float gc0[16], gc1[16];
    { const float tot0 = gate_prefix(P, sGLR, 32, 0, h, dk, part, gc0); const float tot1 = gate_prefix(P, sGLR + 16, 32, 1, h, dk, part, gc1);
      sPart[part * 64 + dk] = tot0; sPart[256 + part * 64 + dk] = tot1; }
    __syncthreads();
    float gref0, gref1;
    {
        const float a0 = sPart[dk], a1 = sPart[64 + dk], a2 = sPart[128 + dk];
        const float c1 = sPart[256 + 64 + dk], c2 = sPart[256 + 128 + dk], c3 = sPart[256 + 192 + dk];
        const float off0 = part == 0 ? 0.f : (part == 1 ? a0 : (part == 2 ? a0 + a1 : a0 + a1 + a2));
        const float off1 = part == 3 ? 0.f : (part == 2 ? c3 : (part == 1 ? c3 + c2 : c3 + c2 + c1));
        gref0 = a0 + a1; gref1 = c3 + c2;
#pragma unroll
        for (int ii = 0; ii < 16; ++ii) { gc0[ii] += off0; gc1[ii] += off1; }
    }
    f32x4 pacc[4];
#pragma unroll
    for (int jt = 0; jt < 4; ++jt) pacc[jt] = (f32x4){0.f, 0.f, 0.f, 0.f};
#pragma unroll
    for (int d = 0; d < 2; ++d) {
        const float gref = d == 0 ? gref0 : gref1;
#pragma unroll
        for (int ii = 0; ii < 16; ++ii) {
            const int i = part * 16 + ii;
            const float gc = d == 0 ? gc0[ii] : gc1[ii];
            sQD[i * LROW + dk] = f2bf(qq[ii] * __expf(gc - gref));
            sKD[i * LROW + dk] = f2bf(kk[ii] * __expf(gref - gc));
            sQG[i * 136 + d * 64 + dk] = f2bf(qq[ii] * __expf(gc));
        }
        __syncthreads();
#pragma unroll
        for (int jt = 0; jt < 4; ++jt) {
            f32x4 sc = (f32x4){0.f, 0.f, 0.f, 0.f};
#pragma unroll
            for (int ks = 0; ks < 2; ++ks) {
                const bf16x8 a = *(const bf16x8*)(sQD + (16 * w + fr) * LROW + ks * 32 + fq * 8);
                const bf16x8 bb = *(const bf16x8*)(sKD + (jt * 16 + fr) * LROW + ks * 32 + fq * 8);
                sc = __builtin_amdgcn_mfma_f32_16x16x32_bf16(a, bb, sc, 0, 0, 0);
            }
#pragma unroll
            for (int r = 0; r < 4; ++r) {
                const int i = 16 * w + fq * 4 + r, j = jt * 16 + fr;
                const bool keep = d == 0 ? (j <= i) : (j >= i);
                pacc[jt][r] += keep ? sc[r] : 0.f;
            }
        }
        if (d == 0) __syncthreads();
    }
#pragma unroll
    for (int jt = 0; jt < 4; ++jt)
#pragma unroll
        for (int r = 0; r < 4; ++r) sP[(16 * w + fq * 4 + r) * LROW + jt * 16 + fr] = f2bf(pacc[jt][r]);
    const bf16_t* SS0 = (const bf16_t*)(P.ws + OFF_H) + ((size_t)(((b * 4 + h) * 2 + 0) * 132 + 4 + m)) * 8192;
    const bf16_t* SS1 = (const bf16_t*)(P.ws + OFF_H) + ((size_t)(((b * 4 + h) * 2 + 1) * 132 + 4 + m)) * 8192;
    const int i_out = 16 * w + fr;
    const int tok_out = b * 8192 + ((m & 1) * 64 + i_out) * 64 + (m >> 1);
    bf16_t* YB = (bf16_t*)(P.ws + OFF_YB);
    uint2 rgr[8];
#pragma unroll
    for (int dvt = 0; dvt < 8; ++dvt) rgr[dvt] = *(const uint2*)(R + (size_t)(rowbase + i_out) * 512 + h * 128 + dvt * 16 + fq * 4);
    __syncthreads();
    f32x4 oacc[8];
#pragma unroll
    for (int dvt = 0; dvt < 8; ++dvt) oacc[dvt] = (f32x4){0.f, 0.f, 0.f, 0.f};
#pragma unroll
    for (int ks = 0; ks < 4; ++ks) {
        const bf16x8 qb = *(const bf16x8*)(sQG + (16 * w + fr) * 136 + ks * 32 + fq * 8);
        const bf16_t* SS = (ks >> 1) ? SS1 : SS0;
#pragma unroll
        for (int dvt = 0; dvt < 8; ++dvt) {
            const bf16x8 sa = *(const bf16x8*)(SS + (size_t)(dvt * 16 + fr) * 64 + (ks & 1) * 32 + fq * 8);
            oacc[dvt] = __builtin_amdgcn_mfma_f32_16x16x32_bf16(sa, qb, oacc[dvt], 0, 0, 0);
        }
    }
#pragma unroll
    for (int ks = 0; ks < 2; ++ks) {
        const bf16x8 pb = *(const bf16x8*)(sP + (16 * w + fr) * LROW + ks * 32 + fq * 8);
#pragma unroll
        for (int dvt = 0; dvt < 8; ++dvt) {
            const bf16x8 va = *(const bf16x8*)(sVt + (dvt * 16 + fr) * LROW + ks * 32 + fq * 8);
            oacc[dvt] = __builtin_amdgcn_mfma_f32_16x16x32_bf16(va, pb, oacc[dvt], 0, 0, 0);
        }
    }
    float ss = 0.f;
#pragma unroll
    for (int dvt = 0; dvt < 8; ++dvt)
#pragma unroll
        for (int r = 0; r < 4; ++r) ss += oacc[dvt][r] * oacc[dvt][r];
    ss += __shfl_xor(ss, 16); ss += __shfl_xor(ss, 32);
    const float rinv = rsqrtf(ss * (1.f / 128.f) + 1e-6f);
#pragma unroll
    for (int dvt = 0; dvt < 8; ++dvt) {
        const int dv = dvt * 16 + fq * 4;
        const float rg[4] = {bflo(rgr[dvt].x), bfhi(rgr[dvt].x), bflo(rgr[dvt].y), bfhi(rgr[dvt].y)};
        const f32x4 ng = *(const f32x4*)(P.in[25] + h * 128 + dv);
        f32x4 o;
#pragma unroll
        for (int r = 0; r < 4; ++r) o[r] = oacc[dvt][r] * rinv * ng[r] * siluf_(rg[r]);
        store_bf4(YB + (size_t)tok_out * 512 + h * 128 + dv, o);
    }
    __syncthreads();
}

struct EpiE : pg8::EpiNoMid {
    float* E;
    __device__ __forceinline__ void operator()(const AccT& acc, const Unit& u, int wr, int wc, int fr, int fq) const {
        EPI_LOOP
            if (m < 1056) *(f32x4*)(E + ((size_t)u.g * 1056 + m) * 256 + n) = v;
        EPI_LOOP_END
    }
};
__device__ __forceinline__ void phase6(const Params& P, unsigned char* smem) {
    const int hb = threadIdx.x >> 8;
    for (int base = blockIdx.x * 2; base < 4224; base += gridDim.x * 2) gla_a_item(P, base + hb, smem + hb * HALF_LDS);
    GemmD g{}; g.A = (const bf16_t*)(P.ws + OFF_U); g.Bt = (const bf16_t*)(P.ws + OFF_WE); g.lda = 768; g.ldb = 512; g.K = 512; g.nM = 5; g.nN = 1; g.nG = 32;
    g.gsA = (size_t)UROWS * 768; g.gsB = (size_t)256 * 512;
    EpiE E; E.E = (float*)(P.ws + OFF_E);
    pg8::gemm_phase((PG8_LAS unsigned char*)smem, g, E);
}
__device__ __forceinline__ void s5_carry_item(const Params& P, int item) {
    const int id = item * NTHR + threadIdx.x, p = id & 63, d = (id >> 6) & 1, b = (id >> 7) & 3, g = id >> 9;
    const float2 lamT = ((const float2*)(P.ws + OFF_LP))[((d * 32 + g) * 33 + 32) * 64 + p];
    const float* Eg = (const float*)(P.ws + OFF_E) + (size_t)g * 1056 * 256;
    bf16_t* Ug = (bf16_t*)(P.ws + OFF_U) + (size_t)g * UROWS * 768;
    const int cre = d * 128 + p, cim = d * 128 + 64 + p;
    float2 hh = make_float2(0.f, 0.f);
    {
        float2 e[8];
#pragma unroll
        for (int s = 0; s < 8; ++s) { const int n = d == 0 ? s : 7 - s, row = 1024 + b * 8 + n; e[s] = make_float2(Eg[(size_t)row * 256 + cre], Eg[(size_t)row * 256 + cim]); }
#pragma unroll
        for (int s = 0; s < 8; ++s) { const float2 t = cmul(lamT, hh); hh = make_float2(t.x + e[s].x, t.y + e[s].y); }
    }
    for (int s0 = 0; s0 < 256; s0 += 16) {
        float2 e[16];
#pragma unroll
        for (int q = 0; q < 16; ++q) { const int s = s0 + q, n = d == 0 ? s : 255 - s, row = b * 256 + n; e[q] = make_float2(Eg[(size_t)row * 256 + cre], Eg[(size_t)row * 256 + cim]); }
#pragma unroll
        for (int q = 0; q < 16; ++q) {
            const int s = s0 + q, n = d == 0 ? s : 255 - s, row = b * 256 + n;
            Ug[(size_t)row * 768 + 512 + cre] = f2bf(hh.x); Ug[(size_t)row * 768 + 512 + cim] = f2bf(hh.y);
            const float2 t = cmul(lamT, hh); hh = make_float2(t.x + e[q].x, t.y + e[q].y);
        }
    }
}
__device__ __forceinline__ void phase7(const Params& P) {
    for (int it = blockIdx.x; it < 32 + 128; it += gridDim.x) {
        if (it < 32) s5_carry_item(P, it); else gla_scan_item(P, it - 32);
    }
}
struct EpiY : pg8::EpiNoMid {
    static constexpr bool PERM = true;
    const bf16_t* U; const float* dskip; bf16_t* YG;
    __device__ __forceinline__ void operator()(const AccT& acc, const Unit& u, int wr, int wc, int fr, int fq) const {
        const int nb = 256 * u.pn + 32 * wc + 8 * fq, c0 = 8 * (fq & 1);
        const f32x4 ds0 = *(const f32x4*)(dskip + u.g * 16 + c0), ds1 = *(const f32x4*)(dskip + u.g * 16 + c0 + 4);
#pragma unroll
        for (int ai = 0; ai < 2; ++ai) {
            const int mb = 256 * u.pm + 128 * ai + 64 * wr + fr;
            uint4 ur[4][2];
#pragma unroll
            for (int mm = 0; mm < 4; ++mm)
#pragma unroll
                for (int bj = 0; bj < 2; ++bj) ur[mm][bj] = *(const uint4*)(U + ((size_t)u.g * UROWS + mb + 16 * mm) * 768 + nb + 128 * bj);
#pragma unroll
            for (int mm = 0; mm < 4; ++mm)
#pragma unroll
                for (int bj = 0; bj < 2; ++bj) {
                    const int m = mb + 16 * mm, n = nb + 128 * bj;
                    const int b = m >> 8, nch = m & 255, t = n >> 4;
                    const uint4 uu = ur[mm][bj];
                    const f32x4 v0 = acc[ai][bj][mm][0], v1 = acc[ai][bj][mm][1];
                    const f32x4 o0 = {gelu_tanh(v0[0] + ds0[0] * bflo(uu.x)), gelu_tanh(v0[1] + ds0[1] * bfhi(uu.x)), gelu_tanh(v0[2] + ds0[2] * bflo(uu.y)), gelu_tanh(v0[3] + ds0[3] * bfhi(uu.y))};
                    const f32x4 o1 = {gelu_tanh(v1[0] + ds1[0] * bflo(uu.z)), gelu_tanh(v1[1] + ds1[1] * bfhi(uu.z)), gelu_tanh(v1[2] + ds1[2] * bflo(uu.w)), gelu_tanh(v1[3] + ds1[3] * bfhi(uu.w))};
                    *(uint4*)(YG + ((size_t)(b * 8192 + nch * 32 + t)) * 512 + u.g * 16 + c0) = pack8(o0, o1);
                }
        }
    }
};
__device__ __forceinline__ void phase8(const Params& P, unsigned char* smem) {
    const int hb = threadIdx.x >> 8;
    for (int base = blockIdx.x * 2; base < 2048; base += gridDim.x * 2) gla_c_item(P, base + hb, smem + hb * HALF_LDS);
    GemmD g{}; g.A = (const bf16_t*)(P.ws + OFF_U); g.Bt = (const bf16_t*)(P.ws + OFF_WY); g.lda = 768; g.ldb = 768; g.K = 768; g.nM = 4; g.nN = 2; g.nG = 32;
    g.gsA = (size_t)UROWS * 768; g.gsB = (size_t)512 * 768;
    EpiY E; E.U = (const bf16_t*)(P.ws + OFF_U); E.dskip = P.in[19]; E.YG = (bf16_t*)(P.ws + OFF_E);
    pg8::gemm_phase((PG8_LAS unsigned char*)smem, g, E);
}

struct EpiGlu : pg8::EpiNoMid {
    static constexpr bool PERM = true;
    const bf16_t* YG; const float* bias; bf16_t* YA;
    __device__ __forceinline__ void operator()(const AccT& acc, const Unit& u, int wr, int wc, int fr, int fq) const {
        const int nb = 256 * u.pn + 32 * wc + 8 * fq;
        f32x4 bb[2][2];
#pragma unroll
        for (int bj = 0; bj < 2; ++bj)
#pragma unroll
            for (int nn = 0; nn < 2; ++nn) bb[bj][nn] = *(const f32x4*)(bias + nb + 128 * bj + 4 * nn);
#pragma unroll
        for (int ai = 0; ai < 2; ++ai) {
            const size_t rb = (size_t)(256 * u.pm + 128 * ai + 64 * wr + fr) * 512 + nb;
            uint4 yr[4][2];
#pragma unroll
            for (int mm = 0; mm < 4; ++mm)
#pragma unroll
                for (int bj = 0; bj < 2; ++bj) yr[mm][bj] = *(const uint4*)(YG + rb + (size_t)mm * 16 * 512 + 128 * bj);
#pragma unroll
            for (int mm = 0; mm < 4; ++mm)
#pragma unroll
                for (int bj = 0; bj < 2; ++bj) {
                    const uint4 y = yr[mm][bj]; const f32x4 v0 = acc[ai][bj][mm][0] + bb[bj][0], v1 = acc[ai][bj][mm][1] + bb[bj][1];
                    const f32x4 o0 = {bflo(y.x) * sigm(v0[0]), bfhi(y.x) * sigm(v0[1]), bflo(y.y) * sigm(v0[2]), bfhi(y.y) * sigm(v0[3])};
                    const f32x4 o1 = {bflo(y.z) * sigm(v1[0]), bfhi(y.z) * sigm(v1[1]), bflo(y.w) * sigm(v1[2]), bfhi(y.w) * sigm(v1[3])};
                    *(uint4*)(YA + rb + (size_t)mm * 16 * 512 + 128 * bj) = pack8(o0, o1);
                }
        }
    }
};
__device__ __forceinline__ void phase9(const Params& P, PG8_LAS unsigned char* lds) {
    GemmD g{}; g.A = (const bf16_t*)(P.ws + OFF_E); g.Bt = (const bf16_t*)(P.ws + OFF_WGLU); g.lda = 512; g.ldb = 512; g.K = 512; g.nM = NL >> 8; g.nN = 2; g.nG = 1;
    EpiGlu E; E.YG = (const bf16_t*)(P.ws + OFF_E); E.bias = P.in[21]; E.YA = (bf16_t*)(P.ws + OFF_U);
    pg8::gemm_phase(lds, g, E);
}
struct EpiMerge {
    static constexpr bool PERM = true;
    const bf16_t* GA; const bf16_t* GB; bf16_t* H;
    __device__ __forceinline__ void mid(f32x4 (&acc)[2][2][4][2], const Unit& u, int wr, int wc, int fr, int fq) const {
        const int nb = 256 * u.pn + 32 * wc + 8 * fq;
#pragma unroll
        for (int ai = 0; ai < 2; ++ai) {
            const size_t rb = (size_t)(256 * u.pm + 128 * ai + 64 * wr + fr) * 1024 + nb;
            uint4 br[4][2];
#pragma unroll
            for (int mm = 0; mm < 4; ++mm)
#pragma unroll
                for (int bj = 0; bj < 2; ++bj) br[mm][bj] = *(const uint4*)(GB + rb + (size_t)mm * 16 * 1024 + 128 * bj);
#pragma unroll
            for (int mm = 0; mm < 4; ++mm)
#pragma unroll
                for (int bj = 0; bj < 2; ++bj) {
                    const uint4 b4 = br[mm][bj];
                    f32x4& v0 = acc[ai][bj][mm][0]; f32x4& v1 = acc[ai][bj][mm][1];
                    v0[0] *= bflo(b4.x); v0[1] *= bfhi(b4.x); v0[2] *= bflo(b4.y); v0[3] *= bfhi(b4.y);
                    v1[0] *= bflo(b4.z); v1[1] *= bfhi(b4.z); v1[2] *= bflo(b4.w); v1[3] *= bfhi(b4.w);
                }
        }
    }
    __device__ __forceinline__ void operator()(const AccT& acc, const Unit& u, int wr, int wc, int fr, int fq) const {
        const int nb = 256 * u.pn + 32 * wc + 8 * fq;
#pragma unroll
        for (int ai = 0; ai < 2; ++ai) {
            const size_t rb = (size_t)(256 * u.pm + 128 * ai + 64 * wr + fr) * 1024 + nb;
            uint4 gr[4][2];
#pragma unroll
            for (int mm = 0; mm < 4; ++mm)
#pragma unroll
                for (int bj = 0; bj < 2; ++bj) gr[mm][bj] = *(const uint4*)(GA + rb + (size_t)mm * 16 * 1024 + 128 * bj);
#pragma unroll
            for (int mm = 0; mm < 4; ++mm)
#pragma unroll
                for (int bj = 0; bj < 2; ++bj) {
                    const uint4 g4 = gr[mm][bj]; const f32x4 v0 = acc[ai][bj][mm][0], v1 = acc[ai][bj][mm][1];
                    uint4 o;
                    o.x = pk2(bflo(g4.x) * v0[0], bfhi(g4.x) * v0[1]); o.y = pk2(bflo(g4.y) * v0[2], bfhi(g4.y) * v0[3]);
                    o.z = pk2(bflo(g4.z) * v1[0], bfhi(g4.z) * v1[1]); o.w = pk2(bflo(g4.w) * v1[2], bfhi(g4.w) * v1[3]);
                    *(uint4*)(H + rb + (size_t)mm * 16 * 1024 + 128 * bj) = o;
                }
        }
    }
};
__device__ __forceinline__ void phase10(const Params& P, PG8_LAS unsigned char* lds) {
    GemmD g{}; g.A = (const bf16_t*)(P.ws + OFF_YB); g.Bt = (const bf16_t*)(P.ws + OFF_WGLO); g.A2 = (const bf16_t*)(P.ws + OFF_U); g.Bt2 = (const bf16_t*)(P.ws + OFF_WS5O); g.dual = 1;
    g.lda = 512; g.ldb = 512; g.K = 512; g.nM = NL >> 8; g.nN = 4; g.nG = 1;
    EpiMerge E; E.GA = (const bf16_t*)P.out; E.GB = E.GA + (size_t)NL * 1024; E.H = (bf16_t*)(P.ws + OFF_H);
    pg8::gemm_phase(lds, g, E);
}
__device__ __forceinline__ void phase11(const Params& P, PG8_LAS unsigned char* lds) {
    GemmD g{}; g.A = (const bf16_t*)(P.ws + OFF_H); g.Bt = (const bf16_t*)(P.ws + OFF_WWO); g.lda = 1024; g.ldb = 1024; g.K = 1024; g.nM = NL >> 8; g.nN = 4; g.nG = 1;
    EpiRes<1> E; E.x = nullptr; E.XRb = (bf16_t*)(P.ws + OFF_XR); E.out = nullptr; E.Hn = (bf16_t*)P.out; E.mod = (const float*)(P.ws + OFF_MOD);
    E.gnext = P.in[28]; E.ss = (float*)(P.ws + OFF_SS) + NT;
    pg8::gemm_phase(lds, g, E);
}

__device__ __forceinline__ void phase_ffn_up13(const Params& P, PG8_LAS unsigned char* lds) {
    GemmD g{}; g.A = (const bf16_t*)P.out; g.Bt = (const bf16_t*)(P.ws + OFF_WGU2); g.lda = 1024; g.ldb = 1024; g.K = 1024; g.nM = NL >> 8; g.nN = 22; g.nG = 1;
    EpiFfnUp<1> E; E.HID = (bf16_t*)(P.ws + OFF_HID); E.ss = (const float*)(P.ws + OFF_SS) + NT; E.BW = (const float*)(P.ws + OFF_BW) + 5 * 4352;
    pg8::gemm_phase(lds, g, E);
}

#define XB_TMO      128
#define XB_XCNT(j)  (256  + 64 * (j))
#define XB_XSUB(j)  (1280 + 64 * (j))
#define XB_XGEN(j)  (2304 + 64 * (j))
#define XB_TOP      3328
#define XB_TOPGEN   3392
#define XCD_BAR_WORDS 3456
#define XB_SPIN_CAP (1u << 18)
#define LAS3 __attribute__((address_space(3)))
__device__ __forceinline__ unsigned xb_ld(unsigned* p)              { return __hip_atomic_load(p, __ATOMIC_RELAXED, __HIP_MEMORY_SCOPE_AGENT); }
__device__ __forceinline__ unsigned xb_add(unsigned* p, unsigned v) { return __hip_atomic_fetch_add(p, v, __ATOMIC_RELAXED, __HIP_MEMORY_SCOPE_AGENT); }
__device__ __forceinline__ unsigned xb_xcc_id() { return (unsigned)__builtin_amdgcn_s_getreg((3 << 11) | 20) & 0xFu; }
#define XB_SPIN(cond, bar) do { unsigned _sp = 0; while (cond) { __builtin_amdgcn_s_sleep(1); \
    if ((++_sp & 255u) == 0u) { if (xb_ld(&(bar)[XB_TMO])) break; if (_sp > XB_SPIN_CAP) { atomicAdd(&(bar)[XB_TMO], 1u); break; } } } } while (0)
struct XcdBarrier { unsigned* bar; unsigned x; volatile LAS3 unsigned* st; };
__device__ __forceinline__ XcdBarrier xcd_barrier_post(unsigned* bar, volatile LAS3 unsigned* st) {
    XcdBarrier b; b.bar = bar; b.x = xb_xcc_id(); b.st = st;
    if (threadIdx.x == 0) (void)xb_add(&bar[XB_XCNT(b.x)], 1u);
    return b;
}
__device__ __forceinline__ void xcd_barrier_complete(unsigned* bar, unsigned x, unsigned& nloc, unsigned& nx) {
    const unsigned G = gridDim.x * gridDim.y * gridDim.z;
    unsigned sum, cnt, mine, sp = 0u;
    for (;;) {
        sum = 0u; cnt = 0u; mine = 0u;
#pragma unroll
        for (unsigned j = 0; j < 16; ++j) { const unsigned c = xb_ld(&bar[XB_XCNT(j)]); sum += c; cnt += (c > 0u) ? 1u : 0u; mine = (j == x) ? c : mine; }
        if (sum == G) break;
        __builtin_amdgcn_s_sleep(1);
        if ((++sp & 255u) == 0u) { if (xb_ld(&bar[XB_TMO])) break; if (sp > XB_SPIN_CAP) { atomicAdd(&bar[XB_TMO], 1u); break; } }
    }
    nloc = mine > 0u ? mine : 1u; nx = cnt > 0u ? cnt : 1u;
}
__device__ __forceinline__ void xcd_barrier(const XcdBarrier& b) {
    asm volatile("s_waitcnt vmcnt(0)" ::: "memory");
    __syncthreads();
    if (threadIdx.x == 0) {
        unsigned* bar = b.bar;
        __builtin_amdgcn_s_waitcnt(0);
        unsigned nloc = b.st[0], nx = b.st[1];
        if (nloc == 0u) { xcd_barrier_complete(bar, b.x, nloc, nx); b.st[0] = nloc; b.st[1] = nx; }
        const unsigned old = xb_add(&bar[XB_XSUB(b.x)], 1u);
        const unsigned gen = old / nloc;
        if (old + 1u == (gen + 1u) * nloc) {
            __builtin_amdgcn_fence(__ATOMIC_RELEASE, "agent");
            asm volatile("s_waitcnt vmcnt(0)" ::: "memory");
            const unsigned og = xb_add(&bar[XB_TOP], 1u);
            const unsigned tg = og / nx;
            if (og + 1u == (tg + 1u) * nx) xb_add(&bar[XB_TOPGEN], 1u);
            else XB_SPIN(xb_ld(&bar[XB_TOPGEN]) == tg, bar);
            __builtin_amdgcn_fence(__ATOMIC_ACQUIRE, "agent");
            xb_add(&bar[XB_XGEN(b.x)], 1u);
            asm volatile("s_waitcnt vmcnt(0)" ::: "memory");
        } else {
            XB_SPIN(xb_ld(&bar[XB_XGEN(b.x)]) == gen, bar);
            __builtin_amdgcn_fence(__ATOMIC_ACQUIRE, "agent");
            asm volatile("s_waitcnt vmcnt(0)" ::: "memory");
        }
    }
    __syncthreads();
}

__global__ void __launch_bounds__(512, 2) mega(Params P) {
    extern __shared__ __attribute__((aligned(16))) unsigned char smem[];
    cg::grid_group grid = cg::this_grid();
    PG8_LAS unsigned char* lds = (PG8_LAS unsigned char*)smem;
    __shared__ uint4 xb_words;
    unsigned* bar = (unsigned*)(P.ws + OFF_BAR);
    if (threadIdx.x == 0) xb_words = make_uint4(0u, 0u, 0u, 0u);
    if (blockIdx.x == 0 && P.ph_lo == 0) { for (int i = threadIdx.x; i < XCD_BAR_WORDS; i += NTHR) bar[i] = 0u; }
    __syncthreads();
    XcdBarrier xb; xb.bar = bar; xb.x = 0; xb.st = (volatile LAS3 unsigned*)&xb_words;
#ifndef PHMASK
#define PHMASK 0xFFFF
#endif
#define PHOK(n) ((PHMASK >> n) & 1)
#define RUN(n, call) if (PHOK(n) && P.ph_lo <= n && n < P.ph_hi) { call; if (n + 1 < P.ph_hi) { if (n == 0) { grid.sync(); xb = xcd_barrier_post(bar, (volatile LAS3 unsigned*)&xb_words); } else xcd_barrier(xb); } }
    RUN(0, phase0(P, smem))
    RUN(1, phase1(P))
    RUN(2, phase_ffn_up<0>(P, lds, OFF_WGU1, NT))
    RUN(3, phase_ffn_down<1>(P, lds, OFF_WDN1))
    RUN(4, phase4(P))
    RUN(5, phase5(P, lds))
    RUN(6, phase6(P, smem))
    RUN(7, phase7(P))
    RUN(8, phase8(P, smem))
    RUN(9, phase9(P, lds))
    RUN(10, phase10(P, lds))
    RUN(11, phase11(P, lds))
    RUN(13, phase_ffn_up13(P, lds))
    RUN(14, phase_ffn_down<0>(P, lds, OFF_WDN2))
    RUN(15, phase15(P))
}

extern "C" void kernel_launch(void* const* d_in, const int* in_sizes, int n_in, void* d_out, int out_size, void* d_ws, size_t ws_size, hipStream_t stream) {
    static int grid_blocks = 0;
    if (grid_blocks == 0) {
        if (n_in != 33 || ws_size < WS_END) { fprintf(stderr, "kernel_launch: unexpected n_in %d / ws_size %zu (need %zu)\n", n_in, ws_size, (size_t)WS_END); grid_blocks = -1; return; }
        int dev = 0, cus = 0, per_cu = 0;
        hipGetDevice(&dev);
        hipDeviceGetAttribute(&cus, hipDeviceAttributeMultiprocessorCount, dev);
        hipFuncSetAttribute((const void*)mega, hipFuncAttributeMaxDynamicSharedMemorySize, LDS_BYTES);
        hipOccupancyMaxActiveBlocksPerMultiprocessor(&per_cu, (const void*)mega, NTHR, LDS_BYTES);
        if (per_cu < 1) per_cu = 1;
        if (per_cu > 1) per_cu = 1;
        grid_blocks = cus * per_cu;
        fprintf(stderr, "kernel_launch: cus %d per_cu %d grid %d\n", cus, per_cu, grid_blocks);
    }
    if (grid_blocks < 0) return;
    Params p{};
    for (int i = 0; i < 33; ++i) p.in[i] = (const float*)d_in[i];
    p.out = (float*)d_out; p.ws = (unsigned char*)d_ws;
#if N_LAUNCH_PER_PHASE
    for (int ph = 0; ph < NPHASE; ++ph) {
        p.ph_lo = ph; p.ph_hi = ph + 1;
        void* args[] = {&p};
        hipError_t e = hipLaunchCooperativeKernel((const void*)mega, dim3(grid_blocks), dim3(NTHR), args, LDS_BYTES, stream);
        if (e != hipSuccess) { fprintf(stderr, "cooperative launch failed: %s\n", hipGetErrorString(e)); break; }
    }
#else
    p.ph_lo = 0; p.ph_hi = NPHASE;
    void* args[] = {&p};
    hipError_t e = hipLaunchCooperativeKernel((const void*)mega, dim3(grid_blocks), dim3(NTHR), args, LDS_BYTES, stream);
    if (e != hipSuccess) fprintf(stderr, "cooperative launch failed: %s\n", hipGetErrorString(e));
#endif
}
```

```cpp
#include <hip/hip_runtime.h>
#include <hip/hip_cooperative_groups.h>
#include <cstdio>
namespace cg = cooperative_groups;

#ifndef N_LAUNCH_PER_PHASE
#define N_LAUNCH_PER_PHASE 0
#endif

typedef unsigned short bf16_t;
typedef short bf16x8 __attribute__((ext_vector_type(8)));
typedef float f32x4 __attribute__((ext_vector_type(4)));

constexpr int NL = 32768, NC = 1024, NT = 33792, D = 1024, FF = 2816;
constexpr int NPHASE = 16;
constexpr int HALF_LDS = 79872;
constexpr int LDS_BYTES = 2 * HALF_LDS;
constexpr int NTHR = 512;
constexpr int UROWS = 1280;

constexpr size_t SZ_WGU = (size_t)5632 * 1024 * 2, SZ_WDN = (size_t)1024 * 2816 * 2;
constexpr size_t OFF_WGU1 = 0;
constexpr size_t OFF_WDN1 = OFF_WGU1 + SZ_WGU;
constexpr size_t OFF_WGU2 = OFF_WDN1 + SZ_WDN;
constexpr size_t OFF_WDN2 = OFF_WGU2 + SZ_WGU;
constexpr size_t OFF_WIN = OFF_WDN2 + SZ_WDN;
constexpr size_t OFF_WGLU = OFF_WIN + (size_t)4352 * 1024 * 2;
constexpr size_t OFF_WS5O = OFF_WGLU + (size_t)512 * 512 * 2;
constexpr size_t OFF_WGLO = OFF_WS5O + (size_t)1024 * 512 * 2;
constexpr size_t OFF_WWO = OFF_WGLO + (size_t)1024 * 512 * 2;
constexpr size_t OFF_WE = OFF_WWO + (size_t)1024 * 1024 * 2;
constexpr size_t OFF_WY = OFF_WE + (size_t)32 * 256 * 512 * 2;
constexpr size_t OFF_KD = OFF_WY + (size_t)32 * 512 * 768 * 2;
constexpr size_t OFF_LP = OFF_KD + (size_t)2 * 32 * 32 * 256 * 4;
constexpr size_t OFF_BB = OFF_LP + (size_t)2 * 32 * 33 * 64 * 8;
constexpr size_t OFF_MOD = OFF_BB + (size_t)2 * 32 * 64 * 16 * 8;
constexpr size_t OFF_DEC = OFF_MOD + (size_t)5 * 9216 * 4;
constexpr size_t OFF_H = OFF_DEC + (size_t)4224 * 64 * 4;
constexpr size_t OFF_HID = OFF_H + (size_t)NT * 1024 * 2;
constexpr size_t OFF_U = OFF_HID;
constexpr size_t OFF_Q = OFF_U + (size_t)32 * UROWS * 768 * 2;
constexpr size_t OFF_K = OFF_Q + (size_t)NT * 256 * 2;
constexpr size_t OFF_V = OFF_K + (size_t)NT * 256 * 2;
constexpr size_t OFF_R = OFF_V + (size_t)NT * 512 * 2;
constexpr size_t OFF_GLR = OFF_R + (size_t)NT * 512 * 2;
constexpr size_t OFF_XR = OFF_HID + (size_t)NT * 2816 * 2;
constexpr size_t OFF_YB = OFF_XR + (size_t)NT * 1024 * 2;
constexpr size_t OFF_E = OFF_XR + (size_t)NT * 1024 * 4;
constexpr size_t OFF_BAR = OFF_E + (size_t)32 * 1056 * 256 * 4;
constexpr size_t OFF_SS = OFF_BAR + 16384;
constexpr size_t OFF_BW = OFF_SS + 401408;
constexpr size_t WS_END = OFF_BW + 204800;
static_assert(WS_END <= (size_t)536870912, "workspace");
static_assert(OFF_GLR + (size_t)NT * 32 * 2 <= OFF_XR, "alias overflow");

struct Params { const float* in[33]; float* out; unsigned char* ws; int ph_lo, ph_hi; };

typedef float f32x2_t __attribute__((ext_vector_type(2)));
typedef __bf16 bf16x2_t __attribute__((ext_vector_type(2)));
__device__ __forceinline__ unsigned pk2(float a, float b) { const f32x2_t v = {a, b}; const bf16x2_t r = __builtin_convertvector(v, bf16x2_t); return __builtin_bit_cast(unsigned, r); }
__device__ __forceinline__ bf16_t f2bf(float f) { return (bf16_t)(pk2(f, f) & 0xffffu); }
__device__ __forceinline__ float bf2f(bf16_t h) { return __uint_as_float(((unsigned)h) << 16); }
__device__ __forceinline__ float bflo(unsigned u) { return __uint_as_float(u << 16); }
__device__ __forceinline__ float bfhi(unsigned u) { return __uint_as_float(u & 0xffff0000u); }
__device__ __forceinline__ float rcpf_(float x) { return __builtin_amdgcn_rcpf(x); }
__device__ __forceinline__ float sigm(float x) { return rcpf_(1.f + __expf(-x)); }
__device__ __forceinline__ float siluf_(float x) { return x * sigm(x); }
__device__ __forceinline__ float gelu_tanh(float x) { float y = 0.7978845608028654f * (x + 0.044715f * x * x * x); float t = 1.f - 2.f * rcpf_(1.f + __expf(2.f * y)); return 0.5f * x * (1.f + t); }
__device__ __forceinline__ float wave_sum(float v) {
#pragma unroll
    for (int o = 1; o < 64; o <<= 1) v += __shfl_xor(v, o);
    return v;
}
__device__ __forceinline__ void store_bf4(bf16_t* p, f32x4 v) { uint2 o; o.x = pk2(v[0], v[1]); o.y = pk2(v[2], v[3]); *(uint2*)p = o; }
__device__ __forceinline__ f32x4 load_bf4(const bf16_t* p) { uint2 u = *(const uint2*)p; f32x4 v; v[0] = bflo(u.x); v[1] = bfhi(u.x); v[2] = bflo(u.y); v[3] = bfhi(u.y); return v; }

constexpr int LROW = 72;
namespace pg8 {
#define PG8_LAS __attribute__((address_space(3)))
constexpr int BM = 256, BK = 64, HALF = 128, HTB = HALF * BK * 2, STAGE_BYTES = 8 * HTB;
__device__ __forceinline__ int lds_byte(int r, int c) { const int st = (r >> 4) * 2 + (c >> 5), rr = r & 15, cc = c & 31, ob = rr * 64 + cc * 2; return st * 1024 + (ob ^ (((ob >> 9) & 1) << 5)); }
__device__ __forceinline__ void stage_rc(int b, int& R, int& C) { const int st = b / 1024, sb = b % 1024, swz = sb ^ (((sb >> 9) & 1) << 5); R = (st >> 1) * 16 + swz / 64; C = (st & 1) * 32 + (swz % 64) / 2; }
struct Unit { int pm, pn, g, part; };
struct GemmD { const bf16_t* A; const bf16_t* Bt; int lda, ldb, K, nM, nN, nG; size_t gsA, gsB; int permA; const bf16_t* A2; const bf16_t* Bt2; int dual; };
__device__ __forceinline__ int perm32(int rho) { const int n = rho >> 4, i = rho & 15; return 8 * (i >> 2) + 4 * n + (i & 3); }
struct EpiNoMid { static constexpr bool PERM = false; __device__ __forceinline__ void mid(f32x4 (&)[2][2][4][2], const Unit&, int, int, int, int) const {} };
__device__ __forceinline__ bool unit_at(const GemmD& d, int i, Unit& u) {
    const long L = (long)(d.dual ? (i >> 1) : i) * gridDim.x + blockIdx.x; const int per = d.nM * d.nN;
    u.part = d.dual ? (i & 1) : 0;
    if (L >= (long)per * d.nG) return false;
    if (d.nG == 1) {
        int wgid = (int)L; const int nwg = per;
        { const int q = nwg / 8, r = nwg % 8, xcd = wgid % 8, off = wgid / 8; wgid = (xcd < r ? xcd * (q + 1) : r * (q + 1) + (xcd - r) * q) + off; }
        const int nig = 8 * d.nN, gid = wgid / nig, fm = gid * 8, gsz = (d.nM - fm) < 8 ? (d.nM - fm) : 8;
        u.pm = fm + ((wgid % nig) % gsz); u.pn = (wgid % nig) / gsz; u.g = 0;
    } else if ((d.nG & 7) == 0) {
        const int x = (int)(L & 7), j = (int)(L >> 3), gpx = d.nG >> 3;
        u.g = x * gpx + j / per; const int w = j % per; u.pm = w / d.nN; u.pn = w % d.nN;
    } else { u.g = (int)(L / per); const int w = (int)(L % per); u.pm = w / d.nN; u.pn = w % d.nN; }
    return true;
}
__device__ __forceinline__ const char* a_base(const GemmD& d, const Unit& u) {
    const size_t row0 = d.permA ? (size_t)(((u.pm >> 5) << 13) + 4 * (u.pm & 31)) : (size_t)u.pm * 256;
    return (const char*)(((d.dual && u.part) ? d.A2 : d.A) + (size_t)u.g * d.gsA + row0 * d.lda);
}
__device__ __forceinline__ const char* b_base(const GemmD& d, const Unit& u) { return (const char*)(((d.dual && u.part) ? d.Bt2 : d.Bt) + (size_t)u.g * d.gsB + (size_t)u.pn * 256 * d.ldb); }

template <class Epi>
__device__ __forceinline__ void gemm_phase(PG8_LAS unsigned char* lds, const GemmD g, const Epi& E) {
    const int tid = threadIdx.x, wid = __builtin_amdgcn_readfirstlane(tid >> 6), lane = tid & 63, wr = wid >> 2, wc = wid & 3, fr = lane & 15, fq = lane >> 4;
    const int K = g.K, nt = K / BK;
    unsigned voffA[2], voffB[2];
#pragma unroll
    for (int i = 0; i < 2; ++i) { int R, C; stage_rc(tid * 16 + i * 8192, R, C);
        const int Ra = g.permA ? (((R & 63) << 7) + (R >> 6)) : R;
        const int Rb = Epi::PERM ? ((R & ~31) + perm32(R & 31)) : R;
        voffA[i] = (unsigned)(Ra * g.lda + C) * 2u; voffB[i] = (unsigned)(Rb * g.ldb + C) * 2u; }
    const size_t kstep = (size_t)(BK * 2);
    const size_t hstepA = g.permA ? (size_t)2 * g.lda * 2 : (size_t)HALF * g.lda * 2;
    const size_t hstepB = (size_t)HALF * g.ldb * 2;
    const unsigned ldsw = (unsigned)wid * 1024u;
    const int aoff = lds_byte(wr * 64 + fr, fq * 8), boff = lds_byte(wc * 32 + fr, fq * 8);
#define PG8_SA(b, h) (((b) * 2 + (h)) * HTB)
#define PG8_SB(b, h) ((4 + (b) * 2 + (h)) * HTB)
#define PG8_STAGE(bufoff, gbase, voff) do { _Pragma("unroll") for (int _i = 0; _i < 2; ++_i) \
        __builtin_amdgcn_global_load_lds((const unsigned*)((const char*)(gbase) + (voff)[_i]), (PG8_LAS unsigned*)(lds + (bufoff) + ldsw + _i * 8192), 16, 0, 0); } while (0)
#define PG8_LDA(dst, b, h) do { _Pragma("unroll") for (int m = 0; m < 4; ++m) _Pragma("unroll") for (int k = 0; k < 2; ++k) dst[m][k] = *(const PG8_LAS bf16x8*)(lds + PG8_SA(b, h) + aoff + m * 2048 + k * 1024); } while (0)
#define PG8_LDB(dst, b, h) do { _Pragma("unroll") for (int n = 0; n < 2; ++n) _Pragma("unroll") for (int k = 0; k < 2; ++k) dst[n][k] = *(const PG8_LAS bf16x8*)(lds + PG8_SB(b, h) + boff + n * 2048 + k * 1024); } while (0)
#define PG8_MMA(ai, bj, At, Bt) do { __builtin_amdgcn_s_setprio(1); _Pragma("unroll") for (int m = 0; m < 4; ++m) _Pragma("unroll") for (int n = 0; n < 2; ++n) _Pragma("unroll") for (int k = 0; k < 2; ++k) \
        acc[ai][bj][m][n] = __builtin_amdgcn_mfma_f32_16x16x32_bf16(Bt[n][k], At[m][k], acc[ai][bj][m][n], 0, 0, 0); __builtin_amdgcn_s_setprio(0); } while (0)
#define PG8_WAIT_V(n) asm volatile("s_waitcnt vmcnt(" #n ")" ::: "memory")
#define PG8_WAIT_L(n) asm volatile("s_waitcnt lgkmcnt(" #n ")" ::: "memory")
#define PG8_BAR __builtin_amdgcn_s_barrier()
#define PG8_SCHED __builtin_amdgcn_sched_barrier(0)
    Unit cur, nxt; int ui = 0;
    if (!unit_at(g, 0, cur)) return;
    f32x4 acc[2][2][4][2];
#pragma unroll
    for (int a = 0; a < 2; ++a)
#pragma unroll
        for (int b = 0; b < 2; ++b)
#pragma unroll
            for (int m = 0; m < 4; ++m)
#pragma unroll
                for (int n = 0; n < 2; ++n) acc[a][b][m][n] = (f32x4){0.f, 0.f, 0.f, 0.f};
    bf16x8 At[4][2], B0[2][2], B1[2][2];
    const char* cA = a_base(g, cur); const char* cB = b_base(g, cur);
    PG8_STAGE(PG8_SB(0, 0), cB, voffB); PG8_STAGE(PG8_SA(0, 0), cA, voffA); PG8_STAGE(PG8_SB(0, 1), cB + hstepB, voffB); PG8_STAGE(PG8_SA(0, 1), cA + hstepA, voffA);
    if (wr == 1) PG8_BAR;
    PG8_WAIT_V(4); PG8_BAR;
    PG8_STAGE(PG8_SB(1, 0), cB + kstep, voffB); PG8_STAGE(PG8_SA(1, 0), cA + kstep, voffA); PG8_STAGE(PG8_SB(1, 1), cB + hstepB + kstep, voffB);
    PG8_WAIT_V(6); PG8_BAR;
    for (;;) {
        const bool has_next = unit_at(g, ui + 1, nxt);
        const char* nA = has_next ? a_base(g, nxt) : cA; const char* nB = has_next ? b_base(g, nxt) : cB;
        for (int t = 0; t < nt; t += 2) {
            const bool last = (t == nt - 2);
            const char* a1 = cA + (size_t)(t + 1) * kstep;
            const char* a2 = last ? nA : cA + (size_t)(t + 2) * kstep; const char* b2 = last ? nB : cB + (size_t)(t + 2) * kstep;
            const char* a3 = a2 + kstep; const char* b3 = b2 + kstep;
            PG8_LDB(B0, 0, 0); PG8_SCHED; PG8_LDA(At, 0, 0); PG8_STAGE(PG8_SA(1, 1), a1 + hstepA, voffA);
            PG8_WAIT_L(8); PG8_BAR; PG8_WAIT_L(0); PG8_MMA(0, 0, At, B0); PG8_BAR; PG8_SCHED;
            PG8_LDB(B1, 0, 1); PG8_STAGE(PG8_SB(0, 0), b2, voffB);
            PG8_BAR; PG8_WAIT_L(0); PG8_MMA(0, 1, At, B1); PG8_BAR;
            PG8_LDA(At, 0, 1); PG8_STAGE(PG8_SA(0, 0), a2, voffA);
            PG8_BAR; PG8_WAIT_L(0); PG8_MMA(1, 0, At, B0); PG8_BAR; PG8_SCHED;
            PG8_STAGE(PG8_SB(0, 1), b2 + hstepB, voffB);
            PG8_WAIT_V(6); PG8_BAR; PG8_MMA(1, 1, At, B1); PG8_BAR;
            PG8_LDB(B0, 1, 0); PG8_SCHED; PG8_LDA(At, 1, 0); PG8_STAGE(PG8_SA(0, 1), a2 + hstepA, voffA);
            PG8_WAIT_L(8); PG8_BAR; PG8_WAIT_L(0); PG8_MMA(0, 0, At, B0); PG8_BAR; PG8_SCHED;
            PG8_LDB(B1, 1, 1); PG8_STAGE(PG8_SB(1, 0), b3, voffB);
            PG8_BAR; PG8_WAIT_L(0); PG8_MMA(0, 1, At, B1); PG8_BAR;
            PG8_LDA(At, 1, 1); PG8_STAGE(PG8_SA(1, 0), a3, voffA);
            PG8_BAR; PG8_WAIT_L(0); PG8_MMA(1, 0, At, B0); PG8_BAR; PG8_SCHED;
            PG8_STAGE(PG8_SB(1, 1), b3 + hstepB, voffB);
            PG8_WAIT_V(6); PG8_BAR; PG8_MMA(1, 1, At, B1); PG8_BAR;
        }
        const bool midp = g.dual && cur.part == 0;
        if (midp) E.mid(acc, cur, wr, wc, fr, fq); else E(acc, cur, wr, wc, fr, fq);
        if (!has_next) break;
        if (!midp)
#pragma unroll
        for (int a = 0; a < 2; ++a)
#pragma unroll
            for (int b = 0; b < 2; ++b)
#pragma unroll
                for (int m = 0; m < 4; ++m)
#pragma unroll
                    for (int n = 0; n < 2; ++n) acc[a][b][m][n] = (f32x4){0.f, 0.f, 0.f, 0.f};
        cur = nxt; cA = nA; cB = nB; ++ui;
    }
    PG8_WAIT_V(0);
    if (wr == 0) PG8_BAR;
    PG8_BAR;
#undef PG8_SA
#undef PG8_SB
#undef PG8_STAGE
#undef PG8_LDA
#undef PG8_LDB
#undef PG8_MMA
#undef PG8_WAIT_V
#undef PG8_WAIT_L
#undef PG8_BAR
#undef PG8_SCHED
}
}
using pg8::Unit; using pg8::GemmD;
typedef f32x4 AccT[2][2][4][2];
#define EPI_LOOP _Pragma("unroll") for (int ai = 0; ai < 2; ++ai) _Pragma("unroll") for (int bj = 0; bj < 2; ++bj) _Pragma("unroll") for (int mm = 0; mm < 4; ++mm) _Pragma("unroll") for (int nn = 0; nn < 2; ++nn) { \
    const int m = 256 * u.pm + 128 * ai + 64 * wr + 16 * mm + fr; const int n = 256 * u.pn + 128 * bj + 32 * wc + 16 * nn + 4 * fq; const f32x4 v = acc[ai][bj][mm][nn];
#define EPI_LOOP_END }
#define EPI_LOOP_NV _Pragma("unroll") for (int ai = 0; ai < 2; ++ai) _Pragma("unroll") for (int bj = 0; bj < 2; ++bj) _Pragma("unroll") for (int mm = 0; mm < 4; ++mm) _Pragma("unroll") for (int nn = 0; nn < 2; ++nn) { \
    const int m = 256 * u.pm + 128 * ai + 64 * wr + 16 * mm + fr; const int n = 256 * u.pn + 128 * bj + 32 * wc + 16 * nn + 4 * fq;

__device__ __forceinline__ int map_row(int mode, int n) {
    if (mode == 1) return ((n >> 7) << 8) + (n & 127);
    if (mode == 2) return ((n >> 7) << 8) + 128 + (n & 127);
    if (mode == 3) {
        if (n < 2048) return n;
        if (n < 2080) return 4096 + (n - 2048);
        if (n < 3104) { const int j = n - 2080; return 2048 + ((j >> 4) << 5) + (((j >> 2) & 3) << 3) + (j & 3); }
        { const int j = n - 3104; return 2048 + ((j >> 4) << 5) + (((j >> 2) & 3) << 3) + 4 + (j & 3); }
    }
    return n;
}
struct TItem { const float* src; bf16_t* dst; int K, mode, n0; };
__device__ __forceinline__ void transpose_load(const TItem& t, int N, float (&v)[8]) {
#pragma unroll
    for (int i = 0; i < 8; ++i) v[i] = t.src[(size_t)(8 * i) * N];
}
__device__ __forceinline__ void transpose_store(const TItem& t, const float (&v)[8], float* scr) {
    const int tid = threadIdx.x & 255;
#pragma unroll
    for (int i = 0; i < 8; ++i) scr[((tid >> 5) + 8 * i) * 33 + (tid & 31)] = v[i];
    __syncthreads();
    const int n = tid >> 3, kc = (tid & 7) * 8;
    const float* s = scr + kc * 33 + n;
    uint4 o; o.x = pk2(s[0], s[33]); o.y = pk2(s[66], s[99]); o.z = pk2(s[132], s[165]); o.w = pk2(s[198], s[231]);
    const int nd = map_row(t.mode, t.n0 + n);
    *(uint4*)(t.dst + (size_t)nd * t.K) = o;
    __syncthreads();
}
__device__ __forceinline__ void ada_item(const Params& P, int item, float* sm) {
    float* sv = sm; float* red = sm + 5 * 1024;
    const int tid = threadIdx.x & 255;
    for (int e = tid; e < 5 * 1024; e += 256) { const int r = e >> 10, k = e & 1023; const float c = r < 4 ? P.in[1][r * 1024 + k] : P.in[3][k]; sv[e] = siluf_(c); }
    __syncthreads();
    const int cgp = tid & 15, kg = tid >> 4, n0 = item * 64;
    f32x4 a[5];
#pragma unroll
    for (int r = 0; r < 5; ++r) a[r] = (f32x4){0.f, 0.f, 0.f, 0.f};
    const float* wp = P.in[4] + (size_t)(kg * 64) * 9216 + n0 + cgp * 4;
#pragma unroll 16
    for (int kk = 0; kk < 64; ++kk) {
        const f32x4 w4 = *(const f32x4*)(wp + (size_t)kk * 9216);
#pragma unroll
        for (int r = 0; r < 5; ++r) { const float s = sv[r * 1024 + kg * 64 + kk]; a[r] += w4 * s; }
    }
#pragma unroll
    for (int r = 0; r < 5; ++r) *(f32x4*)(red + (kg * 5 + r) * 64 + cgp * 4) = a[r];
    __syncthreads();
    for (int e = tid; e < 320; e += 256) {
        const int r = e >> 6, col = e & 63; float s = P.in[5][n0 + col];
#pragma unroll
        for (int g = 0; g < 16; ++g) s += red[(g * 5 + r) * 64 + col];
        ((float*)(P.ws + OFF_MOD))[r * 9216 + n0 + col] = s;
    }
    __syncthreads();
}

__device__ __forceinline__ float2 cmul(float2 a, float2 b) { return make_float2(a.x * b.x - a.y * b.y, a.x * b.y + a.y * b.x); }

__device__ __forceinline__ void phase0(const Params& P, unsigned char* smem) {
    const int hb = threadIdx.x >> 8;
    float* scr = (float*)(smem + hb * HALF_LDS);
    struct TW { int in; int K, N; size_t off; int mode; };
    const TW tw[13] = {
        {7, 1024, 2816, OFF_WGU1, 1}, {8, 1024, 2816, OFF_WGU1, 2}, {9, 2816, 1024, OFF_WDN1, 0},
        {29, 1024, 2816, OFF_WGU2, 1}, {30, 1024, 2816, OFF_WGU2, 2}, {31, 2816, 1024, OFF_WDN2, 0},
        {11, 1024, 4128, OFF_WIN, 3}, {20, 512, 512, OFF_WGLU, 0}, {22, 512, 1024, OFF_WS5O, 0}, {26, 512, 1024, OFF_WGLO, 0}, {27, 1024, 1024, OFF_WWO, 0},
        {0, 0, 0, 0, 0}, {0, 0, 0, 0, 0}};
    int total = 0;
#pragma unroll
    for (int i = 0; i < 11; ++i) total += (tw[i].K >> 6) * (tw[i].N >> 5);
    const int n_ada = 144;
    for (int base = blockIdx.x * 2; base < n_ada; base += gridDim.x * 2) ada_item(P, base + hb, scr);
    auto lookup = [&](int it, TItem& t, int& N) {
        int r = it < total ? it : total - 1;
        t.src = nullptr; t.dst = nullptr; t.K = 0; t.mode = 0; t.n0 = 0; N = 0;
#pragma unroll
        for (int i = 0; i < 11; ++i) {
            const int cnt = (tw[i].K >> 6) * (tw[i].N >> 5);
            if (r >= 0 && r < cnt) {
                const int nblk = tw[i].N >> 5, kb = r / nblk, nb = r - kb * nblk, k0 = kb * 64, n0 = nb * 32, tid = threadIdx.x & 255;
                N = tw[i].N; t.K = tw[i].K; t.mode = tw[i].mode; t.n0 = n0;
                t.src = P.in[tw[i].in] + (size_t)(k0 + (tid >> 5)) * tw[i].N + n0 + (tid & 31);
                t.dst = (bf16_t*)(P.ws + tw[i].off) + k0 + (tid & 7) * 8;
            }
            r -= cnt;
        }
    };
    {
        const int stride = gridDim.x * 2;
        int it = blockIdx.x * 2 + hb;
        TItem cur, nxt; int Nc = 0, Nn = 0; float vn[8];
        if (blockIdx.x * 2 < total) { lookup(it, nxt, Nn); transpose_load(nxt, Nn, vn); }
        for (int base = blockIdx.x * 2; base < total; base += stride) {
            float v[8];
#pragma unroll
            for (int i = 0; i < 8; ++i) v[i] = vn[i];
            cur = nxt; Nc = Nn;
            if (base + stride < total) { lookup(it + stride, nxt, Nn); transpose_load(nxt, Nn, vn); }
            transpose_store(cur, v, scr);
            it += stride;
        }
    }
    const int gtid = blockIdx.x * NTHR + threadIdx.x, gsz = gridDim.x * NTHR;
    for (int e = gtid; e < NT + 2 * NL; e += gsz) ((float*)(P.ws + OFF_SS))[e] = 0.f;
    float2* LP = (float2*)(P.ws + OFF_LP); float2* BB = (float2*)(P.ws + OFF_BB);
    for (int e = gtid; e < 2 * 32 * 33 * 64; e += gsz) {
        const int p = e & 63, tau = (e >> 6) % 33, dg = e / (33 * 64);
        const float lre = fminf(P.in[12][dg * 64 + p], -1e-4f), lim = P.in[13][dg * 64 + p], dt = expf(P.in[14][dg]);
        const float mag = expf(lre * dt * (float)tau), ang = (lim * dt) * (float)tau;
        float sn, cs; sincosf(ang, &sn, &cs);
        LP[e] = make_float2(mag * cs, mag * sn);
    }
    for (int e = gtid; e < 2 * 32 * 64 * 16; e += gsz) {
        const int dgp = e >> 4;
        const int dg = dgp >> 6;
        const float lre = fminf(P.in[12][dgp], -1e-4f), lim = P.in[13][dgp], dt = expf(P.in[14][dg]);
        const float mag = expf(lre * dt), ang = lim * dt;
        float sn, cs; sincosf(ang, &sn, &cs);
        const float ar = mag * cs - 1.f, ai = mag * sn;
        const float den = lre * lre + lim * lim;
        const float qr = (ar * lre + ai * lim) / den, qi = (ai * lre - ar * lim) / den;
        BB[e] = cmul(make_float2(qr, qi), make_float2(P.in[15][e], P.in[16][e]));
    }
}

__device__ __forceinline__ void norm_row_pre(const f32x4 (&v)[4], const float* __restrict__ g, const float* __restrict__ shift, const float* __restrict__ scale, bf16_t* __restrict__ dst, int lane) {
    float ss = 0.f;
#pragma unroll
    for (int j = 0; j < 4; ++j) ss += v[j][0] * v[j][0] + v[j][1] * v[j][1] + v[j][2] * v[j][2] + v[j][3] * v[j][3];
    ss = wave_sum(ss);
    const float rstd = rsqrtf(ss * (1.f / 1024.f) + 1e-6f);
#pragma unroll
    for (int j = 0; j < 4; ++j) {
        const int c4 = lane + 64 * j;
        const f32x4 g4 = ((const f32x4*)g)[c4], sh = ((const f32x4*)shift)[c4], sc = ((const f32x4*)scale)[c4];
        f32x4 h = (v[j] * rstd) * g4; h = h * (sc + 1.f) + sh;
        store_bf4(dst + c4 * 4, h);
    }
}
__device__ __forceinline__ void norm_row(const float* __restrict__ src, const float* __restrict__ g, const float* __restrict__ shift, const float* __restrict__ scale, bf16_t* __restrict__ dst, int lane) {
    f32x4 v[4]; float ss = 0.f;
#pragma unroll
    for (int j = 0; j < 4; ++j) { v[j] = ((const f32x4*)src)[lane + 64 * j]; ss += v[j][0] * v[j][0] + v[j][1] * v[j][1] + v[j][2] * v[j][2] + v[j][3] * v[j][3]; }
    ss = wave_sum(ss);
    const float rstd = rsqrtf(ss * (1.f / 1024.f) + 1e-6f);
#pragma unroll
    for (int j = 0; j < 4; ++j) {
        const int c4 = lane + 64 * j;
        const f32x4 g4 = ((const f32x4*)g)[c4], sh = ((const f32x4*)shift)[c4], sc = ((const f32x4*)scale)[c4];
        f32x4 h = (v[j] * rstd) * g4; h = h * (sc + 1.f) + sh;
        store_bf4(dst + c4 * 4, h);
    }
}

__device__ __forceinline__ void phase1(const Params& P) {
    const int lane = threadIdx.x & 63, w = threadIdx.x >> 6;
    const float* mod = (const float*)(P.ws + OFF_MOD);
    bf16_t* H = (bf16_t*)(P.ws + OFF_H);
    {
        const int stride = gridDim.x * 8;
        int row = blockIdx.x * 8 + w;
        f32x4 vn[4];
        if (row < NT) { const float* src = row < NL ? P.in[0] + (size_t)row * 1024 : P.in[2] + (size_t)(row - NL) * 1024;
#pragma unroll
            for (int j = 0; j < 4; ++j) vn[j] = ((const f32x4*)src)[lane + 64 * j]; }
        while (row < NT) {
            f32x4 v[4];
#pragma unroll
            for (int j = 0; j < 4; ++j) v[j] = vn[j];
            const int nrow = row + stride;
            if (nrow < NT) { const float* src = nrow < NL ? P.in[0] + (size_t)nrow * 1024 : P.in[2] + (size_t)(nrow - NL) * 1024;
#pragma unroll
                for (int j = 0; j < 4; ++j) vn[j] = ((const f32x4*)src)[lane + 64 * j]; }
            const int mr = row < NL ? (row >> 13) : 4;
            norm_row_pre(v, P.in[6], mod + mr * 9216 + 0, mod + mr * 9216 + 1024, H + (size_t)row * 1024, lane);
            if (row >= NL) {
#pragma unroll
                for (int j = 0; j < 4; ++j) ((f32x4*)((float*)(P.ws + OFF_E) + (size_t)(row - NL) * 1024))[lane + 64 * j] = v[j];
            }
            row = nrow;
        }
    }
    for (int r0 = blockIdx.x * 32 + w * 4; r0 < 4352 + 5632; r0 += gridDim.x * 32)
    for (int r = r0; r < r0 + 4; ++r) {
        const bool first = r < 4352;
        const bf16_t* wt = first ? (const bf16_t*)(P.ws + OFF_WIN) + (size_t)r * 1024 : (const bf16_t*)(P.ws + OFF_WGU2) + (size_t)(r - 4352) * 1024;
        const float* sh = mod + (first ? 3 : 6) * 1024 + lane * 16;
        const uint4 w0 = *(const uint4*)(wt + lane * 16), w1 = *(const uint4*)(wt + lane * 16 + 8);
        const float wv[16] = {bflo(w0.x), bfhi(w0.x), bflo(w0.y), bfhi(w0.y), bflo(w0.z), bfhi(w0.z), bflo(w0.w), bfhi(w0.w),
                              bflo(w1.x), bfhi(w1.x), bflo(w1.y), bfhi(w1.y), bflo(w1.z), bfhi(w1.z), bflo(w1.w), bfhi(w1.w)};
        float* BW = (float*)(P.ws + OFF_BW);
#pragma unroll
        for (int mr = 0; mr < 5; ++mr) {
            float a = 0.f;
#pragma unroll
            for (int q = 0; q < 4; ++q) { const f32x4 s4 = *(const f32x4*)(sh + mr * 9216 + q * 4); a += s4[0] * wv[q * 4] + s4[1] * wv[q * 4 + 1] + s4[2] * wv[q * 4 + 2] + s4[3] * wv[q * 4 + 3]; }
            a = wave_sum(a);
            if (lane == 0) { if (first) BW[mr * 4352 + r] = a; else BW[5 * 4352 + mr * 5632 + (r - 4352)] = a; }
        }
    }
    const int gtid = blockIdx.x * NTHR + threadIdx.x, gsz = gridDim.x * NTHR;
    const float2* LP = (const float2*)(P.ws + OFF_LP); const float2* BB = (const float2*)(P.ws + OFF_BB);
    float* KD = (float*)(P.ws + OFF_KD);
    {
        constexpr int N = 2 * 32 * 32 * 256;
        int e0 = gtid;
        for (; e0 + 3 * gsz < N; e0 += 4 * gsz) {
            float sacc[4] = {0.f, 0.f, 0.f, 0.f};
#pragma unroll 2
            for (int p = 0; p < 64; ++p) {
#pragma unroll
                for (int q = 0; q < 4; ++q) {
                    const int e = e0 + q * gsz;
                    const int cp = e & 15, c = (e >> 4) & 15, tau = (e >> 8) & 31, dg = e >> 13;
                    const float2 C = make_float2(P.in[17][(dg * 16 + c) * 64 + p], P.in[18][(dg * 16 + c) * 64 + p]);
                    const float2 z = cmul(LP[(dg * 33 + tau) * 64 + p], BB[(dg * 64 + p) * 16 + cp]);
                    sacc[q] += C.x * z.x - C.y * z.y;
                }
            }
#pragma unroll
            for (int q = 0; q < 4; ++q) KD[e0 + q * gsz] = sacc[q];
        }
        for (; e0 < N; e0 += gsz) {
            const int e = e0, cp = e & 15, c = (e >> 4) & 15, tau = (e >> 8) & 31, dg = e >> 13;
            float sa = 0.f;
            for (int p = 0; p < 64; ++p) {
                const float2 C = make_float2(P.in[17][(dg * 16 + c) * 64 + p], P.in[18][(dg * 16 + c) * 64 + p]);
                const float2 z = cmul(LP[(dg * 33 + tau) * 64 + p], BB[(dg * 64 + p) * 16 + cp]);
                sa += C.x * z.x - C.y * z.y;
            }
            KD[e] = sa;
        }
    }
    bf16_t* WE = (bf16_t*)(P.ws + OFF_WE);
    auto we_val = [&](int e) -> float {
        const int k = e & 511, n = (e >> 9) & 255, g = e >> 17;
        const int s = k >> 4, cp = k & 15, d = n >> 7, ri = (n >> 6) & 1, p = n & 63, dg = d * 32 + g;
        const int tau = d == 0 ? 31 - s : s;
        const float2 z = cmul(LP[(dg * 33 + tau) * 64 + p], BB[(dg * 64 + p) * 16 + cp]);
        return ri ? z.y : z.x;
    };
    {
        constexpr int N = 32 * 256 * 512;
        int e0 = gtid;
        for (; e0 + 3 * gsz < N; e0 += 4 * gsz) {
            float val[4];
#pragma unroll
            for (int q = 0; q < 4; ++q) val[q] = we_val(e0 + q * gsz);
#pragma unroll
            for (int q = 0; q < 4; ++q) WE[e0 + q * gsz] = f2bf(val[q]);
        }
        for (; e0 < N; e0 += gsz) WE[e0] = f2bf(we_val(e0));
    }
    bf16_t* WY = (bf16_t*)(P.ws + OFF_WY);
    auto po_val = [&](int e) -> float {
        const int kk = e & 255, n = (e >> 8) & 511, g = e >> 17;
        const int t = n >> 4, c = n & 15, d = kk >> 7, ri = (kk >> 6) & 1, p = kk & 63, dg = d * 32 + g;
        const int tau = d == 0 ? t + 1 : 32 - t;
        const float2 C = make_float2(P.in[17][(dg * 16 + c) * 64 + p], P.in[18][(dg * 16 + c) * 64 + p]);
        const float2 z = cmul(C, LP[(dg * 33 + tau) * 64 + p]);
        return ri ? -z.y : z.x;
    };
    auto po_idx = [&](int e) -> size_t { const int kk = e & 255, n = (e >> 8) & 511, g = e >> 17; return ((size_t)g * 512 + n) * 768 + 512 + kk; };
    {
        constexpr int N = 32 * 512 * 256;
        int e0 = gtid;
        for (; e0 + 3 * gsz < N; e0 += 4 * gsz) {
            float val[4];
#pragma unroll
            for (int q = 0; q < 4; ++q) val[q] = po_val(e0 + q * gsz);
#pragma unroll
            for (int q = 0; q < 4; ++q) WY[po_idx(e0 + q * gsz)] = f2bf(val[q]);
        }
        for (; e0 < N; e0 += gsz) WY[po_idx(e0)] = f2bf(po_val(e0));
    }
}

__device__ __forceinline__ void phase4(const Params& P) {
    const int lane = threadIdx.x & 63, w = threadIdx.x >> 6;
    const float* mod = (const float*)(P.ws + OFF_MOD);
    bf16_t* H = (bf16_t*)(P.ws + OFF_H);
    const float* XRC = (const float*)(P.ws + OFF_E);
    float* ss2 = (float*)(P.ws + OFF_SS);
    for (int r0 = blockIdx.x * 32 + w * 4; r0 < NC; r0 += gridDim.x * 32)
    for (int r = r0; r < r0 + 4; ++r) {
        const float* src = XRC + (size_t)r * 1024;
        float ss = 0.f;
#pragma unroll
        for (int j = 0; j < 4; ++j) {
            const int c4 = lane + 64 * j;
            const f32x4 v = ((const f32x4*)src)[c4];
            ss += v[0] * v[0] + v[1] * v[1] + v[2] * v[2] + v[3] * v[3];
            const f32x4 g4 = ((const f32x4*)P.in[10])[c4], sc = ((const f32x4*)(mod + 4 * 9216 + 4 * 1024))[c4];
            store_bf4(H + (size_t)(NL + r) * 1024 + c4 * 4, v * (g4 * (sc + 1.f)));
        }
        ss = wave_sum(ss);
        if (lane == 0) ss2[NL + r] = ss;
    }
    const bool split = gridDim.x > 64;
    if (split && blockIdx.x < 32) return;
    const int gtid = (split ? (int)blockIdx.x - 32 : (int)blockIdx.x) * NTHR + threadIdx.x, gsz = (split ? (int)gridDim.x - 32 : (int)gridDim.x) * NTHR;
    const float* KD = (const float*)(P.ws + OFF_KD);
    bf16_t* WY = (bf16_t*)(P.ws + OFF_WY);
    auto kf_val = [&](int e) -> float {
        const int k = e & 511, n = (e >> 9) & 511, g = e >> 18;
        const int t = n >> 4, c = n & 15, s = k >> 4, cp = k & 15;
        const int d0 = t - s, d1 = s - t;
        const float a0 = KD[(((0 * 32 + g) * 32 + (d0 > 0 ? d0 : 0)) * 16 + c) * 16 + cp];
        const float a1 = KD[(((1 * 32 + g) * 32 + (d1 > 0 ? d1 : 0)) * 16 + c) * 16 + cp];
        return (s <= t ? a0 : 0.f) + (s >= t ? a1 : 0.f);
    };
    auto kf_idx = [&](int e) -> size_t { const int k = e & 511, n = (e >> 9) & 511, g = e >> 18; return ((size_t)g * 512 + n) * 768 + k; };
    {
        constexpr int N = 32 * 512 * 512;
        int e0 = gtid;
        for (; e0 + 3 * gsz < N; e0 += 4 * gsz) {
            float val[4];
#pragma unroll
            for (int q = 0; q < 4; ++q) val[q] = kf_val(e0 + q * gsz);
#pragma unroll
            for (int q = 0; q < 4; ++q) WY[kf_idx(e0 + q * gsz)] = f2bf(val[q]);
        }
        for (; e0 < N; e0 += gsz) WY[kf_idx(e0)] = f2bf(kf_val(e0));
    }
}

__device__ __forceinline__ void phase15(const Params& P) {
    const int lane = threadIdx.x & 63, w = threadIdx.x >> 6;
    const float* ss4 = (const float*)(P.ws + OFF_SS) + NT + NL;
    const int stride = gridDim.x * 8;
    int row = blockIdx.x * 8 + w;
    f32x4 vn[4]; float sn = 0.f;
    if (row < NL) { sn = ss4[row];
#pragma unroll
        for (int j = 0; j < 4; ++j) vn[j] = ((const f32x4*)(P.out + (size_t)row * 1024))[lane + 64 * j]; }
    f32x4 fn[4];
#pragma unroll
    for (int j = 0; j < 4; ++j) fn[j] = ((const f32x4*)P.in[32])[lane + 64 * j];
    while (row < NL) {
        f32x4 v[4]; const float sc = sn;
#pragma unroll
        for (int j = 0; j < 4; ++j) v[j] = vn[j];
        const int nrow = row + stride;
        if (nrow < NL) { sn = ss4[nrow];
#pragma unroll
            for (int j = 0; j < 4; ++j) vn[j] = ((const f32x4*)(P.out + (size_t)nrow * 1024))[lane + 64 * j]; }
        const float rstd = rsqrtf(sc * (1.f / 1024.f) + 1e-6f);
        f32x4* o = (f32x4*)(P.out + (size_t)row * 1024);
#pragma unroll
        for (int j = 0; j < 4; ++j) o[lane + 64 * j] = (v[j] * rstd) * fn[j];
        row = nrow;
    }
}

template <int NORM> struct EpiFfnUp : pg8::EpiNoMid {
    static constexpr bool PERM = true;
    bf16_t* HID; const float* ss; const float* BW;
    __device__ __forceinline__ void operator()(const AccT& acc, const Unit& u, int wr, int wc, int fr, int fq) const {
        f32x4 bwg[2], bwu[2]; float rstd[2][4];
        if (NORM) {
            const float* bw = BW + ((256 * u.pm) >> 13) * 5632 + 256 * u.pn + 32 * wc + 8 * fq;
#pragma unroll
            for (int nn = 0; nn < 2; ++nn) { bwg[nn] = *(const f32x4*)(bw + 4 * nn); bwu[nn] = *(const f32x4*)(bw + 128 + 4 * nn); }
#pragma unroll
            for (int ai = 0; ai < 2; ++ai)
#pragma unroll
                for (int mm = 0; mm < 4; ++mm) rstd[ai][mm] = rsqrtf(ss[256 * u.pm + 128 * ai + 64 * wr + 16 * mm + fr] * (1.f / 1024.f) + 1e-6f);
        }
        const int oc = 128 * u.pn + 32 * wc + 8 * fq;
#pragma unroll
        for (int ai = 0; ai < 2; ++ai)
#pragma unroll
            for (int mm = 0; mm < 4; ++mm) {
                const int m = 256 * u.pm + 128 * ai + 64 * wr + 16 * mm + fr;
                f32x4 o[2];
#pragma unroll
                for (int nn = 0; nn < 2; ++nn) {
                    f32x4 g = acc[ai][0][mm][nn], uu = acc[ai][1][mm][nn];
                    if (NORM) { g = g * rstd[ai][mm] + bwg[nn]; uu = uu * rstd[ai][mm] + bwu[nn]; }
#pragma unroll
                    for (int r = 0; r < 4; ++r) o[nn][r] = siluf_(g[r]) * uu[r];
                }
                *(uint4*)(HID + (size_t)m * FF + oc) = make_uint4(pk2(o[0][0], o[0][1]), pk2(o[0][2], o[0][3]), pk2(o[1][0], o[1][1]), pk2(o[1][2], o[1][3]));
            }
    }
};
template <int MODE> struct EpiRes : pg8::EpiNoMid {
    static constexpr bool PERM = true;
    const float* x; bf16_t* XRb; float* out; bf16_t* Hn; const float* mod; const float* gnext; float* ss;
    __device__ __forceinline__ void operator()(const AccT& acc, const Unit& u, int wr, int wc, int fr, int fq) const {
        constexpr int GJ = MODE == 0 ? 2 : (MODE == 1 ? 5 : 8), SJ = MODE == 0 ? 4 : 7;
        constexpr float COEF = MODE == 1 ? 1.f : 0.5f;
        const float* mb = mod + ((256 * u.pm) >> 13) * 9216;
        const int nb = 256 * u.pn + 32 * wc + 8 * fq;
        f32x4 gate[2][2]; uint2 gmp[2][2];
#pragma unroll
        for (int bj = 0; bj < 2; ++bj)
#pragma unroll
            for (int nn = 0; nn < 2; ++nn) {
                const int n = nb + 128 * bj + 4 * nn;
                gate[bj][nn] = *(const f32x4*)(mb + GJ * 1024 + n) * COEF;
                if (MODE < 2) { const f32x4 t = *(const f32x4*)(gnext + n) * (*(const f32x4*)(mb + SJ * 1024 + n) + 1.f); gmp[bj][nn] = make_uint2(pk2(t[0], t[1]), pk2(t[2], t[3])); }
            }
#pragma unroll
        for (int ai = 0; ai < 2; ++ai)
#pragma unroll
        for (int mh = 0; mh < 2; ++mh) {
            const size_t rb = (size_t)(256 * u.pm + 128 * ai + 64 * wr + 32 * mh + fr) * 1024 + nb;
            f32x4 xf[MODE == 0 ? 2 : 1][2][2]; uint4 xh[MODE == 0 ? 1 : 2][2];
#pragma unroll
            for (int mm = 0; mm < 2; ++mm)
#pragma unroll
                for (int bj = 0; bj < 2; ++bj) {
                    const size_t idx = rb + (size_t)mm * 16 * 1024 + 128 * bj;
                    if (MODE == 0) { xf[mm][bj][0] = *(const f32x4*)(x + idx); xf[mm][bj][1] = *(const f32x4*)(x + idx + 4); }
                    else xh[mm][bj] = *(const uint4*)(XRb + idx);
                }
#pragma unroll
            for (int mm = 0; mm < 2; ++mm) {
                float part = 0.f;
#pragma unroll
                for (int bj = 0; bj < 2; ++bj) {
                    const size_t idx = rb + (size_t)mm * 16 * 1024 + 128 * bj;
                    f32x4 x0, x1;
                    if (MODE == 0) { x0 = xf[mm][bj][0]; x1 = xf[mm][bj][1]; }
                    else { const uint4 h4 = xh[mm][bj]; x0 = (f32x4){bflo(h4.x), bfhi(h4.x), bflo(h4.y), bfhi(h4.y)}; x1 = (f32x4){bflo(h4.z), bfhi(h4.z), bflo(h4.w), bfhi(h4.w)}; }
                    const f32x4 n0 = x0 + gate[bj][0] * acc[ai][bj][2 * mh + mm][0], n1 = x1 + gate[bj][1] * acc[ai][bj][2 * mh + mm][1];
                    part += (n0[0] * n0[0] + n0[1] * n0[1] + n0[2] * n0[2] + n0[3] * n0[3]) + (n1[0] * n1[0] + n1[1] * n1[1] + n1[2] * n1[2] + n1[3] * n1[3]);
                    if (MODE < 2) {
                        *(uint4*)(XRb + idx) = make_uint4(pk2(n0[0], n0[1]), pk2(n0[2], n0[3]), pk2(n1[0], n1[1]), pk2(n1[2], n1[3]));
                        const f32x4 g0 = {bflo(gmp[bj][0].x), bfhi(gmp[bj][0].x), bflo(gmp[bj][0].y), bfhi(gmp[bj][0].y)}, g1 = {bflo(gmp[bj][1].x), bfhi(gmp[bj][1].x), bflo(gmp[bj][1].y), bfhi(gmp[bj][1].y)};
                        const f32x4 h0 = n0 * g0, h1 = n1 * g1;
                        *(uint4*)(Hn + idx) = make_uint4(pk2(h0[0], h0[1]), pk2(h0[2], h0[3]), pk2(h1[0], h1[1]), pk2(h1[2], h1[3]));
                    } else { *(f32x4*)(out + idx) = n0; *(f32x4*)(out + idx + 4) = n1; }
                }
                part += __shfl_xor(part, 16); part += __shfl_xor(part, 32);
                if (fq == 0) (void)__hip_atomic_fetch_add(ss + 256 * u.pm + 128 * ai + 64 * wr + 32 * mh + 16 * mm + fr, part, __ATOMIC_RELAXED, __HIP_MEMORY_SCOPE_AGENT);
            }
        }
    }
};
template <int NORM>
__device__ __forceinline__ void phase_ffn_up(const Params& P, PG8_LAS unsigned char* lds, size_t off_w, int M) {
    GemmD g{}; g.A = (const bf16_t*)(P.ws + OFF_H); g.Bt = (const bf16_t*)(P.ws + off_w); g.lda = 1024; g.ldb = 1024; g.K = 1024; g.nM = M >> 8; g.nN = 22; g.nG = 1;
    EpiFfnUp<NORM> E; E.HID = (bf16_t*)(P.ws + OFF_HID); E.ss = (const float*)(P.ws + OFF_SS) + NT; E.BW = (const float*)(P.ws + OFF_BW) + 5 * 4352;
    pg8::gemm_phase(lds, g, E);
}
struct EpiFfnDownCtx : pg8::EpiNoMid {
    float* XR; const float* mod;
    __device__ __forceinline__ void operator()(const AccT& acc, const Unit& u, int wr, int wc, int fr, int fq) const {
#pragma unroll
        for (int bj = 0; bj < 2; ++bj)
#pragma unroll
            for (int nn = 0; nn < 2; ++nn) {
                const int n = 256 * u.pn + 128 * bj + 32 * wc + 16 * nn + 4 * fq;
                const f32x4 gt = *(const f32x4*)(mod + 4 * 9216 + 2 * 1024 + n) * 0.5f;
                float* xb = XR + (size_t)(256 * u.pm + 64 * wr + fr) * 1024 + n;
#pragma unroll
                for (int ai = 0; ai < 2; ++ai)
#pragma unroll
                    for (int mm = 0; mm < 4; ++mm) {
                        float* xp = xb + (size_t)(128 * ai + 16 * mm) * 1024;
                        const f32x4 v = acc[ai][bj][mm][nn] * gt;
#pragma unroll
                        for (int r = 0; r < 4; ++r) (void)__hip_atomic_fetch_add(xp + r, v[r], __ATOMIC_RELAXED, __HIP_MEMORY_SCOPE_AGENT);
                    }
                asm volatile("" ::: "memory");
            }
    }
};
template <int FIRST>
__device__ __forceinline__ void phase_ffn_down(const Params& P, PG8_LAS unsigned char* lds, size_t off_w) {
    GemmD g{}; g.A = (const bf16_t*)(P.ws + OFF_HID); g.Bt = (const bf16_t*)(P.ws + off_w); g.lda = FF; g.ldb = FF; g.K = FF; g.nM = NL >> 8; g.nN = 4; g.nG = 1;
    EpiRes<FIRST ? 0 : 2> E; E.x = P.in[0]; E.XRb = (bf16_t*)(P.ws + OFF_XR); E.out = P.out; E.Hn = (bf16_t*)(P.ws + OFF_H); E.mod = (const float*)(P.ws + OFF_MOD);
    E.gnext = P.in[10]; E.ss = (float*)(P.ws + OFF_SS) + (FIRST ? 0 : NT + NL);
    pg8::gemm_phase(lds, g, E);
    if (FIRST) {
        GemmD c{}; c.A = (const bf16_t*)(P.ws + OFF_HID) + (size_t)NL * FF; c.Bt = g.Bt; c.lda = FF; c.ldb = FF; c.K = 256; c.nM = 4; c.nN = 4; c.nG = 11; c.gsA = 256; c.gsB = 256;
        EpiFfnDownCtx EC; EC.XR = (float*)(P.ws + OFF_E); EC.mod = E.mod;
        pg8::gemm_phase(lds, c, EC);
    }
}
__device__ __forceinline__ uint4 pack8(f32x4 a, f32x4 b) { return make_uint4(pk2(a[0], a[1]), pk2(a[2], a[3]), pk2(b[0], b[1]), pk2(b[2], b[3])); }
struct EpiWin : pg8::EpiNoMid {
    static constexpr bool PERM = true;
    bf16_t *U, *Q, *Kb, *V, *R, *GLR, *GA, *GB; const float* ss; const float* BW;
    __device__ __forceinline__ void operator()(const AccT& acc, const Unit& u, int wr, int wc, int fr, int fq) const {
        f32x4 bias[2][2]; float rstd[2][4];
        const int m0 = 256 * u.pm, nb = 256 * u.pn + 32 * wc + 8 * fq;
        {
            const float* bw = BW + (m0 < NL ? (m0 >> 13) : 4) * 4352 + nb;
#pragma unroll
            for (int bj = 0; bj < 2; ++bj)
#pragma unroll
                for (int nn = 0; nn < 2; ++nn) bias[bj][nn] = *(const f32x4*)(bw + 128 * bj + 4 * nn);
#pragma unroll
            for (int ai = 0; ai < 2; ++ai)
#pragma unroll
                for (int mm = 0; mm < 4; ++mm) rstd[ai][mm] = rsqrtf(ss[m0 + 128 * ai + 64 * wr + 16 * mm + fr] * (1.f / 1024.f) + 1e-6f);
        }
#pragma unroll
        for (int ai = 0; ai < 2; ++ai)
#pragma unroll
            for (int mm = 0; mm < 4; ++mm) {
                const int m = m0 + 128 * ai + 64 * wr + 16 * mm + fr;
                const bool lat = m < NL;
                const int b = lat ? (m >> 13) : ((m - NL) >> 8), l = lat ? (m & 8191) : ((m - NL) & 255);
                const int rcm = lat ? (b << 13) + ((l & 63) << 7) + (l >> 6) : m;
#pragma unroll
                for (int bj = 0; bj < 2; ++bj) {
                    const int n = nb + 128 * bj;
                    const f32x4 v0 = acc[ai][bj][mm][0] * rstd[ai][mm] + bias[bj][0], v1 = acc[ai][bj][mm][1] * rstd[ai][mm] + bias[bj][1];
                    if (n < 512) {
                        const int g = n >> 4, urow = lat ? (b << 8) + (l >> 5) : 1024 + (b << 3) + (l >> 5), t = l & 31;
                        *(uint4*)(U + ((size_t)g * UROWS + urow) * 768 + t * 16 + (n & 15)) = pack8(v0, v1);
                    } else if (n < 768) { *(uint4*)(Q + (size_t)rcm * 256 + (n - 512)) = pack8(v0 * 0.125f, v1 * 0.125f); }
                    else if (n < 1024) { *(uint4*)(Kb + (size_t)rcm * 256 + (n - 768)) = pack8(v0, v1); }
                    else if (n < 1536) { *(uint4*)(V + (size_t)rcm * 512 + (n - 1024)) = pack8(v0, v1); }
                    else if (n < 2048) { *(uint4*)(R + (size_t)rcm * 512 + (n - 1536)) = pack8(v0, v1); }
                    else if (n < 4096) {
                        if (lat) {
                            const int j0 = ((256 * u.pn + 128 * bj + 32 * wc - 2048) >> 1) + 4 * fq;
                            f32x4 sa, rt;
#pragma unroll
                            for (int r = 0; r < 4; ++r) { const float ea = 1.f + __expf(-v0[r]), eb = 1.f + __expf(-v1[r]); sa[r] = rcpf_(ea); rt[r] = ea * rcpf_(eb); }
                            store_bf4(GA + (size_t)m * 1024 + j0, sa);
                            store_bf4(GB + (size_t)m * 1024 + j0, rt);
                        }
                    }
                    else if (n < 4128) { *(uint4*)(GLR + (size_t)rcm * 32 + (n - 4096)) = pack8(v0, v1); }
                }
            }
    }
};
__device__ __forceinline__ void phase5(const Params& P, PG8_LAS unsigned char* lds) {
    GemmD g{}; g.A = (const bf16_t*)(P.ws + OFF_H); g.Bt = (const bf16_t*)(P.ws + OFF_WIN); g.lda = 1024; g.ldb = 1024; g.K = 1024; g.nM = NT >> 8; g.nN = 17; g.nG = 1;
    EpiWin E; E.U = (bf16_t*)(P.ws + OFF_U); E.Q = (bf16_t*)(P.ws + OFF_Q); E.Kb = (bf16_t*)(P.ws + OFF_K); E.V = (bf16_t*)(P.ws + OFF_V); E.R = (bf16_t*)(P.ws + OFF_R);
    E.GLR = (bf16_t*)(P.ws + OFF_GLR); E.GA = (bf16_t*)P.out; E.GB = E.GA + (size_t)NL * 1024; E.ss = (const float*)(P.ws + OFF_SS); E.BW = (const float*)(P.ws + OFF_BW);
    pg8::gemm_phase(lds, g, E);
}

__device__ __forceinline__ float logsig(float z) { return fminf(z, 0.f) - __logf(1.f + __expf(-fabsf(z))); }

struct VRegs { uint4 a0, a1, b0, b1; };
__device__ __forceinline__ VRegs load_v_regs(const bf16_t* __restrict__ Vg, int t) {
    const int ip = t & 31, c = t >> 5; VRegs r;
    const bf16_t* p = Vg + (size_t)(2 * ip) * 512 + c * 16;
    r.a0 = *(const uint4*)p; r.a1 = *(const uint4*)(p + 8); r.b0 = *(const uint4*)(p + 512); r.b1 = *(const uint4*)(p + 520);
    return r;
}
__device__ __forceinline__ void store_vt(const VRegs& r, bf16_t* sVt, int t) {
    const int ip = t & 31, c = t >> 5;
    const unsigned ua[8] = {r.a0.x, r.a0.y, r.a0.z, r.a0.w, r.a1.x, r.a1.y, r.a1.z, r.a1.w};
    const unsigned ub[8] = {r.b0.x, r.b0.y, r.b0.z, r.b0.w, r.b1.x, r.b1.y, r.b1.z, r.b1.w};
    unsigned* base = (unsigned*)(sVt + (c * 16) * LROW + 2 * ip);
#pragma unroll
    for (int e = 0; e < 8; ++e) {
        base[(2 * e) * (LROW / 2)] = (ua[e] & 0xffffu) | (ub[e] << 16);
        base[(2 * e + 1) * (LROW / 2)] = (ua[e] >> 16) | (ub[e] & 0xffff0000u);
    }
}
__device__ __forceinline__ float gate_prefix(const Params& P, const float* sGLRd  , int stride, int d, int h, int dk, int part, float (&pre)[16]) {
    float gu[16];
#pragma unroll
    for (int j = 0; j < 16; ++j) gu[j] = P.in[23][(d * 16 + j) * 256 + h * 64 + dk];
    const float gb = P.in[24][d * 256 + h * 64 + dk];
#pragma unroll
    for (int ii = 0; ii < 16; ++ii) {
        const float* gl = sGLRd + (part * 16 + ii) * stride;
        float z = gb;
#pragma unroll
        for (int j4 = 0; j4 < 4; ++j4) { const f32x4 x = *(const f32x4*)(gl + j4 * 4); z += x[0] * gu[j4 * 4] + x[1] * gu[j4 * 4 + 1] + x[2] * gu[j4 * 4 + 2] + x[3] * gu[j4 * 4 + 3]; }
        pre[ii] = logsig(z) * (1.f / 16.f);
    }
    if (d == 0) {
#pragma unroll
        for (int ii = 1; ii < 16; ++ii) pre[ii] += pre[ii - 1];
        return pre[15];
    } else {
#pragma unroll
        for (int ii = 14; ii >= 0; --ii) pre[ii] += pre[ii + 1];
        return pre[0];
    }
}

__device__ __forceinline__ void gla_a_item(const Params& P, int item, unsigned char* smem) {
    float* sGLR = (float*)smem;
    float* sPart = (float*)(smem + 4096);
    bf16_t* sKDt = (bf16_t*)(smem + 5120);
    bf16_t* sVt = (bf16_t*)(smem + 5120 + 9216);
    const int n = item % 132, d = (item / 132) & 1, h = (item / 264) & 3, b = item / 1056;
    const int rowbase = n < 4 ? NL + b * 256 + n * 64 : b * 8192 + (n - 4) * 64;
    const bf16_t* Kb = (const bf16_t*)(P.ws + OFF_K); const bf16_t* V = (const bf16_t*)(P.ws + OFF_V); const bf16_t* GLR = (const bf16_t*)(P.ws + OFF_GLR);
    const int tid = threadIdx.x & 255, lane = tid & 63, w = tid >> 6, dk = tid & 63, part = tid >> 6;
    const VRegs vr = load_v_regs(V + (size_t)rowbase * 512 + h * 128, tid);
    const f32x4 gl4 = load_bf4(GLR + (size_t)(rowbase + (tid >> 2)) * 32 + d * 16 + (tid & 3) * 4);
    float kk[16];
#pragma unroll
    for (int ii = 0; ii < 16; ++ii) kk[ii] = bf2f(Kb[(size_t)(rowbase + part * 16 + ii) * 256 + h * 64 + dk]);
    *(f32x4*)(sGLR + (tid >> 2) * 16 + (tid & 3) * 4) = gl4;
    store_vt(vr, sVt, tid);
    __syncthreads();
    float pre[16];
    const float tot = gate_prefix(P, sGLR, 16, d, h, dk, part, pre);
    sPart[part * 64 + dk] = tot;
    __syncthreads();
    const float t0 = sPart[dk], t1 = sPart[64 + dk], t2 = sPart[128 + dk], t3 = sPart[192 + dk];
    const float gtot = (t0 + t1) + (t2 + t3);
    float off;
    if (d == 0) off = part == 0 ? 0.f : (part == 1 ? t0 : (part == 2 ? t0 + t1 : t0 + t1 + t2));
    else off = part == 3 ? 0.f : (part == 2 ? t3 : (part == 1 ? t3 + t2 : t3 + t2 + t1));
    unsigned pk[8];
#pragma unroll
    for (int e = 0; e < 8; ++e) pk[e] = pk2(kk[2 * e] * __expf(gtot - (off + pre[2 * e])), kk[2 * e + 1] * __expf(gtot - (off + pre[2 * e + 1])));
    *(uint4*)(sKDt + dk * LROW + part * 16) = make_uint4(pk[0], pk[1], pk[2], pk[3]);
    *(uint4*)(sKDt + dk * LROW + part * 16 + 8) = make_uint4(pk[4], pk[5], pk[6], pk[7]);
    if (part == 0) ((float*)(P.ws + OFF_DEC))[(size_t)item * 64 + dk] = __expf(gtot);
    __syncthreads();
    bf16_t* KVt = (bf16_t*)(P.ws + OFF_H) + (size_t)item * 8192;
    const int fr = lane & 15, fq = lane >> 4;
#pragma unroll
    for (int dvt = 0; dvt < 2; ++dvt) {
        f32x4 acc[4];
#pragma unroll
        for (int dkt = 0; dkt < 4; ++dkt) acc[dkt] = (f32x4){0.f, 0.f, 0.f, 0.f};
#pragma unroll
        for (int ks = 0; ks < 2; ++ks) {
            const bf16x8 vb = *(const bf16x8*)(sVt + (w * 32 + dvt * 16 + fr) * LROW + ks * 32 + fq * 8);
#pragma unroll
            for (int dkt = 0; dkt < 4; ++dkt) {
                const bf16x8 ka = *(const bf16x8*)(sKDt + (dkt * 16 + fr) * LROW + ks * 32 + fq * 8);
                acc[dkt] = __builtin_amdgcn_mfma_f32_16x16x32_bf16(ka, vb, acc[dkt], 0, 0, 0);
            }
        }
#pragma unroll
        for (int dkt = 0; dkt < 4; ++dkt) store_bf4(KVt + (size_t)(w * 32 + dvt * 16 + fr) * 64 + dkt * 16 + fq * 4, acc[dkt]);
    }
    __syncthreads();
}

__device__ __forceinline__ void gla_scan_item(const Params& P, int item) {
    const int gid = item * NTHR + threadIdx.x, seq = gid >> 11, e = gid & 2047, dv = e >> 4, dk4 = (e & 15) * 4, d = seq & 1;
    bf16_t* base = (bf16_t*)(P.ws + OFF_H) + (size_t)seq * 132 * 8192 + dv * 64 + dk4;
    const float* decb = (const float*)(P.ws + OFF_DEC) + (size_t)seq * 132 * 64 + dk4;
    f32x4 S = (f32x4){0.f, 0.f, 0.f, 0.f};
    for (int s0 = 0; s0 < 132; s0 += 12) {
        uint2 kvr[12]; f32x4 dec[12];
#pragma unroll
        for (int q = 0; q < 12; ++q) {
            const int step = s0 + q, n = d == 0 ? step : (step < 4 ? 3 - step : 135 - step);
            kvr[q] = *(const uint2*)(base + (size_t)n * 8192); dec[q] = *(const f32x4*)(decb + n * 64);
        }
#pragma unroll
        for (int q = 0; q < 12; ++q) {
            const int step = s0 + q, n = d == 0 ? step : (step < 4 ? 3 - step : 135 - step);
            if (n >= 4) store_bf4(base + (size_t)n * 8192, S);
            f32x4 kv; kv[0] = bflo(kvr[q].x); kv[1] = bfhi(kvr[q].x); kv[2] = bflo(kvr[q].y); kv[3] = bfhi(kvr[q].y);
            S = dec[q] * S + kv;
        }
    }
}

__device__ __forceinline__ void gla_c_item(const Params& P, int item, unsigned char* smem) {
    float* sGLR = (float*)smem;
    float* sPart = (float*)(smem + 8192);
    bf16_t* sQD = (bf16_t*)(smem + 10240);
    bf16_t* sKD = (bf16_t*)(smem + 10240 + 9216);
    bf16_t* sQG = (bf16_t*)(smem + 10240 + 2 * 9216);
    bf16_t* sP = (bf16_t*)(smem + 10240 + 2 * 9216 + 17408);
    bf16_t* sVt = (bf16_t*)(smem + 10240 + 3 * 9216 + 17408);
    const int m = item & 127, h = (item >> 7) & 3, b = item >> 9;
    const int rowbase = b * 8192 + m * 64;
    const bf16_t* Q = (const bf16_t*)(P.ws + OFF_Q); const bf16_t* Kb = (const bf16_t*)(P.ws + OFF_K);
    bf16_t* V = (bf16_t*)(P.ws + OFF_V); const bf16_t* R = (const bf16_t*)(P.ws + OFF_R); const bf16_t* GLR = (const bf16_t*)(P.ws + OFF_GLR);
    const int tid = threadIdx.x & 255, lane = tid & 63, w = tid >> 6, fr = lane & 15, fq = lane >> 4, dk = tid & 63, part = tid >> 6;
    const VRegs vr = load_v_regs(V + (size_t)rowbase * 512 + h * 128, tid);
    const uint4 gl8 = *(const uint4*)(GLR + (size_t)(rowbase + (tid >> 2)) * 32 + (tid & 3) * 8);
    float qq[16], kk[16];
#pragma unroll
    for (int ii = 0; ii < 16; ++ii) { qq[ii] = bf2f(Q[(size_t)(rowbase + part * 16 + ii) * 256 + h * 64 + dk]); kk[ii] = bf2f(Kb[(size_t)(rowbase + part * 16 + ii) * 256 + h * 64 + dk]); }
    {
        float* gp = sGLR + (tid >> 2) * 32 + (tid & 3) * 8;
        *(f32x4*)gp = (f32x4){bflo(gl8.x), bfhi(gl8.x), bflo(gl8.y), bfhi(gl8.y)};
        *(f32x4*)(gp + 4) = (f32x4){bflo(gl8.z), bfhi(gl8.z), bflo(gl8.w), bfhi(gl8.w)};
    }
    store_vt(vr, sVt, tid);
    __syncthreads();
    float gc0[16], gc1[16];
    { const float tot0 = gate_prefix(P, sGLR, 32, 0, h, dk, part, gc0); const float tot1 = gate_prefix(P, sGLR + 16, 32, 1, h, dk, part, gc1);
      sPart[part * 64 + dk] = tot0; sPart[256 + part * 64 + dk] = tot1; }
    __syncthreads();
    float gref0, gref1;
    {
        const float a0 = sPart[dk], a1 = sPart[64 + dk], a2 = sPart[128 + dk];
        const float c1 = sPart[256 + 64 + dk], c2 = sPart[256 + 128 + dk], c3 = sPart[256 + 192 + dk];
        const float off0 = part == 0 ? 0.f : (part == 1 ? a0 : (part == 2 ? a0 + a1 : a0 + a1 + a2));
        const float off1 = part == 3 ? 0.f : (part == 2 ? c3 : (part == 1 ? c3 + c2 : c3 + c2 + c1));
        gref0 = a0 + a1; gref1 = c3 + c2;
#pragma unroll
        for (int ii = 0; ii < 16; ++ii) { gc0[ii] += off0; gc1[ii] += off1; }
    }
    f32x4 pacc[4];
#pragma unroll
    for (int jt = 0; jt < 4; ++jt) pacc[jt] = (f32x4){0.f, 0.f, 0.f, 0.f};
#pragma unroll
    for (int d = 0; d < 2; ++d) {
        const float gref = d == 0 ? gref0 : gref1;
#pragma unroll
        for (int ii = 0; ii < 16; ++ii) {
            const int i = part * 16 + ii;
            const float gc = d == 0 ? gc0[ii] : gc1[ii];
            sQD[i * LROW + dk] = f2bf(qq[ii] * __expf(gc - gref));
            sKD[i * LROW + dk] = f2bf(kk[ii] * __expf(gref - gc));
            sQG[i * 136 + d * 64 + dk] = f2bf(qq[ii] * __expf(gc));
        }
        __syncthreads();
#pragma unroll
        for (int jt = 0; jt < 4; ++jt) {
            f32x4 sc = (f32x4){0.f, 0.f, 0.f, 0.f};
#pragma unroll
            for (int ks = 0; ks < 2; ++ks) {
                const bf16x8 a = *(const bf16x8*)(sQD + (16 * w + fr) * LROW + ks * 32 + fq * 8);
                const bf16x8 bb = *(const bf16x8*)(sKD + (jt * 16 + fr) * LROW + ks * 32 + fq * 8);
                sc = __builtin_amdgcn_mfma_f32_16x16x32_bf16(a, bb, sc, 0, 0, 0);
            }
#pragma unroll
            for (int r = 0; r < 4; ++r) {
                const int i = 16 * w + fq * 4 + r, j = jt * 16 + fr;
                const bool keep = d == 0 ? (j <= i) : (j >= i);
                pacc[jt][r] += keep ? sc[r] : 0.f;
            }
        }
        if (d == 0) __syncthreads();
    }
#pragma unroll
    for (int jt = 0; jt < 4; ++jt)
#pragma unroll
        for (int r = 0; r < 4; ++r) sP[(16 * w + fq * 4 + r) * LROW + jt * 16 + fr] = f2bf(pacc[jt][r]);
    const bf16_t* SS0 = (const bf16_t*)(P.ws + OFF_H) + ((size_t)(((b * 4 + h) * 2 + 0) * 132 + 4 + m)) * 8192;
    const bf16_t* SS1 = (const bf16_t*)(P.ws + OFF_H) + ((size_t)(((b * 4 + h) * 2 + 1) * 132 + 4 + m)) * 8192;
    const int i_out = 16 * w + fr;
    const int tok_out = b * 8192 + ((m & 1) * 64 + i_out) * 64 + (m >> 1);
    bf16_t* YB = (bf16_t*)(P.ws + OFF_YB);
    uint2 rgr[8];
#pragma unroll
    for (int dvt = 0; dvt < 8; ++dvt) rgr[dvt] = *(const uint2*)(R + (size_t)(rowbase + i_out) * 512 + h * 128 + dvt * 16 + fq * 4);
    __syncthreads();
    f32x4 oacc[8];
#pragma unroll
    for (int dvt = 0; dvt < 8; ++dvt) oacc[dvt] = (f32x4){0.f, 0.f, 0.f, 0.f};
#pragma unroll
    for (int ks = 0; ks < 4; ++ks) {
        const bf16x8 qb = *(const bf16x8*)(sQG + (16 * w + fr) * 136 + ks * 32 + fq * 8);
        const bf16_t* SS = (ks >> 1) ? SS1 : SS0;
#pragma unroll
        for (int dvt = 0; dvt < 8; ++dvt) {
            const bf16x8 sa = *(const bf16x8*)(SS + (size_t)(dvt * 16 + fr) * 64 + (ks & 1) * 32 + fq * 8);
            oacc[dvt] = __builtin_amdgcn_mfma_f32_16x16x32_bf16(sa, qb, oacc[dvt], 0, 0, 0);
        }
    }
#pragma unroll
    for (int ks = 0; ks < 2; ++ks) {
        const bf16x8 pb = *(const bf16x8*)(sP + (16 * w + fr) * LROW + ks * 32 + fq * 8);
#pragma unroll
        for (int dvt = 0; dvt < 8; ++dvt) {
            const bf16x8 va = *(const bf16x8*)(sVt + (dvt * 16 + fr) * LROW + ks * 32 + fq * 8);
            oacc[dvt] = __builtin_amdgcn_mfma_f32_16x16x32_bf16(va, pb, oacc[dvt], 0, 0, 0);
        }
    }
    float ss = 0.f;
#pragma unroll
    for (int dvt = 0; dvt < 8; ++dvt)
#pragma unroll
        for (int r = 0; r < 4; ++r) ss += oacc[dvt][r] * oacc[dvt][r];
    ss += __shfl_xor(ss, 16); ss += __shfl_xor(ss, 32);
    const float rinv = rsqrtf(ss * (1.f / 128.f) + 1e-6f);
#pragma unroll
    for (int dvt = 0; dvt < 8; ++dvt) {
        const int dv = dvt * 16 + fq * 4;
        const float rg[4] = {bflo(rgr[dvt].x), bfhi(rgr[dvt].x), bflo(rgr[dvt].y), bfhi(rgr[dvt].y)};
        const f32x4 ng = *(const f32x4*)(P.in[25] + h * 128 + dv);
        f32x4 o;
#pragma unroll
        for (int r = 0; r < 4; ++r) o[r] = oacc[dvt][r] * rinv * ng[r] * siluf_(rg[r]);
        store_bf4(YB + (size_t)tok_out * 512 + h * 128 + dv, o);
    }
    __syncthreads();
}

struct EpiE : pg8::EpiNoMid {
    float* E;
    __device__ __forceinline__ void operator()(const AccT& acc, const Unit& u, int wr, int wc, int fr, int fq) const {
        EPI_LOOP
            if (m < 1056) *(f32x4*)(E + ((size_t)u.g * 1056 + m) * 256 + n) = v;
        EPI_LOOP_END
    }
};
__device__ __forceinline__ void phase6(const Params& P, unsigned char* smem) {
    const int hb = threadIdx.x >> 8;
    for (int base = blockIdx.x * 2; base < 4224; base += gridDim.x * 2) gla_a_item(P, base + hb, smem + hb * HALF_LDS);
    GemmD g{}; g.A = (const bf16_t*)(P.ws + OFF_U); g.Bt = (const bf16_t*)(P.ws + OFF_WE); g.lda = 768; g.ldb = 512; g.K = 512; g.nM = 5; g.nN = 1; g.nG = 32;
    g.gsA = (size_t)UROWS * 768; g.gsB = (size_t)256 * 512;
    EpiE E; E.E = (float*)(P.ws + OFF_E);
    pg8::gemm_phase((PG8_LAS unsigned char*)smem, g, E);
}
__device__ __forceinline__ void s5_carry_item(const Params& P, int item) {
    const int id = item * NTHR + threadIdx.x, p = id & 63, d = (id >> 6) & 1, b = (id >> 7) & 3, g = id >> 9;
    const float2 lamT = ((const float2*)(P.ws + OFF_LP))[((d * 32 + g) * 33 + 32) * 64 + p];
    const float* Eg = (const float*)(P.ws + OFF_E) + (size_t)g * 1056 * 256;
    bf16_t* Ug = (bf16_t*)(P.ws + OFF_U) + (size_t)g * UROWS * 768;
    const int cre = d * 128 + p, cim = d * 128 + 64 + p;
    float2 hh = make_float2(0.f, 0.f);
    {
        float2 e[8];
#pragma unroll
        for (int s = 0; s < 8; ++s) { const int n = d == 0 ? s : 7 - s, row = 1024 + b * 8 + n; e[s] = make_float2(Eg[(size_t)row * 256 + cre], Eg[(size_t)row * 256 + cim]); }
#pragma unroll
        for (int s = 0; s < 8; ++s) { const float2 t = cmul(lamT, hh); hh = make_float2(t.x + e[s].x, t.y + e[s].y); }
    }
    for (int s0 = 0; s0 < 256; s0 += 16) {
        float2 e[16];
#pragma unroll
        for (int q = 0; q < 16; ++q) { const int s = s0 + q, n = d == 0 ? s : 255 - s, row = b * 256 + n; e[q] = make_float2(Eg[(size_t)row * 256 + cre], Eg[(size_t)row * 256 + cim]); }
#pragma unroll
        for (int q = 0; q < 16; ++q) {
            const int s = s0 + q, n = d == 0 ? s : 255 - s, row = b * 256 + n;
            Ug[(size_t)row * 768 + 512 + cre] = f2bf(hh.x); Ug[(size_t)row * 768 + 512 + cim] = f2bf(hh.y);
            const float2 t = cmul(lamT, hh); hh = make_float2(t.x + e[q].x, t.y + e[q].y);
        }
    }
}
__device__ __forceinline__ void phase7(const Params& P) {
    for (int it = blockIdx.x; it < 32 + 128; it += gridDim.x) {
        if (it < 32) s5_carry_item(P, it); else gla_scan_item(P, it - 32);
    }
}
struct EpiY : pg8::EpiNoMid {
    static constexpr bool PERM = true;
    const bf16_t* U; const float* dskip; bf16_t* YG;
    __device__ __forceinline__ void operator()(const AccT& acc, const Unit& u, int wr, int wc, int fr, int fq) const {
        const int nb = 256 * u.pn + 32 * wc + 8 * fq, c0 = 8 * (fq & 1);
        const f32x4 ds0 = *(const f32x4*)(dskip + u.g * 16 + c0), ds1 = *(const f32x4*)(dskip + u.g * 16 + c0 + 4);
#pragma unroll
        for (int ai = 0; ai < 2; ++ai) {
            const int mb = 256 * u.pm + 128 * ai + 64 * wr + fr;
            uint4 ur[4][2];
#pragma unroll
            for (int mm = 0; mm < 4; ++mm)
#pragma unroll
                for (int bj = 0; bj < 2; ++bj) ur[mm][bj] = *(const uint4*)(U + ((size_t)u.g * UROWS + mb + 16 * mm) * 768 + nb + 128 * bj);
#pragma unroll
            for (int mm = 0; mm < 4; ++mm)
#pragma unroll
                for (int bj = 0; bj < 2; ++bj) {
                    const int m = mb + 16 * mm, n = nb + 128 * bj;
                    const int b = m >> 8, nch = m & 255, t = n >> 4;
                    const uint4 uu = ur[mm][bj];
                    const f32x4 v0 = acc[ai][bj][mm][0], v1 = acc[ai][bj][mm][1];
                    const f32x4 o0 = {gelu_tanh(v0[0] + ds0[0] * bflo(uu.x)), gelu_tanh(v0[1] + ds0[1] * bfhi(uu.x)), gelu_tanh(v0[2] + ds0[2] * bflo(uu.y)), gelu_tanh(v0[3] + ds0[3] * bfhi(uu.y))};
                    const f32x4 o1 = {gelu_tanh(v1[0] + ds1[0] * bflo(uu.z)), gelu_tanh(v1[1] + ds1[1] * bfhi(uu.z)), gelu_tanh(v1[2] + ds1[2] * bflo(uu.w)), gelu_tanh(v1[3] + ds1[3] * bfhi(uu.w))};
                    *(uint4*)(YG + ((size_t)(b * 8192 + nch * 32 + t)) * 512 + u.g * 16 + c0) = pack8(o0, o1);
                }
        }
    }
};
__device__ __forceinline__ void phase8(const Params& P, unsigned char* smem) {
    const int hb = threadIdx.x >> 8;
    for (int base = blockIdx.x * 2; base < 2048; base += gridDim.x * 2) gla_c_item(P, base + hb, smem + hb * HALF_LDS);
    GemmD g{}; g.A = (const bf16_t*)(P.ws + OFF_U); g.Bt = (const bf16_t*)(P.ws + OFF_WY); g.lda = 768; g.ldb = 768; g.K = 768; g.nM = 4; g.nN = 2; g.nG = 32;
    g.gsA = (size_t)UROWS * 768; g.gsB = (size_t)512 * 768;
    EpiY E; E.U = (const bf16_t*)(P.ws + OFF_U); E.dskip = P.in[19]; E.YG = (bf16_t*)(P.ws + OFF_E);
    pg8::gemm_phase((PG8_LAS unsigned char*)smem, g, E);
}

struct EpiGlu : pg8::EpiNoMid {
    static constexpr bool PERM = true;
    const bf16_t* YG; const float* bias; bf16_t* YA;
    __device__ __forceinline__ void operator()(const AccT& acc, const Unit& u, int wr, int wc, int fr, int fq) const {
        const int nb = 256 * u.pn + 32 * wc + 8 * fq;
        f32x4 bb[2][2];
#pragma unroll
        for (int bj = 0; bj < 2; ++bj)
#pragma unroll
            for (int nn = 0; nn < 2; ++nn) bb[bj][nn] = *(const f32x4*)(bias + nb + 128 * bj + 4 * nn);
#pragma unroll
        for (int ai = 0; ai < 2; ++ai) {
            const size_t rb = (size_t)(256 * u.pm + 128 * ai + 64 * wr + fr) * 512 + nb;
            uint4 yr[4][2];
#pragma unroll
            for (int mm = 0; mm < 4; ++mm)
#pragma unroll
                for (int bj = 0; bj < 2; ++bj) yr[mm][bj] = *(const uint4*)(YG + rb + (size_t)mm * 16 * 512 + 128 * bj);
#pragma unroll
            for (int mm = 0; mm < 4; ++mm)
#pragma unroll
                for (int bj = 0; bj < 2; ++bj) {
                    const uint4 y = yr[mm][bj]; const f32x4 v0 = acc[ai][bj][mm][0] + bb[bj][0], v1 = acc[ai][bj][mm][1] + bb[bj][1];
                    const f32x4 o0 = {bflo(y.x) * sigm(v0[0]), bfhi(y.x) * sigm(v0[1]), bflo(y.y) * sigm(v0[2]), bfhi(y.y) * sigm(v0[3])};
                    const f32x4 o1 = {bflo(y.z) * sigm(v1[0]), bfhi(y.z) * sigm(v1[1]), bflo(y.w) * sigm(v1[2]), bfhi(y.w) * sigm(v1[3])};
                    *(uint4*)(YA + rb + (size_t)mm * 16 * 512 + 128 * bj) = pack8(o0, o1);
                }
        }
    }
};
__device__ __forceinline__ void phase9(const Params& P, PG8_LAS unsigned char* lds) {
    GemmD g{}; g.A = (const bf16_t*)(P.ws + OFF_E); g.Bt = (const bf16_t*)(P.ws + OFF_WGLU); g.lda = 512; g.ldb = 512; g.K = 512; g.nM = NL >> 8; g.nN = 2; g.nG = 1;
    EpiGlu E; E.YG = (const bf16_t*)(P.ws + OFF_E); E.bias = P.in[21]; E.YA = (bf16_t*)(P.ws + OFF_U);
    pg8::gemm_phase(lds, g, E);
}
struct EpiMerge {
    static constexpr bool PERM = true;
    const bf16_t* GA; const bf16_t* GB; bf16_t* H;
    __device__ __forceinline__ void mid(f32x4 (&acc)[2][2][4][2], const Unit& u, int wr, int wc, int fr, int fq) const {
        const int nb = 256 * u.pn + 32 * wc + 8 * fq;
#pragma unroll
        for (int ai = 0; ai < 2; ++ai) {
            const size_t rb = (size_t)(256 * u.pm + 128 * ai + 64 * wr + fr) * 1024 + nb;
            uint4 br[4][2];
#pragma unroll
            for (int mm = 0; mm < 4; ++mm)
#pragma unroll
                for (int bj = 0; bj < 2; ++bj) br[mm][bj] = *(const uint4*)(GB + rb + (size_t)mm * 16 * 1024 + 128 * bj);
#pragma unroll
            for (int mm = 0; mm < 4; ++mm)
#pragma unroll
                for (int bj = 0; bj < 2; ++bj) {
                    const uint4 b4 = br[mm][bj];
                    f32x4& v0 = acc[ai][bj][mm][0]; f32x4& v1 = acc[ai][bj][mm][1];
                    v0[0] *= bflo(b4.x); v0[1] *= bfhi(b4.x); v0[2] *= bflo(b4.y); v0[3] *= bfhi(b4.y);
                    v1[0] *= bflo(b4.z); v1[1] *= bfhi(b4.z); v1[2] *= bflo(b4.w); v1[3] *= bfhi(b4.w);
                }
        }
    }
    __device__ __forceinline__ void operator()(const AccT& acc, const Unit& u, int wr, int wc, int fr, int fq) const {
        const int nb = 256 * u.pn + 32 * wc + 8 * fq;
#pragma unroll
        for (int ai = 0; ai < 2; ++ai) {
            const size_t rb = (size_t)(256 * u.pm + 128 * ai + 64 * wr + fr) * 1024 + nb;
            uint4 gr[4][2];
#pragma unroll
            for (int mm = 0; mm < 4; ++mm)
#pragma unroll
                for (int bj = 0; bj < 2; ++bj) gr[mm][bj] = *(const uint4*)(GA + rb + (size_t)mm * 16 * 1024 + 128 * bj);
#pragma unroll
            for (int mm = 0; mm < 4; ++mm)
#pragma unroll
                for (int bj = 0; bj < 2; ++bj) {
                    const uint4 g4 = gr[mm][bj]; const f32x4 v0 = acc[ai][bj][mm][0], v1 = acc[ai][bj][mm][1];
                    uint4 o;
                    o.x = pk2(bflo(g4.x) * v0[0], bfhi(g4.x) * v0[1]); o.y = pk2(bflo(g4.y) * v0[2], bfhi(g4.y) * v0[3]);
                    o.z = pk2(bflo(g4.z) * v1[0], bfhi(g4.z) * v1[1]); o.w = pk2(bflo(g4.w) * v1[2], bfhi(g4.w) * v1[3]);
                    *(uint4*)(H + rb + (size_t)mm * 16 * 1024 + 128 * bj) = o;
                }
        }
    }
};
__device__ __forceinline__ void phase10(const Params& P, PG8_LAS unsigned char* lds) {
    GemmD g{}; g.A = (const bf16_t*)(P.ws + OFF_YB); g.Bt = (const bf16_t*)(P.ws + OFF_WGLO); g.A2 = (const bf16_t*)(P.ws + OFF_U); g.Bt2 = (const bf16_t*)(P.ws + OFF_WS5O); g.dual = 1;
    g.lda = 512; g.ldb = 512; g.K = 512; g.nM = NL >> 8; g.nN = 4; g.nG = 1;
    EpiMerge E; E.GA = (const bf16_t*)P.out; E.GB = E.GA + (size_t)NL * 1024; E.H = (bf16_t*)(P.ws + OFF_H);
    pg8::gemm_phase(lds, g, E);
}
__device__ __forceinline__ void phase11(const Params& P, PG8_LAS unsigned char* lds) {
    GemmD g{}; g.A = (const bf16_t*)(P.ws + OFF_H); g.Bt = (const bf16_t*)(P.ws + OFF_WWO); g.lda = 1024; g.ldb = 1024; g.K = 1024; g.nM = NL >> 8; g.nN = 4; g.nG = 1;
    EpiRes<1> E; E.x = nullptr; E.XRb = (bf16_t*)(P.ws + OFF_XR); E.out = nullptr; E.Hn = (bf16_t*)P.out; E.mod = (const float*)(P.ws + OFF_MOD);
    E.gnext = P.in[28]; E.ss = (float*)(P.ws + OFF_SS) + NT;
    pg8::gemm_phase(lds, g, E);
}

__device__ __forceinline__ void phase_ffn_up13(const Params& P, PG8_LAS unsigned char* lds) {
    GemmD g{}; g.A = (const bf16_t*)P.out; g.Bt = (const bf16_t*)(P.ws + OFF_WGU2); g.lda = 1024; g.ldb = 1024; g.K = 1024; g.nM = NL >> 8; g.nN = 22; g.nG = 1;
    EpiFfnUp<1> E; E.HID = (bf16_t*)(P.ws + OFF_HID); E.ss = (const float*)(P.ws + OFF_SS) + NT; E.BW = (const float*)(P.ws + OFF_BW) + 5 * 4352;
    pg8::gemm_phase(lds, g, E);
}

#define XB_TMO      128
#define XB_XCNT(j)  (256  + 64 * (j))
#define XB_XSUB(j)  (1280 + 64 * (j))
#define XB_XGEN(j)  (2304 + 64 * (j))
#define XB_TOP      3328
#define XB_TOPGEN   3392
#define XCD_BAR_WORDS 3456
#define XB_SPIN_CAP (1u << 18)
#define LAS3 __attribute__((address_space(3)))
__device__ __forceinline__ unsigned xb_ld(unsigned* p)              { return __hip_atomic_load(p, __ATOMIC_RELAXED, __HIP_MEMORY_SCOPE_AGENT); }
__device__ __forceinline__ unsigned xb_add(unsigned* p, unsigned v) { return __hip_atomic_fetch_add(p, v, __ATOMIC_RELAXED, __HIP_MEMORY_SCOPE_AGENT); }
__device__ __forceinline__ unsigned xb_xcc_id() { return (unsigned)__builtin_amdgcn_s_getreg((3 << 11) | 20) & 0xFu; }
#define XB_SPIN(cond, bar) do { unsigned _sp = 0; while (cond) { __builtin_amdgcn_s_sleep(1); \
    if ((++_sp & 255u) == 0u) { if (xb_ld(&(bar)[XB_TMO])) break; if (_sp > XB_SPIN_CAP) { atomicAdd(&(bar)[XB_TMO], 1u); break; } } } } while (0)
struct XcdBarrier { unsigned* bar; unsigned x; volatile LAS3 unsigned* st; };
__device__ __forceinline__ XcdBarrier xcd_barrier_post(unsigned* bar, volatile LAS3 unsigned* st) {
    XcdBarrier b; b.bar = bar; b.x = xb_xcc_id(); b.st = st;
    if (threadIdx.x == 0) (void)xb_add(&bar[XB_XCNT(b.x)], 1u);
    return b;
}
__device__ __forceinline__ void xcd_barrier_complete(unsigned* bar, unsigned x, unsigned& nloc, unsigned& nx) {
    const unsigned G = gridDim.x * gridDim.y * gridDim.z;
    unsigned sum, cnt, mine, sp = 0u;
    for (;;) {
        sum = 0u; cnt = 0u; mine = 0u;
#pragma unroll
        for (unsigned j = 0; j < 16; ++j) { const unsigned c = xb_ld(&bar[XB_XCNT(j)]); sum += c; cnt += (c > 0u) ? 1u : 0u; mine = (j == x) ? c : mine; }
        if (sum == G) break;
        __builtin_amdgcn_s_sleep(1);
        if ((++sp & 255u) == 0u) { if (xb_ld(&bar[XB_TMO])) break; if (sp > XB_SPIN_CAP) { atomicAdd(&bar[XB_TMO], 1u); break; } }
    }
    nloc = mine > 0u ? mine : 1u; nx = cnt > 0u ? cnt : 1u;
}
__device__ __forceinline__ void xcd_barrier(const XcdBarrier& b) {
    asm volatile("s_waitcnt vmcnt(0)" ::: "memory");
    __syncthreads();
    if (threadIdx.x == 0) {
        unsigned* bar = b.bar;
        __builtin_amdgcn_s_waitcnt(0);
        unsigned nloc = b.st[0], nx = b.st[1];
        if (nloc == 0u) { xcd_barrier_complete(bar, b.x, nloc, nx); b.st[0] = nloc; b.st[1] = nx; }
        const unsigned old = xb_add(&bar[XB_XSUB(b.x)], 1u);
        const unsigned gen = old / nloc;
        if (old + 1u == (gen + 1u) * nloc) {
            __builtin_amdgcn_fence(__ATOMIC_RELEASE, "agent");
            asm volatile("s_waitcnt vmcnt(0)" ::: "memory");
            const unsigned og = xb_add(&bar[XB_TOP], 1u);
            const unsigned tg = og / nx;
            if (og + 1u == (tg + 1u) * nx) xb_add(&bar[XB_TOPGEN], 1u);
            else XB_SPIN(xb_ld(&bar[XB_TOPGEN]) == tg, bar);
            __builtin_amdgcn_fence(__ATOMIC_ACQUIRE, "agent");
            xb_add(&bar[XB_XGEN(b.x)], 1u);
            asm volatile("s_waitcnt vmcnt(0)" ::: "memory");
        } else {
            XB_SPIN(xb_ld(&bar[XB_XGEN(b.x)]) == gen, bar);
            __builtin_amdgcn_fence(__ATOMIC_ACQUIRE, "agent");
            asm volatile("s_waitcnt vmcnt(0)" ::: "memory");
        }
    }
    __syncthreads();
}

__global__ void __launch_bounds__(512, 2) mega(Params P) {
    extern __shared__ __attribute__((aligned(16))) unsigned char smem[];
    cg::grid_group grid = cg::this_grid();
    PG8_LAS unsigned char* lds = (PG8_LAS unsigned char*)smem;
    __shared__ uint4 xb_words;
    unsigned* bar = (unsigned*)(P.ws + OFF_BAR);
    if (threadIdx.x == 0) xb_words = make_uint4(0u, 0u, 0u, 0u);
    if (blockIdx.x == 0 && P.ph_lo == 0) { for (int i = threadIdx.x; i < XCD_BAR_WORDS; i += NTHR) bar[i] = 0u; }
    __syncthreads();
    XcdBarrier xb; xb.bar = bar; xb.x = 0; xb.st = (volatile LAS3 unsigned*)&xb_words;
#ifndef PHMASK
#define PHMASK 0xFFFF
#endif
#define PHOK(n) ((PHMASK >> n) & 1)
#define RUN(n, call) if (PHOK(n) && P.ph_lo <= n && n < P.ph_hi) { call; if (n + 1 < P.ph_hi) { if (n == 0) { grid.sync(); xb = xcd_barrier_post(bar, (volatile LAS3 unsigned*)&xb_words); } else xcd_barrier(xb); } }
    RUN(0, phase0(P, smem))
    RUN(1, phase1(P))
    RUN(2, phase_ffn_up<0>(P, lds, OFF_WGU1, NT))
    RUN(3, phase_ffn_down<1>(P, lds, OFF_WDN1))
    RUN(4, phase4(P))
    RUN(5, phase5(P, lds))
    RUN(6, phase6(P, smem))
    RUN(7, phase7(P))
    RUN(8, phase8(P, smem))
    RUN(9, phase9(P, lds))
    RUN(10, phase10(P, lds))
    RUN(11, phase11(P, lds))
    RUN(13, phase_ffn_up13(P, lds))
    RUN(14, phase_ffn_down<0>(P, lds, OFF_WDN2))
    RUN(15, phase15(P))
}

extern "C" void kernel_launch(void* const* d_in, const int* in_sizes, int n_in, void* d_out, int out_size, void* d_ws, size_t ws_size, hipStream_t stream) {
    static int grid_blocks = 0;
    if (grid_blocks == 0) {
        if (n_in != 33 || ws_size < WS_END) { fprintf(stderr, "kernel_launch: unexpected n_in %d / ws_size %zu (need %zu)\n", n_in, ws_size, (size_t)WS_END); grid_blocks = -1; return; }
        int dev = 0, cus = 0, per_cu = 0;
        hipGetDevice(&dev);
        hipDeviceGetAttribute(&cus, hipDeviceAttributeMultiprocessorCount, dev);
        hipFuncSetAttribute((const void*)mega, hipFuncAttributeMaxDynamicSharedMemorySize, LDS_BYTES);
        hipOccupancyMaxActiveBlocksPerMultiprocessor(&per_cu, (const void*)mega, NTHR, LDS_BYTES);
        if (per_cu < 1) per_cu = 1;
        if (per_cu > 1) per_cu = 1;
        grid_blocks = cus * per_cu;
        fprintf(stderr, "kernel_launch: cus %d per_cu %d grid %d\n", cus, per_cu, grid_blocks);
    }
    if (grid_blocks < 0) return;
    Params p{};
    for (int i = 0; i < 33; ++i) p.in[i] = (const float*)d_in[i];
    p.out = (float*)d_out; p.ws = (unsigned char*)d_ws;
#if N_LAUNCH_PER_PHASE
    for (int ph = 0; ph < NPHASE; ++ph) {
        p.ph_lo = ph; p.ph_hi = ph + 1;
        void* args[] = {&p};
        hipError_t e = hipLaunchCooperativeKernel((const void*)mega, dim3(grid_blocks), dim3(NTHR), args, LDS_BYTES, stream);
        if (e != hipSuccess) { fprintf(stderr, "cooperative launch failed: %s\n", hipGetErrorString(e)); break; }
    }
#else
    p.ph_lo = 0; p.ph_hi = NPHASE;
    void* args[] = {&p};
    hipError_t e = hipLaunchCooperativeKernel((const void*)mega, dim3(grid_blocks), dim3(NTHR), args, LDS_BYTES, stream);
    if (e != hipSuccess) fprintf(stderr, "cooperative launch failed: %s\n", hipGetErrorString(e));
#endif
}
```

```cpp
#include <hip/hip_runtime.h>
#include <hip/hip_cooperative_groups.h>
#include <cstdio>
namespace cg = cooperative_groups;

#ifndef N_LAUNCH_PER_PHASE
#define N_LAUNCH_PER_PHASE 0
#endif

typedef unsigned short bf16_t;
typedef short bf16x8 __attribute__((ext_vector_type(8)));
typedef float f32x4 __attribute__((ext_vector_type(4)));

constexpr int NL = 32768, NC = 1024, NT = 33792, D = 1024, FF = 2816;
constexpr int NPHASE = 16;
constexpr int HALF_LDS = 79872;
constexpr int LDS_BYTES = 2 * HALF_LDS;
constexpr int NTHR = 512;
constexpr int UROWS = 1280;

constexpr size_t SZ_WGU = (size_t)5632 * 1024 * 2, SZ_WDN = (size_t)1024 * 2816 * 2;
constexpr size_t OFF_WGU1 = 0;
constexpr size_t OFF_WDN1 = OFF_WGU1 + SZ_WGU;
constexpr size_t OFF_WGU2 = OFF_WDN1 + SZ_WDN;
constexpr size_t OFF_WDN2 = OFF_WGU2 + SZ_WGU;
constexpr size_t OFF_WIN = OFF_WDN2 + SZ_WDN;
constexpr size_t OFF_WGLU = OFF_WIN + (size_t)4352 * 1024 * 2;
constexpr size_t OFF_WS5O = OFF_WGLU + (size_t)512 * 512 * 2;
constexpr size_t OFF_WGLO = OFF_WS5O + (size_t)1024 * 512 * 2;
constexpr size_t OFF_WWO = OFF_WGLO + (size_t)1024 * 512 * 2;
constexpr size_t OFF_WE = OFF_WWO + (size_t)1024 * 1024 * 2;
constexpr size_t OFF_WY = OFF_WE + (size_t)32 * 256 * 512 * 2;
constexpr size_t OFF_KD = OFF_WY + (size_t)32 * 512 * 768 * 2;
constexpr size_t OFF_LP = OFF_KD + (size_t)2 * 32 * 32 * 256 * 4;
constexpr size_t OFF_BB = OFF_LP + (size_t)2 * 32 * 33 * 64 * 8;
constexpr size_t OFF_MOD = OFF_BB + (size_t)2 * 32 * 64 * 16 * 8;
constexpr size_t OFF_DEC = OFF_MOD + (size_t)5 * 9216 * 4;
constexpr size_t OFF_H = OFF_DEC + (size_t)4224 * 64 * 4;
constexpr size_t OFF_HID = OFF_H + (size_t)NT * 1024 * 2;
constexpr size_t OFF_U = OFF_HID;
constexpr size_t OFF_Q = OFF_U + (size_t)32 * UROWS * 768 * 2;
constexpr size_t OFF_K = OFF_Q + (size_t)NT * 256 * 2;
constexpr size_t OFF_V = OFF_K + (size_t)NT * 256 * 2;
constexpr size_t OFF_R = OFF_V + (size_t)NT * 512 * 2;
constexpr size_t OFF_GLR = OFF_R + (size_t)NT * 512 * 2;
constexpr size_t OFF_XR = OFF_HID + (size_t)NT * 2816 * 2;
constexpr size_t OFF_YB = OFF_XR + (size_t)NT * 1024 * 2;
constexpr size_t OFF_E = OFF_XR + (size_t)NT * 1024 * 4;
constexpr size_t OFF_BAR = OFF_E + (size_t)32 * 1056 * 256 * 4;
constexpr size_t OFF_SS = OFF_BAR + 16384;
constexpr size_t OFF_BW = OFF_SS + 401408;
constexpr size_t WS_END = OFF_BW + 204800;
static_assert(WS_END <= (size_t)536870912, "workspace");
static_assert(OFF_GLR + (size_t)NT * 32 * 2 <= OFF_XR, "alias overflow");

struct Params { const float* in[33]; float* out; unsigned char* ws; int ph_lo, ph_hi; };

typedef float f32x2_t __attribute__((ext_vector_type(2)));
typedef __bf16 bf16x2_t __attribute__((ext_vector_type(2)));
__device__ __forceinline__ unsigned pk2(float a, float b) { const f32x2_t v = {a, b}; const bf16x2_t r = __builtin_convertvector(v, bf16x2_t); return __builtin_bit_cast(unsigned, r); }
__device__ __forceinline__ bf16_t f2bf(float f) { return (bf16_t)(pk2(f, f) & 0xffffu); }
__device__ __forceinline__ float bf2f(bf16_t h) { return __uint_as_float(((unsigned)h) << 16); }
__device__ __forceinline__ float bflo(unsigned u) { return __uint_as_float(u << 16); }
__device__ __forceinline__ float bfhi(unsigned u) { return __uint_as_float(u & 0xffff0000u); }
__device__ __forceinline__ float rcpf_(float x) { return __builtin_amdgcn_rcpf(x); }
__device__ __forceinline__ float sigm(float x) { return rcpf_(1.f + __expf(-x)); }
__device__ __forceinline__ float siluf_(float x) { return x * sigm(x); }
__device__ __forceinline__ float gelu_tanh(float x) { float y = 0.7978845608028654f * (x + 0.044715f * x * x * x); float t = 1.f - 2.f * rcpf_(1.f + __expf(2.f * y)); return 0.5f * x * (1.f + t); }
__device__ __forceinline__ float wave_sum(float v) {
#pragma unroll
    for (int o = 1; o < 64; o <<= 1) v += __shfl_xor(v, o);
    return v;
}
__device__ __forceinline__ void store_bf4(bf16_t* p, f32x4 v) { uint2 o; o.x = pk2(v[0], v[1]); o.y = pk2(v[2], v[3]); *(uint2*)p = o; }
__device__ __forceinline__ f32x4 load_bf4(const bf16_t* p) { uint2 u = *(const uint2*)p; f32x4 v; v[0] = bflo(u.x); v[1] = bfhi(u.x); v[2] = bflo(u.y); v[3] = bfhi(u.y); return v; }

constexpr int LROW = 72;
namespace pg8 {
#define PG8_LAS __attribute__((address_space(3)))
constexpr int BM = 256, BK = 64, HALF = 128, HTB = HALF * BK * 2, STAGE_BYTES = 8 * HTB;
__device__ __forceinline__ int lds_byte(int r, int c) { const int st = (r >> 4) * 2 + (c >> 5), rr = r & 15, cc = c & 31, ob = rr * 64 + cc * 2; return st * 1024 + (ob ^ (((ob >> 9) & 1) << 5)); }
__device__ __forceinline__ void stage_rc(int b, int& R, int& C) { const int st = b / 1024, sb = b % 1024, swz = sb ^ (((sb >> 9) & 1) << 5); R = (st >> 1) * 16 + swz / 64; C = (st & 1) * 32 + (swz % 64) / 2; }
struct Unit { int pm, pn, g, part; };
struct GemmD { const bf16_t* A; const bf16_t* Bt; int lda, ldb, K, nM, nN, nG; size_t gsA, gsB; int permA; const bf16_t* A2; const bf16_t* Bt2; int dual; };
__device__ __forceinline__ int perm32(int rho) { const int n = rho >> 4, i = rho & 15; return 8 * (i >> 2) + 4 * n + (i & 3); }
struct EpiNoMid { static constexpr bool PERM = false; __device__ __forceinline__ void mid(f32x4 (&)[2][2][4][2], const Unit&, int, int, int, int) const {} };
__device__ __forceinline__ bool unit_at(const GemmD& d, int i, Unit& u) {
    const long L = (long)(d.dual ? (i >> 1) : i) * gridDim.x + blockIdx.x; const int per = d.nM * d.nN;
    u.part = d.dual ? (i & 1) : 0;
    if (L >= (long)per * d.nG) return false;
    if (d.nG == 1) {
        int wgid = (int)L; const int nwg = per;
        { const int q = nwg / 8, r = nwg % 8, xcd = wgid % 8, off = wgid / 8; wgid = (xcd < r ? xcd * (q + 1) : r * (q + 1) + (xcd - r) * q) + off; }
        const int nig = 8 * d.nN, gid = wgid / nig, fm = gid * 8, gsz = (d.nM - fm) < 8 ? (d.nM - fm) : 8;
        u.pm = fm + ((wgid % nig) % gsz); u.pn = (wgid % nig) / gsz; u.g = 0;
    } else if ((d.nG & 7) == 0) {
        const int x = (int)(L & 7), j = (int)(L >> 3), gpx = d.nG >> 3;
        u.g = x * gpx + j / per; const int w = j % per; u.pm = w / d.nN; u.pn = w % d.nN;
    } else { u.g = (int)(L / per); const int w = (int)(L % per); u.pm = w / d.nN; u.pn = w % d.nN; }
    return true;
}
__device__ __forceinline__ const char* a_base(const GemmD& d, const Unit& u) {
    const size_t row0 = d.permA ? (size_t)(((u.pm >> 5) << 13) + 4 * (u.pm & 31)) : (size_t)u.pm * 256;
    return (const char*)(((d.dual && u.part) ? d.A2 : d.A) + (size_t)u.g * d.gsA + row0 * d.lda);
}
__device__ __forceinline__ const char* b_base(const GemmD& d, const Unit& u) { return (const char*)(((d.dual && u.part) ? d.Bt2 : d.Bt) + (size_t)u.g * d.gsB + (size_t)u.pn * 256 * d.ldb); }

template <class Epi>
__device__ __forceinline__ void gemm_phase(PG8_LAS unsigned char* lds, const GemmD g, const Epi& E) {
    const int tid = threadIdx.x, wid = __builtin_amdgcn_readfirstlane(tid >> 6), lane = tid & 63, wr = wid >> 2, wc = wid & 3, fr = lane & 15, fq = lane >> 4;
    const int K = g.K, nt = K / BK;
    unsigned voffA[2], voffB[2];
#pragma unroll
    for (int i = 0; i < 2; ++i) { int R, C; stage_rc(tid * 16 + i * 8192, R, C);
        const int Ra = g.permA ? (((R & 63) << 7) + (R >> 6)) : R;
        const int Rb = Epi::PERM ? ((R & ~31) + perm32(R & 31)) : R;
        voffA[i] = (unsigned)(Ra * g.lda + C) * 2u; voffB[i] = (unsigned)(Rb * g.ldb + C) * 2u; }
    const size_t kstep = (size_t)(BK * 2);
    const size_t hstepA = g.permA ? (size_t)2 * g.lda * 2 : (size_t)HALF * g.lda * 2;
    const size_t hstepB = (size_t)HALF * g.ldb * 2;
    const unsigned ldsw = (unsigned)wid * 1024u;
    const int aoff = lds_byte(wr * 64 + fr, fq * 8), boff = lds_byte(wc * 32 + fr, fq * 8);
#define PG8_SA(b, h) (((b) * 2 + (h)) * HTB)
#define PG8_SB(b, h) ((4 + (b) * 2 + (h)) * HTB)
#define PG8_STAGE(bufoff, gbase, voff) do { _Pragma("unroll") for (int _i = 0; _i < 2; ++_i) \
        __builtin_amdgcn_global_load_lds((const unsigned*)((const char*)(gbase) + (voff)[_i]), (PG8_LAS unsigned*)(lds + (bufoff) + ldsw + _i * 8192), 16, 0, 0); } while (0)
#define PG8_LDA(dst, b, h) do { _Pragma("unroll") for (int m = 0; m < 4; ++m) _Pragma("unroll") for (int k = 0; k < 2; ++k) dst[m][k] = *(const PG8_LAS bf16x8*)(lds + PG8_SA(b, h) + aoff + m * 2048 + k * 1024); } while (0)
#define PG8_LDB(dst, b, h) do { _Pragma("unroll") for (int n = 0; n < 2; ++n) _Pragma("unroll") for (int k = 0; k < 2; ++k) dst[n][k] = *(const PG8_LAS bf16x8*)(lds + PG8_SB(b, h) + boff + n * 2048 + k * 1024); } while (0)
#define PG8_MMA(ai, bj, At, Bt) do { __builtin_amdgcn_s_setprio(1); _Pragma("unroll") for (int m = 0; m < 4; ++m) _Pragma("unroll") for (int n = 0; n < 2; ++n) _Pragma("unroll") for (int k = 0; k < 2; ++k) \
        acc[ai][bj][m][n] = __builtin_amdgcn_mfma_f32_16x16x32_bf16(Bt[n][k], At[m][k], acc[ai][bj][m][n], 0, 0, 0); __builtin_amdgcn_s_setprio(0); } while (0)
#define PG8_WAIT_V(n) asm volatile("s_waitcnt vmcnt(" #n ")" ::: "memory")
#define PG8_WAIT_L(n) asm volatile("s_waitcnt lgkmcnt(" #n ")" ::: "memory")
#define PG8_BAR __builtin_amdgcn_s_barrier()
#define PG8_SCHED __builtin_amdgcn_sched_barrier(0)
    Unit cur, nxt; int ui = 0;
    if (!unit_at(g, 0, cur)) return;
    f32x4 acc[2][2][4][2];
#pragma unroll
    for (int a = 0; a < 2; ++a)
#pragma unroll
        for (int b = 0; b < 2; ++b)
#pragma unroll
            for (int m = 0; m < 4; ++m)
#pragma unroll
                for (int n = 0; n < 2; ++n) acc[a][b][m][n] = (f32x4){0.f, 0.f, 0.f, 0.f};
    bf16x8 At[4][2], B0[2][2], B1[2][2];
    const char* cA = a_base(g, cur); const char* cB = b_base(g, cur);
    PG8_STAGE(PG8_SB(0, 0), cB, voffB); PG8_STAGE(PG8_SA(0, 0), cA, voffA); PG8_STAGE(PG8_SB(0, 1), cB + hstepB, voffB); PG8_STAGE(PG8_SA(0, 1), cA + hstepA, voffA);
    if (wr == 1) PG8_BAR;
    PG8_WAIT_V(4); PG8_BAR;
    PG8_STAGE(PG8_SB(1, 0), cB + kstep, voffB); PG8_STAGE(PG8_SA(1, 0), cA + kstep, voffA); PG8_STAGE(PG8_SB(1, 1), cB + hstepB + kstep, voffB);
    PG8_WAIT_V(6); PG8_BAR;
    for (;;) {
        const bool has_next = unit_at(g, ui + 1, nxt);
        const char* nA = has_next ? a_base(g, nxt) : cA; const char* nB = has_next ? b_base(g, nxt) : cB;
        for (int t = 0; t < nt; t += 2) {
            const bool last = (t == nt - 2);
            const char* a1 = cA + (size_t)(t + 1) * kstep;
            const char* a2 = last ? nA : cA + (size_t)(t + 2) * kstep; const char* b2 = last ? nB : cB + (size_t)(t + 2) * kstep;
            const char* a3 = a2 + kstep; const char* b3 = b2 + kstep;
            PG8_LDB(B0, 0, 0); PG8_SCHED; PG8_LDA(At, 0, 0); PG8_STAGE(PG8_SA(1, 1), a1 + hstepA, voffA);
            PG8_WAIT_L(8); PG8_BAR; PG8_WAIT_L(0); PG8_MMA(0, 0, At, B0); PG8_BAR; PG8_SCHED;
            PG8_LDB(B1, 0, 1); PG8_STAGE(PG8_SB(0, 0), b2, voffB);
            PG8_BAR; PG8_WAIT_L(0); PG8_MMA(0, 1, At, B1); PG8_BAR;
            PG8_LDA(At, 0, 1); PG8_STAGE(PG8_SA(0, 0), a2, voffA);
            PG8_BAR; PG8_WAIT_L(0); PG8_MMA(1, 0, At, B0); PG8_BAR; PG8_SCHED;
            PG8_STAGE(PG8_SB(0, 1), b2 + hstepB, voffB);
            PG8_WAIT_V(6); PG8_BAR; PG8_MMA(1, 1, At, B1); PG8_BAR;
            PG8_LDB(B0, 1, 0); PG8_SCHED; PG8_LDA(At, 1, 0); PG8_STAGE(PG8_SA(0, 1), a2 + hstepA, voffA);
            PG8_WAIT_L(8); PG8_BAR; PG8_WAIT_L(0); PG8_MMA(0, 0, At, B0); PG8_BAR; PG8_SCHED;
            PG8_LDB(B1, 1, 1); PG8_STAGE(PG8_SB(1, 0), b3, voffB);
            PG8_BAR; PG8_WAIT_L(0); PG8_MMA(0, 1, At, B1); PG8_BAR;
            PG8_LDA(At, 1, 1); PG8_STAGE(PG8_SA(1, 0), a3, voffA);
            PG8_BAR; PG8_WAIT_L(0); PG8_MMA(1, 0, At, B0); PG8_BAR; PG8_SCHED;
            PG8_STAGE(PG8_SB(1, 1), b3 + hstepB, voffB);
            PG8_WAIT_V(6); PG8_BAR; PG8_MMA(1, 1, At, B1); PG8_BAR;
        }
        const bool midp = g.dual && cur.part == 0;
        if (midp) E.mid(acc, cur, wr, wc, fr, fq); else E(acc, cur, wr, wc, fr, fq);
        if (!has_next) break;
        if (!midp)
#pragma unroll
        for (int a = 0; a < 2; ++a)
#pragma unroll
            for (int b = 0; b < 2; ++b)
#pragma unroll
                for (int m = 0; m < 4; ++m)
#pragma unroll
                    for (int n = 0; n < 2; ++n) acc[a][b][m][n] = (f32x4){0.f, 0.f, 0.f, 0.f};
        cur = nxt; cA = nA; cB = nB; ++ui;
    }
    PG8_WAIT_V(0);
    if (wr == 0) PG8_BAR;
    PG8_BAR;
#undef PG8_SA
#undef PG8_SB
#undef PG8_STAGE
#undef PG8_LDA
#undef PG8_LDB
#undef PG8_MMA
#undef PG8_WAIT_V
#undef PG8_WAIT_L
#undef PG8_BAR
#undef PG8_SCHED
}
}
using pg8::Unit; using pg8::GemmD;
typedef f32x4 AccT[2][2][4][2];
#define EPI_LOOP _Pragma("unroll") for (int ai = 0; ai < 2; ++ai) _Pragma("unroll") for (int bj = 0; bj < 2; ++bj) _Pragma("unroll") for (int mm = 0; mm < 4; ++mm) _Pragma("unroll") for (int nn = 0; nn < 2; ++nn) { \
    const int m = 256 * u.pm + 128 * ai + 64 * wr + 16 * mm + fr; const int n = 256 * u.pn + 128 * bj + 32 * wc + 16 * nn + 4 * fq; const f32x4 v = acc[ai][bj][mm][nn];
#define EPI_LOOP_END }
#define EPI_LOOP_NV _Pragma("unroll") for (int ai = 0; ai < 2; ++ai) _Pragma("unroll") for (int bj = 0; bj < 2; ++bj) _Pragma("unroll") for (int mm = 0; mm < 4; ++mm) _Pragma("unroll") for (int nn = 0; nn < 2; ++nn) { \
    const int m = 256 * u.pm + 128 * ai + 64 * wr + 16 * mm + fr; const int n = 256 * u.pn + 128 * bj + 32 * wc + 16 * nn + 4 * fq;

__device__ __forceinline__ int map_row(int mode, int n) {
    if (mode == 1) return ((n >> 7) << 8) + (n & 127);
    if (mode == 2) return ((n >> 7) << 8) + 128 + (n & 127);
    if (mode == 3) {
        if (n < 2048) return n;
        if (n < 2080) return 4096 + (n - 2048);
        if (n < 3104) { const int j = n - 2080; return 2048 + ((j >> 4) << 5) + (((j >> 2) & 3) << 3) + (j & 3); }
        { const int j = n - 3104; return 2048 + ((j >> 4) << 5) + (((j >> 2) & 3) << 3) + 4 + (j & 3); }
    }
    return n;
}
struct TItem { const float* src; bf16_t* dst; int K, mode, n0; };
__device__ __forceinline__ void transpose_load(const TItem& t, int N, float (&v)[8]) {
#pragma unroll
    for (int i = 0; i < 8; ++i) v[i] = t.src[(size_t)(8 * i) * N];
}
__device__ __forceinline__ void transpose_store(const TItem& t, const float (&v)[8], float* scr) {
    const int tid = threadIdx.x & 255;
#pragma unroll
    for (int i = 0; i < 8; ++i) scr[((tid >> 5) + 8 * i) * 33 + (tid & 31)] = v[i];
    __syncthreads();
    const int n = tid >> 3, kc = (tid & 7) * 8;
    const float* s = scr + kc * 33 + n;
    uint4 o; o.x = pk2(s[0], s[33]); o.y = pk2(s[66], s[99]); o.z = pk2(s[132], s[165]); o.w = pk2(s[198], s[231]);
    const int nd = map_row(t.mode, t.n0 + n);
    *(uint4*)(t.dst + (size_t)nd * t.K) = o;
    __syncthreads();
}
__device__ __forceinline__ void ada_item(const Params& P, int item, float* sm) {
    float* sv = sm; float* red = sm + 5 * 1024;
    const int tid = threadIdx.x & 255;
    for (int e = tid; e < 5 * 1024; e += 256) { const int r = e >> 10, k = e & 1023; const float c = r < 4 ? P.in[1][r * 1024 + k] : P.in[3][k]; sv[e] = siluf_(c); }
    __syncthreads();
    const int cgp = tid & 15, kg = tid >> 4, n0 = item * 64;
    f32x4 a[5];
#pragma unroll
    for (int r = 0; r < 5; ++r) a[r] = (f32x4){0.f, 0.f, 0.f, 0.f};
    const float* wp = P.in[4] + (size_t)(kg * 64) * 9216 + n0 + cgp * 4;
#pragma unroll 16
    for (int kk = 0; kk < 64; ++kk) {
        const f32x4 w4 = *(const f32x4*)(wp + (size_t)kk * 9216);
#pragma unroll
        for (int r = 0; r < 5; ++r) { const float s = sv[r * 1024 + kg * 64 + kk]; a[r] += w4 * s; }
    }
#pragma unroll
    for (int r = 0; r < 5; ++r) *(f32x4*)(red + (kg * 5 + r) * 64 + cgp * 4) = a[r];
    __syncthreads();
    for (int e = tid; e < 320; e += 256) {
        const int r = e >> 6, col = e & 63; float s = P.in[5][n0 + col];
#pragma unroll
        for (int g = 0; g < 16; ++g) s += red[(g * 5 + r) * 64 + col];
        ((float*)(P.ws + OFF_MOD))[r * 9216 + n0 + col] = s;
    }
    __syncthreads();
}

__device__ __forceinline__ float2 cmul(float2 a, float2 b) { return make_float2(a.x * b.x - a.y * b.y, a.x * b.y + a.y * b.x); }

__device__ __forceinline__ void phase0(const Params& P, unsigned char* smem) {
    const int hb = threadIdx.x >> 8;
    float* scr = (float*)(smem + hb * HALF_LDS);
    struct TW { int in; int K, N; size_t off; int mode; };
    const TW tw[13] = {
        {7, 1024, 2816, OFF_WGU1, 1}, {8, 1024, 2816, OFF_WGU1, 2}, {9, 2816, 1024, OFF_WDN1, 0},
        {29, 1024, 2816, OFF_WGU2, 1}, {30, 1024, 2816, OFF_WGU2, 2}, {31, 2816, 1024, OFF_WDN2, 0},
        {11, 1024, 4128, OFF_WIN, 3}, {20, 512, 512, OFF_WGLU, 0}, {22, 512, 1024, OFF_WS5O, 0}, {26, 512, 1024, OFF_WGLO, 0}, {27, 1024, 1024, OFF_WWO, 0},
        {0, 0, 0, 0, 0}, {0, 0, 0, 0, 0}};
    int total = 0;
#pragma unroll
    for (int i = 0; i < 11; ++i) total += (tw[i].K >> 6) * (tw[i].N >> 5);
    const int n_ada = 144;
    for (int base = blockIdx.x * 2; base < n_ada; base += gridDim.x * 2) ada_item(P, base + hb, scr);
    auto lookup = [&](int it, TItem& t, int& N) {
        int r = it < total ? it : total - 1;
        t.src = nullptr; t.dst = nullptr; t.K = 0; t.mode = 0; t.n0 = 0; N = 0;
#pragma unroll
        for (int i = 0; i < 11; ++i) {
            const int cnt = (tw[i].K >> 6) * (tw[i].N >> 5);
            if (r >= 0 && r < cnt) {
                const int nblk = tw[i].N >> 5, kb = r / nblk, nb = r - kb * nblk, k0 = kb * 64, n0 = nb * 32, tid = threadIdx.x & 255;
                N = tw[i].N; t.K = tw[i].K; t.mode = tw[i].mode; t.n0 = n0;
                t.src = P.in[tw[i].in] + (size_t)(k0 + (tid >> 5)) * tw[i].N + n0 + (tid & 31);
                t.dst = (bf16_t*)(P.ws + tw[i].off) + k0 + (tid & 7) * 8;
            }
            r -= cnt;
        }
    };
    {
        const int stride = gridDim.x * 2;
        int it = blockIdx.x * 2 + hb;
        TItem cur, nxt; int Nc = 0, Nn = 0; float vn[8];
        if (blockIdx.x * 2 < total) { lookup(it, nxt, Nn); transpose_load(nxt, Nn, vn); }
        for (int base = blockIdx.x * 2; base < total; base += stride) {
            float v[8];
#pragma unroll
            for (int i = 0; i < 8; ++i) v[i] = vn[i];
            cur = nxt; Nc = Nn;
            if (base + stride < total) { lookup(it + stride, nxt, Nn); transpose_load(nxt, Nn, vn); }
            transpose_store(cur, v, scr);
            it += stride;
        }
    }
    const int gtid = blockIdx.x * NTHR + threadIdx.x, gsz = gridDim.x * NTHR;
    for (int e = gtid; e < NT + 2 * NL; e += gsz) ((float*)(P.ws + OFF_SS))[e] = 0.f;
    float2* LP = (float2*)(P.ws + OFF_LP); float2* BB = (float2*)(P.ws + OFF_BB);
    for (int e = gtid; e < 2 * 32 * 33 * 64; e += gsz) {
        const int p = e & 63, tau = (e >> 6) % 33, dg = e / (33 * 64);
        const float lre = fminf(P.in[12][dg * 64 + p], -1e-4f), lim = P.in[13][dg * 64 + p], dt = expf(P.in[14][dg]);
        const float mag = expf(lre * dt * (float)tau), ang = (lim * dt) * (float)tau;
        float sn, cs; sincosf(ang, &sn, &cs);
        LP[e] = make_float2(mag * cs, mag * sn);
    }
    for (int e = gtid; e < 2 * 32 * 64 * 16; e += gsz) {
        const int dgp = e >> 4;
        const int dg = dgp >> 6;
        const float lre = fminf(P.in[12][dgp], -1e-4f), lim = P.in[13][dgp], dt = expf(P.in[14][dg]);
        const float mag = expf(lre * dt), ang = lim * dt;
        float sn, cs; sincosf(ang, &sn, &cs);
        const float ar = mag * cs - 1.f, ai = mag * sn;
        const float den = lre * lre + lim * lim;
        const float qr = (ar * lre + ai * lim) / den, qi = (ai * lre - ar * lim) / den;
        BB[e] = cmul(make_float2(qr, qi), make_float2(P.in[15][e], P.in[16][e]));
    }
}

__device__ __forceinline__ void norm_row_pre(const f32x4 (&v)[4], const float* __restrict__ g, const float* __restrict__ shift, const float* __restrict__ scale, bf16_t* __restrict__ dst, int lane) {
    float ss = 0.f;
#pragma unroll
    for (int j = 0; j < 4; ++j) ss += v[j][0] * v[j][0] + v[j][1] * v[j][1] + v[j][2] * v[j][2] + v[j][3] * v[j][3];
    ss = wave_sum(ss);
    const float rstd = rsqrtf(ss * (1.f / 1024.f) + 1e-6f);
#pragma unroll
    for (int j = 0; j < 4; ++j) {
        const int c4 = lane + 64 * j;
        const f32x4 g4 = ((const f32x4*)g)[c4], sh = ((const f32x4*)shift)[c4], sc = ((const f32x4*)scale)[c4];
        f32x4 h = (v[j] * rstd) * g4; h = h * (sc + 1.f) + sh;
        store_bf4(dst + c4 * 4, h);
    }
}
__device__ __forceinline__ void norm_row(const float* __restrict__ src, const float* __restrict__ g, const float* __restrict__ shift, const float* __restrict__ scale, bf16_t* __restrict__ dst, int lane) {
    f32x4 v[4]; float ss = 0.f;
#pragma unroll
    for (int j = 0; j < 4; ++j) { v[j] = ((const f32x4*)src)[lane + 64 * j]; ss += v[j][0] * v[j][0] + v[j][1] * v[j][1] + v[j][2] * v[j][2] + v[j][3] * v[j][3]; }
    ss = wave_sum(ss);
    const float rstd = rsqrtf(ss * (1.f / 1024.f) + 1e-6f);
#pragma unroll
    for (int j = 0; j < 4; ++j) {
        const int c4 = lane + 64 * j;
        const f32x4 g4 = ((const f32x4*)g)[c4], sh = ((const f32x4*)shift)[c4], sc = ((const f32x4*)scale)[c4];
        f32x4 h = (v[j] * rstd) * g4; h = h * (sc + 1.f) + sh;
        store_bf4(dst + c4 * 4, h);
    }
}

__device__ __forceinline__ void phase1(const Params& P) {
    const int lane = threadIdx.x & 63, w = threadIdx.x >> 6;
    const float* mod = (const float*)(P.ws + OFF_MOD);
    bf16_t* H = (bf16_t*)(P.ws + OFF_H);
    {
        const int stride = gridDim.x * 8;
        int row = blockIdx.x * 8 + w;
        f32x4 vn[4];
        if (row < NT) { const float* src = row < NL ? P.in[0] + (size_t)row * 1024 : P.in[2] + (size_t)(row - NL) * 1024;
#pragma unroll
            for (int j = 0; j < 4; ++j) vn[j] = ((const f32x4*)src)[lane + 64 * j]; }
        while (row < NT) {
            f32x4 v[4];
#pragma unroll
            for (int j = 0; j < 4; ++j) v[j] = vn[j];
            const int nrow = row + stride;
            if (nrow < NT) { const float* src = nrow < NL ? P.in[0] + (size_t)nrow * 1024 : P.in[2] + (size_t)(nrow - NL) * 1024;
#pragma unroll
                for (int j = 0; j < 4; ++j) vn[j] = ((const f32x4*)src)[lane + 64 * j]; }
            const int mr = row < NL ? (row >> 13) : 4;
            norm_row_pre(v, P.in[6], mod + mr * 9216 + 0, mod + mr * 9216 + 1024, H + (size_t)row * 1024, lane);
            if (row >= NL) {
#pragma unroll
                for (int j = 0; j < 4; ++j) ((f32x4*)((float*)(P.ws + OFF_E) + (size_t)(row - NL) * 1024))[lane + 64 * j] = v[j];
            }
            row = nrow;
        }
    }
    for (int r0 = blockIdx.x * 32 + w * 4; r0 < 4352 + 5632; r0 += gridDim.x * 32) {
        const bool first = r0 < 4352;
        const bf16_t* wt = first ? (const bf16_t*)(P.ws + OFF_WIN) + (size_t)r0 * 1024 : (const bf16_t*)(P.ws + OFF_WGU2) + (size_t)(r0 - 4352) * 1024;
        const float* sh = mod + (first ? 3 : 6) * 1024 + lane * 16;
        uint4 wq[4][2];
#pragma unroll
        for (int i = 0; i < 4; ++i) { wq[i][0] = *(const uint4*)(wt + (size_t)i * 1024 + lane * 16); wq[i][1] = *(const uint4*)(wt + (size_t)i * 1024 + lane * 16 + 8); }
        f32x4 s4[5][4];
#pragma unroll
        for (int mr = 0; mr < 5; ++mr)
#pragma unroll
            for (int q = 0; q < 4; ++q) s4[mr][q] = *(const f32x4*)(sh + mr * 9216 + q * 4);
        float* BW = (float*)(P.ws + OFF_BW);
#pragma unroll
        for (int i = 0; i < 4; ++i) {
            const uint4 w0 = wq[i][0], w1 = wq[i][1];
            const float wv[16] = {bflo(w0.x), bfhi(w0.x), bflo(w0.y), bfhi(w0.y), bflo(w0.z), bfhi(w0.z), bflo(w0.w), bfhi(w0.w),
                                  bflo(w1.x), bfhi(w1.x), bflo(w1.y), bfhi(w1.y), bflo(w1.z), bfhi(w1.z), bflo(w1.w), bfhi(w1.w)};
            const int r = r0 + i;
#pragma unroll
            for (int mr = 0; mr < 5; ++mr) {
                float a = 0.f;
#pragma unroll
                for (int q = 0; q < 4; ++q) a += s4[mr][q][0] * wv[q * 4] + s4[mr][q][1] * wv[q * 4 + 1] + s4[mr][q][2] * wv[q * 4 + 2] + s4[mr][q][3] * wv[q * 4 + 3];
                a = wave_sum(a);
                if (lane == 0) { if (first) BW[mr * 4352 + r] = a; else BW[5 * 4352 + mr * 5632 + (r - 4352)] = a; }
            }
        }
    }
    const int gtid = blockIdx.x * NTHR + threadIdx.x, gsz = gridDim.x * NTHR;
    const float2* LP = (const float2*)(P.ws + OFF_LP); const float2* BB = (const float2*)(P.ws + OFF_BB);
    float* KD = (float*)(P.ws + OFF_KD);
    {
        constexpr int N = 2 * 32 * 32 * 256;
        int e0 = gtid;
        for (; e0 + 3 * gsz < N; e0 += 4 * gsz) {
            float sacc[4] = {0.f, 0.f, 0.f, 0.f};
#pragma unroll 2
            for (int p = 0; p < 64; ++p) {
#pragma unroll
                for (int q = 0; q < 4; ++q) {
                    const int e = e0 + q * gsz;
                    const int cp = e & 15, c = (e >> 4) & 15, tau = (e >> 8) & 31, dg = e >> 13;
                    const float2 C = make_float2(P.in[17][(dg * 16 + c) * 64 + p], P.in[18][(dg * 16 + c) * 64 + p]);
                    const float2 z = cmul(LP[(dg * 33 + tau) * 64 + p], BB[(dg * 64 + p) * 16 + cp]);
                    sacc[q] += C.x * z.x - C.y * z.y;
                }
            }
#pragma unroll
            for (int q = 0; q < 4; ++q) KD[e0 + q * gsz] = sacc[q];
        }
        for (; e0 < N; e0 += gsz) {
            const int e = e0, cp = e & 15, c = (e >> 4) & 15, tau = (e >> 8) & 31, dg = e >> 13;
            float sa = 0.f;
            for (int p = 0; p < 64; ++p) {
                const float2 C = make_float2(P.in[17][(dg * 16 + c) * 64 + p], P.in[18][(dg * 16 + c) * 64 + p]);
                const float2 z = cmul(LP[(dg * 33 + tau) * 64 + p], BB[(dg * 64 + p) * 16 + cp]);
                sa += C.x * z.x - C.y * z.y;
            }
            KD[e] = sa;
        }
    }
    bf16_t* WE = (bf16_t*)(P.ws + OFF_WE);
    auto we_val = [&](int e) -> float {
        const int k = e & 511, n = (e >> 9) & 255, g = e >> 17;
        const int s = k >> 4, cp = k & 15, d = n >> 7, ri = (n >> 6) & 1, p = n & 63, dg = d * 32 + g;
        const int tau = d == 0 ? 31 - s : s;
        const float2 z = cmul(LP[(dg * 33 + tau) * 64 + p], BB[(dg * 64 + p) * 16 + cp]);
        return ri ? z.y : z.x;
    };
    {
        constexpr int N = 32 * 256 * 512;
        int e0 = gtid;
        for (; e0 + 3 * gsz < N; e0 += 4 * gsz) {
            float val[4];
#pragma unroll
            for (int q = 0; q < 4; ++q) val[q] = we_val(e0 + q * gsz);
#pragma unroll
            for (int q = 0; q < 4; ++q) WE[e0 + q * gsz] = f2bf(val[q]);
        }
        for (; e0 < N; e0 += gsz) WE[e0] = f2bf(we_val(e0));
    }
    bf16_t* WY = (bf16_t*)(P.ws + OFF_WY);
    auto po_val = [&](int e) -> float {
        const int kk = e & 255, n = (e >> 8) & 511, g = e >> 17;
        const int t = n >> 4, c = n & 15, d = kk >> 7, ri = (kk >> 6) & 1, p = kk & 63, dg = d * 32 + g;
        const int tau = d == 0 ? t + 1 : 32 - t;
        const float2 C = make_float2(P.in[17][(dg * 16 + c) * 64 + p], P.in[18][(dg * 16 + c) * 64 + p]);
        const float2 z = cmul(C, LP[(dg * 33 + tau) * 64 + p]);
        return ri ? -z.y : z.x;
    };
    auto po_idx = [&](int e) -> size_t { const int kk = e & 255, n = (e >> 8) & 511, g = e >> 17; return ((size_t)g * 512 + n) * 768 + 512 + kk; };
    {
        constexpr int N = 32 * 512 * 256;
        int e0 = gtid;
        for (; e0 + 3 * gsz < N; e0 += 4 * gsz) {
            float val[4];
#pragma unroll
            for (int q = 0; q < 4; ++q) val[q] = po_val(e0 + q * gsz);
#pragma unroll
            for (int q = 0; q < 4; ++q) WY[po_idx(e0 + q * gsz)] = f2bf(val[q]);
        }
        for (; e0 < N; e0 += gsz) WY[po_idx(e0)] = f2bf(po_val(e0));
    }
}

__device__ __forceinline__ void phase4(const Params& P) {
    const int lane = threadIdx.x & 63, w = threadIdx.x >> 6;
    const float* mod = (const float*)(P.ws + OFF_MOD);
    bf16_t* H = (bf16_t*)(P.ws + OFF_H);
    const float* XRC = (const float*)(P.ws + OFF_E);
    float* ss2 = (float*)(P.ws + OFF_SS);
    for (int r0 = blockIdx.x * 32 + w * 4; r0 < NC; r0 += gridDim.x * 32)
    for (int r = r0; r < r0 + 4; ++r) {
        const float* src = XRC + (size_t)r * 1024;
        float ss = 0.f;
#pragma unroll
        for (int j = 0; j < 4; ++j) {
            const int c4 = lane + 64 * j;
            const f32x4 v = ((const f32x4*)src)[c4];
            ss += v[0] * v[0] + v[1] * v[1] + v[2] * v[2] + v[3] * v[3];
            const f32x4 g4 = ((const f32x4*)P.in[10])[c4], sc = ((const f32x4*)(mod + 4 * 9216 + 4 * 1024))[c4];
            store_bf4(H + (size_t)(NL + r) * 1024 + c4 * 4, v * (g4 * (sc + 1.f)));
        }
        ss = wave_sum(ss);
        if (lane == 0) ss2[NL + r] = ss;
    }
    const bool split = gridDim.x > 64;
    if (split && blockIdx.x < 32) return;
    const int gtid = (split ? (int)blockIdx.x - 32 : (int)blockIdx.x) * NTHR + threadIdx.x, gsz = (split ? (int)gridDim.x - 32 : (int)gridDim.x) * NTHR;
    const float* KD = (const float*)(P.ws + OFF_KD);
    bf16_t* WY = (bf16_t*)(P.ws + OFF_WY);
    auto kf_val = [&](int e) -> float {
        const int k = e & 511, n = (e >> 9) & 511, g = e >> 18;
        const int t = n >> 4, c = n & 15, s = k >> 4, cp = k & 15;
        const int d0 = t - s, d1 = s - t;
        const float a0 = KD[(((0 * 32 + g) * 32 + (d0 > 0 ? d0 : 0)) * 16 + c) * 16 + cp];
        const float a1 = KD[(((1 * 32 + g) * 32 + (d1 > 0 ? d1 : 0)) * 16 + c) * 16 + cp];
        return (s <= t ? a0 : 0.f) + (s >= t ? a1 : 0.f);
    };
    auto kf_idx = [&](int e) -> size_t { const int k = e & 511, n = (e >> 9) & 511, g = e >> 18; return ((size_t)g * 512 + n) * 768 + k; };
    {
        constexpr int N = 32 * 512 * 512;
        int e0 = gtid;
        for (; e0 + 3 * gsz < N; e0 += 4 * gsz) {
            float val[4];
#pragma unroll
            for (int q = 0; q < 4; ++q) val[q] = kf_val(e0 + q * gsz);
#pragma unroll
            for (int q = 0; q < 4; ++q) WY[kf_idx(e0 + q * gsz)] = f2bf(val[q]);
        }
        for (; e0 < N; e0 += gsz) WY[kf_idx(e0)] = f2bf(kf_val(e0));
    }
}

__device__ __forceinline__ void phase15(const Params& P) {
    const int lane = threadIdx.x & 63, w = threadIdx.x >> 6;
    const float* ss4 = (const float*)(P.ws + OFF_SS) + NT + NL;
    const int stride = gridDim.x * 8;
    int row = blockIdx.x * 8 + w;
    f32x4 vn[4]; float sn = 0.f;
    if (row < NL) { sn = ss4[row];
#pragma unroll
        for (int j = 0; j < 4; ++j) vn[j] = ((const f32x4*)(P.out + (size_t)row * 1024))[lane + 64 * j]; }
    f32x4 fn[4];
#pragma unroll
    for (int j = 0; j < 4; ++j) fn[j] = ((const f32x4*)P.in[32])[lane + 64 * j];
    while (row < NL) {
        f32x4 v[4]; const float sc = sn;
#pragma unroll
        for (int j = 0; j < 4; ++j) v[j] = vn[j];
        const int nrow = row + stride;
        if (nrow < NL) { sn = ss4[nrow];
#pragma unroll
            for (int j = 0; j < 4; ++j) vn[j] = ((const f32x4*)(P.out + (size_t)nrow * 1024))[lane + 64 * j]; }
        const float rstd = rsqrtf(sc * (1.f / 1024.f) + 1e-6f);
        f32x4* o = (f32x4*)(P.out + (size_t)row * 1024);
#pragma unroll
        for (int j = 0; j < 4; ++j) o[lane + 64 * j] = (v[j] * rstd) * fn[j];
        row = nrow;
    }
}

template <int NORM> struct EpiFfnUp : pg8::EpiNoMid {
    static constexpr bool PERM = true;
    bf16_t* HID; const float* ss; const float* BW;
    __device__ __forceinline__ void operator()(const AccT& acc, const Unit& u, int wr, int wc, int fr, int fq) const {
        f32x4 bwg[2], bwu[2]; float rstd[2][4];
        if (NORM) {
            const float* bw = BW + ((256 * u.pm) >> 13) * 5632 + 256 * u.pn + 32 * wc + 8 * fq;
#pragma unroll
            for (int nn = 0; nn < 2; ++nn) { bwg[nn] = *(const f32x4*)(bw + 4 * nn); bwu[nn] = *(const f32x4*)(bw + 128 + 4 * nn); }
#pragma unroll
            for (int ai = 0; ai < 2; ++ai)
#pragma unroll
                for (int mm = 0; mm < 4; ++mm) rstd[ai][mm] = rsqrtf(ss[256 * u.pm + 128 * ai + 64 * wr + 16 * mm + fr] * (1.f / 1024.f) + 1e-6f);
        }
        const int oc = 128 * u.pn + 32 * wc + 8 * fq;
#pragma unroll
        for (int ai = 0; ai < 2; ++ai)
#pragma unroll
            for (int mm = 0; mm < 4; ++mm) {
                const int m = 256 * u.pm + 128 * ai + 64 * wr + 16 * mm + fr;
                f32x4 o[2];
#pragma unroll
                for (int nn = 0; nn < 2; ++nn) {
                    f32x4 g = acc[ai][0][mm][nn], uu = acc[ai][1][mm][nn];
                    if (NORM) { g = g * rstd[ai][mm] + bwg[nn]; uu = uu * rstd[ai][mm] + bwu[nn]; }
#pragma unroll
                    for (int r = 0; r < 4; ++r) o[nn][r] = siluf_(g[r]) * uu[r];
                }
                *(uint4*)(HID + (size_t)m * FF + oc) = make_uint4(pk2(o[0][0], o[0][1]), pk2(o[0][2], o[0][3]), pk2(o[1][0], o[1][1]), pk2(o[1][2], o[1][3]));
            }
    }
};
template <int MODE> struct EpiRes : pg8::EpiNoMid {
    static constexpr bool PERM = true;
    const float* x; bf16_t* XRb; float* out; bf16_t* Hn; const float* mod; const float* gnext; float* ss;
    __device__ __forceinline__ void operator()(const AccT& acc, const Unit& u, int wr, int wc, int fr, int fq) const {
        constexpr int GJ = MODE == 0 ? 2 : (MODE == 1 ? 5 : 8), SJ = MODE == 0 ? 4 : 7;
        constexpr float COEF = MODE == 1 ? 1.f : 0.5f;
        const float* mb = mod + ((256 * u.pm) >> 13) * 9216;
        const int nb = 256 * u.pn + 32 * wc + 8 * fq;
        f32x4 gate[2][2]; uint2 gmp[2][2];
#pragma unroll
        for (int bj = 0; bj < 2; ++bj)
#pragma unroll
            for (int nn = 0; nn < 2; ++nn) {
                const int n = nb + 128 * bj + 4 * nn;
                gate[bj][nn] = *(const f32x4*)(mb + GJ * 1024 + n) * COEF;
                if (MODE < 2) { const f32x4 t = *(const f32x4*)(gnext + n) * (*(const f32x4*)(mb + SJ * 1024 + n) + 1.f); gmp[bj][nn] = make_uint2(pk2(t[0], t[1]), pk2(t[2], t[3])); }
            }
#pragma unroll
        for (int ai = 0; ai < 2; ++ai)
#pragma unroll
        for (int mh = 0; mh < 2; ++mh) {
            const size_t rb = (size_t)(256 * u.pm + 128 * ai + 64 * wr + 32 * mh + fr) * 1024 + nb;
            f32x4 xf[MODE == 0 ? 2 : 1][2][2]; uint4 xh[MODE == 0 ? 1 : 2][2];
#pragma unroll
            for (int mm = 0; mm < 2; ++mm)
#pragma unroll
                for (int bj = 0; bj < 2; ++bj) {
                    const size_t idx = rb + (size_t)mm * 16 * 1024 + 128 * bj;
                    if (MODE == 0) { xf[mm][bj][0] = *(const f32x4*)(x + idx); xf[mm][bj][1] = *(const f32x4*)(x + idx + 4); }
                    else xh[mm][bj] = *(const uint4*)(XRb + idx);
                }
#pragma unroll
            for (int mm = 0; mm < 2; ++mm) {
                float part = 0.f;
#pragma unroll
                for (int bj = 0; bj < 2; ++bj) {
                    const size_t idx = rb + (size_t)mm * 16 * 1024 + 128 * bj;
                    f32x4 x0, x1;
                    if (MODE == 0) { x0 = xf[mm][bj][0]; x1 = xf[mm][bj][1]; }
                    else { const uint4 h4 = xh[mm][bj]; x0 = (f32x4){bflo(h4.x), bfhi(h4.x), bflo(h4.y), bfhi(h4.y)}; x1 = (f32x4){bflo(h4.z), bfhi(h4.z), bflo(h4.w), bfhi(h4.w)}; }
                    const f32x4 n0 = x0 + gate[bj][0] * acc[ai][bj][2 * mh + mm][0], n1 = x1 + gate[bj][1] * acc[ai][bj][2 * mh + mm][1];
                    part += (n0[0] * n0[0] + n0[1] * n0[1] + n0[2] * n0[2] + n0[3] * n0[3]) + (n1[0] * n1[0] + n1[1] * n1[1] + n1[2] * n1[2] + n1[3] * n1[3]);
                    if (MODE < 2) {
                        *(uint4*)(XRb + idx) = make_uint4(pk2(n0[0], n0[1]), pk2(n0[2], n0[3]), pk2(n1[0], n1[1]), pk2(n1[2], n1[3]));
                        const f32x4 g0 = {bflo(gmp[bj][0].x), bfhi(gmp[bj][0].x), bflo(gmp[bj][0].y), bfhi(gmp[bj][0].y)}, g1 = {bflo(gmp[bj][1].x), bfhi(gmp[bj][1].x), bflo(gmp[bj][1].y), bfhi(gmp[bj][1].y)};
                        const f32x4 h0 = n0 * g0, h1 = n1 * g1;
                        *(uint4*)(Hn + idx) = make_uint4(pk2(h0[0], h0[1]), pk2(h0[2], h0[3]), pk2(h1[0], h1[1]), pk2(h1[2], h1[3]));
                    } else { *(f32x4*)(out + idx) = n0; *(f32x4*)(out + idx + 4) = n1; }
                }
                part += __shfl_xor(part, 16); part += __shfl_xor(part, 32);
                if (fq == 0) (void)__hip_atomic_fetch_add(ss + 256 * u.pm + 128 * ai + 64 * wr + 32 * mh + 16 * mm + fr, part, __ATOMIC_RELAXED, __HIP_MEMORY_SCOPE_AGENT);
            }
        }
    }
};
template <int NORM>
__device__ __forceinline__ void phase_ffn_up(const Params& P, PG8_LAS unsigned char* lds, size_t off_w, int M) {
    GemmD g{}; g.A = (const bf16_t*)(P.ws + OFF_H); g.Bt = (const bf16_t*)(P.ws + off_w); g.lda = 1024; g.ldb = 1024; g.K = 1024; g.nM = M >> 8; g.nN = 22; g.nG = 1;
    EpiFfnUp<NORM> E; E.HID = (bf16_t*)(P.ws + OFF_HID); E.ss = (const float*)(P.ws + OFF_SS) + NT; E.BW = (const float*)(P.ws + OFF_BW) + 5 * 4352;
    pg8::gemm_phase(lds, g, E);
}
struct EpiFfnDownCtx : pg8::EpiNoMid {
    float* XR; const float* mod;
    __device__ __forceinline__ void operator()(const AccT& acc, const Unit& u, int wr, int wc, int fr, int fq) const {
#pragma unroll
        for (int bj = 0; bj < 2; ++bj)
#pragma unroll
            for (int nn = 0; nn < 2; ++nn) {
                const int n = 256 * u.pn + 128 * bj + 32 * wc + 16 * nn + 4 * fq;
                const f32x4 gt = *(const f32x4*)(mod + 4 * 9216 + 2 * 1024 + n) * 0.5f;
                float* xb = XR + (size_t)(256 * u.pm + 64 * wr + fr) * 1024 + n;
#pragma unroll
                for (int ai = 0; ai < 2; ++ai)
#pragma unroll
                    for (int mm = 0; mm < 4; ++mm) {
                        float* xp = xb + (size_t)(128 * ai + 16 * mm) * 1024;
                        const f32x4 v = acc[ai][bj][mm][nn] * gt;
#pragma unroll
                        for (int r = 0; r < 4; ++r) (void)__hip_atomic_fetch_add(xp + r, v[r], __ATOMIC_RELAXED, __HIP_MEMORY_SCOPE_AGENT);
                    }
                asm volatile("" ::: "memory");
            }
    }
};
template <int FIRST>
__device__ __forceinline__ void phase_ffn_down(const Params& P, PG8_LAS unsigned char* lds, size_t off_w) {
    GemmD g{}; g.A = (const bf16_t*)(P.ws + OFF_HID); g.Bt = (const bf16_t*)(P.ws + off_w); g.lda = FF; g.ldb = FF; g.K = FF; g.nM = NL >> 8; g.nN = 4; g.nG = 1;
    EpiRes<FIRST ? 0 : 2> E; E.x = P.in[0]; E.XRb = (bf16_t*)(P.ws + OFF_XR); E.out = P.out; E.Hn = (bf16_t*)(P.ws + OFF_H); E.mod = (const float*)(P.ws + OFF_MOD);
    E.gnext = P.in[10]; E.ss = (float*)(P.ws + OFF_SS) + (FIRST ? 0 : NT + NL);
    pg8::gemm_phase(lds, g, E);
    if (FIRST) {
        GemmD c{}; c.A = (const bf16_t*)(P.ws + OFF_HID) + (size_t)NL * FF; c.Bt = g.Bt; c.lda = FF; c.ldb = FF; c.K = 256; c.nM = 4; c.nN = 4; c.nG = 11; c.gsA = 256; c.gsB = 256;
        EpiFfnDownCtx EC; EC.XR = (float*)(P.ws + OFF_E); EC.mod = E.mod;
        pg8::gemm_phase(lds, c, EC);
    }
}
__device__ __forceinline__ uint4 pack8(f32x4 a, f32x4 b) { return make_uint4(pk2(a[0], a[1]), pk2(a[2], a[3]), pk2(b[0], b[1]), pk2(b[2], b[3])); }
struct EpiWin : pg8::EpiNoMid {
    static constexpr bool PERM = true;
    bf16_t *U, *Q, *Kb, *V, *R, *GLR, *GA, *GB; const float* ss; const float* BW;
    __device__ __forceinline__ void operator()(const AccT& acc, const Unit& u, int wr, int wc, int fr, int fq) const {
        f32x4 bias[2][2]; float rstd[2][4];
        const int m0 = 256 * u.pm, nb = 256 * u.pn + 32 * wc + 8 * fq;
        {
            const float* bw = BW + (m0 < NL ? (m0 >> 13) : 4) * 4352 + nb;
#pragma unroll
            for (int bj = 0; bj < 2; ++bj)
#pragma unroll
                for (int nn = 0; nn < 2; ++nn) bias[bj][nn] = *(const f32x4*)(bw + 128 * bj + 4 * nn);
#pragma unroll
            for (int ai = 0; ai < 2; ++ai)
#pragma unroll
                for (int mm = 0; mm < 4; ++mm) rstd[ai][mm] = rsqrtf(ss[m0 + 128 * ai + 64 * wr + 16 * mm + fr] * (1.f / 1024.f) + 1e-6f);
        }
#pragma unroll
        for (int ai = 0; ai < 2; ++ai)
#pragma unroll
            for (int mm = 0; mm < 4; ++mm) {
                const int m = m0 + 128 * ai + 64 * wr + 16 * mm + fr;
                const bool lat = m < NL;
                const int b = lat ? (m >> 13) : ((m - NL) >> 8), l = lat ? (m & 8191) : ((m - NL) & 255);
                const int rcm = lat ? (b << 13) + ((l & 63) << 7) + (l >> 6) : m;
#pragma unroll
                for (int bj = 0; bj < 2; ++bj) {
                    const int n = nb + 128 * bj;
                    const f32x4 v0 = acc[ai][bj][mm][0] * rstd[ai][mm] + bias[bj][0], v1 = acc[ai][bj][mm][1] * rstd[ai][mm] + bias[bj][1];
                    if (n < 512) {
                        const int g = n >> 4, urow = lat ? (b << 8) + (l >> 5) : 1024 + (b << 3) + (l >> 5), t = l & 31;
                        *(uint4*)(U + ((size_t)g * UROWS + urow) * 768 + t * 16 + (n & 15)) = pack8(v0, v1);
                    } else if (n < 768) { *(uint4*)(Q + (size_t)rcm * 256 + (n - 512)) = pack8(v0 * 0.125f, v1 * 0.125f); }
                    else if (n < 1024) { *(uint4*)(Kb + (size_t)rcm * 256 + (n - 768)) = pack8(v0, v1); }
                    else if (n < 1536) { *(uint4*)(V + (size_t)rcm * 512 + (n - 1024)) = pack8(v0, v1); }
                    else if (n < 2048) { *(uint4*)(R + (size_t)rcm * 512 + (n - 1536)) = pack8(v0, v1); }
                    else if (n < 4096) {
                        if (lat) {
                            const int j0 = ((256 * u.pn + 128 * bj + 32 * wc - 2048) >> 1) + 4 * fq;
                            f32x4 sa, rt;
#pragma unroll
                            for (int r = 0; r < 4; ++r) { const float ea = 1.f + __expf(-v0[r]), eb = 1.f + __expf(-v1[r]); sa[r] = rcpf_(ea); rt[r] = ea * rcpf_(eb); }
                            store_bf4(GA + (size_t)m * 1024 + j0, sa);
                            store_bf4(GB + (size_t)m * 1024 + j0, rt);
                        }
                    }
                    else if (n < 4128) { *(uint4*)(GLR + (size_t)rcm * 32 + (n - 4096)) = pack8(v0, v1); }
                }
            }
    }
};
__device__ __forceinline__ void phase5(const Params& P, PG8_LAS unsigned char* lds) {
    GemmD g{}; g.A = (const bf16_t*)(P.ws + OFF_H); g.Bt = (const bf16_t*)(P.ws + OFF_WIN); g.lda = 1024; g.ldb = 1024; g.K = 1024; g.nM = NT >> 8; g.nN = 17; g.nG = 1;
    EpiWin E; E.U = (bf16_t*)(P.ws + OFF_U); E.Q = (bf16_t*)(P.ws + OFF_Q); E.Kb = (bf16_t*)(P.ws + OFF_K); E.V = (bf16_t*)(P.ws + OFF_V); E.R = (bf16_t*)(P.ws + OFF_R);
    E.GLR = (bf16_t*)(P.ws + OFF_GLR); E.GA = (bf16_t*)P.out; E.GB = E.GA + (size_t)NL * 1024; E.ss = (const float*)(P.ws + OFF_SS); E.BW = (const float*)(P.ws + OFF_BW);
    pg8::gemm_phase(lds, g, E);
}

__device__ __forceinline__ float logsig(float z) { return fminf(z, 0.f) - __logf(1.f + __expf(-fabsf(z))); }

struct VRegs { uint4 a0, a1, b0, b1; };
__device__ __forceinline__ VRegs load_v_regs(const bf16_t* __restrict__ Vg, int t) {
    const int ip = t & 31, c = t >> 5; VRegs r;
    const bf16_t* p = Vg + (size_t)(2 * ip) * 512 + c * 16;
    r.a0 = *(const uint4*)p; r.a1 = *(const uint4*)(p + 8); r.b0 = *(const uint4*)(p + 512); r.b1 = *(const uint4*)(p + 520);
    return r;
}
__device__ __forceinline__ void store_vt(const VRegs& r, bf16_t* sVt, int t) {
    const int ip = t & 31, c = t >> 5;
    const unsigned ua[8] = {r.a0.x, r.a0.y, r.a0.z, r.a0.w, r.a1.x, r.a1.y, r.a1.z, r.a1.w};
    const unsigned ub[8] = {r.b0.x, r.b0.y, r.b0.z, r.b0.w, r.b1.x, r.b1.y, r.b1.z, r.b1.w};
    unsigned* base = (unsigned*)(sVt + (c * 16) * LROW + 2 * ip);
#pragma unroll
    for (int e = 0; e < 8; ++e) {
        base[(2 * e) * (LROW / 2)] = (ua[e] & 0xffffu) | (ub[e] << 16);
        base[(2 * e + 1) * (LROW / 2)] = (ua[e] >> 16) | (ub[e] & 0xffff0000u);
    }
}
__device__ __forceinline__ float gate_prefix(const Params& P, const float* sGLRd  , int stride, int d, int h, int dk, int part, float (&pre)[16]) {
    float gu[16];
#pragma unroll
    for (int j = 0; j < 16; ++j) gu[j] = P.in[23][(d * 16 + j) * 256 + h * 64 + dk];
    const float gb = P.in[24][d * 256 + h * 64 + dk];
#pragma unroll
    for (int ii = 0; ii < 16; ++ii) {
        const float* gl = sGLRd + (part * 16 + ii) * stride;
        float z = gb;
#pragma unroll
        for (int j4 = 0; j4 < 4; ++j4) { const f32x4 x = *(const f32x4*)(gl + j4 * 4); z += x[0] * gu[j4 * 4] + x[1] * gu[j4 * 4 + 1] + x[2] * gu[j4 * 4 + 2] + x[3] * gu[j4 * 4 + 3]; }
        pre[ii] = logsig(z) * (1.f / 16.f);
    }
    if (d == 0) {
#pragma unroll
        for (int ii = 1; ii < 16; ++ii) pre[ii] += pre[ii - 1];
        return pre[15];
    } else {
#pragma unroll
        for (int ii = 14; ii >= 0; --ii) pre[ii] += pre[ii + 1];
        return pre[0];
    }
}

__device__ __forceinline__ void gla_a_item(const Params& P, int item, unsigned char* smem) {
    float* sGLR = (float*)smem;
    float* sPart = (float*)(smem + 4096);
    bf16_t* sKDt = (bf16_t*)(smem + 5120);
    bf16_t* sVt = (bf16_t*)(smem + 5120 + 9216);
    const int n = item % 132, d = (item / 132) & 1, h = (item / 264) & 3, b = item / 1056;
    const int rowbase = n < 4 ? NL + b * 256 + n * 64 : b * 8192 + (n - 4) * 64;
    const bf16_t* Kb = (const bf16_t*)(P.ws + OFF_K); const bf16_t* V = (const bf16_t*)(P.ws + OFF_V); const bf16_t* GLR = (const bf16_t*)(P.ws + OFF_GLR);
    const int tid = threadIdx.x & 255, lane = tid & 63, w = tid >> 6, dk = tid & 63, part = tid >> 6;
    const VRegs vr = load_v_regs(V + (size_t)rowbase * 512 + h * 128, tid);
    const f32x4 gl4 = load_bf4(GLR + (size_t)(rowbase + (tid >> 2)) * 32 + d * 16 + (tid & 3) * 4);
    float kk[16];
#pragma unroll
    for (int ii = 0; ii < 16; ++ii) kk[ii] = bf2f(Kb[(size_t)(rowbase + part * 16 + ii) * 256 + h * 64 + dk]);
    *(f32x4*)(sGLR + (tid >> 2) * 16 + (tid & 3) * 4) = gl4;
    store_vt(vr, sVt, tid);
    __syncthreads();
    float pre[16];
    const float tot = gate_prefix(P, sGLR, 16, d, h, dk, part, pre);
    sPart[part * 64 + dk] = tot;
    __syncthreads();
    const float t0 = sPart[dk], t1 = sPart[64 + dk], t2 = sPart[128 + dk], t3 = sPart[192 + dk];
    const float gtot = (t0 + t1) + (t2 + t3);
    float off;
    if (d == 0) off = part == 0 ? 0.f : (part == 1 ? t0 : (part == 2 ? t0 + t1 : t0 + t1 + t2));
    else off = part == 3 ? 0.f : (part == 2 ? t3 : (part == 1 ? t3 + t2 : t3 + t2 + t1));
    unsigned pk[8];
#pragma unroll
    for (int e = 0; e < 8; ++e) pk[e] = pk2(kk[2 * e] * __expf(gtot - (off + pre[2 * e])), kk[2 * e + 1] * __expf(gtot - (off + pre[2 * e + 1])));
    *(uint4*)(sKDt + dk * LROW + part * 16) = make_uint4(pk[0], pk[1], pk[2], pk[3]);
    *(uint4*)(sKDt + dk * LROW + part * 16 + 8) = make_uint4(pk[4], pk[5], pk[6], pk[7]);
    if (part == 0) ((float*)(P.ws + OFF_DEC))[(size_t)item * 64 + dk] = __expf(gtot);
    __syncthreads();
    bf16_t* KVt = (bf16_t*)(P.ws + OFF_H) + (size_t)item * 8192;
    const int fr = lane & 15, fq = lane >> 4;
#pragma unroll
    for (int dvt = 0; dvt < 2; ++dvt) {
        f32x4 acc[4];
#pragma unroll
        for (int dkt = 0; dkt < 4; ++dkt) acc[dkt] = (f32x4){0.f, 0.f, 0.f, 0.f};
#pragma unroll
        for (int ks = 0; ks < 2; ++ks) {
            const bf16x8 vb = *(const bf16x8*)(sVt + (w * 32 + dvt * 16 + fr) * LROW + ks * 32 + fq * 8);
#pragma unroll
            for (int dkt = 0; dkt < 4; ++dkt) {
                const bf16x8 ka = *(const bf16x8*)(sKDt + (dkt * 16 + fr) * LROW + ks * 32 + fq * 8);
                acc[dkt] = __builtin_amdgcn_mfma_f32_16x16x32_bf16(ka, vb, acc[dkt], 0, 0, 0);
            }
        }
#pragma unroll
        for (int dkt = 0; dkt < 4; ++dkt) store_bf4(KVt + (size_t)(w * 32 + dvt * 16 + fr) * 64 + dkt * 16 + fq * 4, acc[dkt]);
    }
    __syncthreads();
}

__device__ __forceinline__ void gla_scan_item(const Params& P, int item) {
    const int gid = item * NTHR + threadIdx.x, seq = gid >> 11, e = gid & 2047, dv = e >> 4, dk4 = (e & 15) * 4, d = seq & 1;
    bf16_t* base = (bf16_t*)(P.ws + OFF_H) + (size_t)seq * 132 * 8192 + dv * 64 + dk4;
    const float* decb = (const float*)(P.ws + OFF_DEC) + (size_t)seq * 132 * 64 + dk4;
    f32x4 S = (f32x4){0.f, 0.f, 0.f, 0.f};
    for (int s0 = 0; s0 < 132; s0 += 12) {
        uint2 kvr[12]; f32x4 dec[12];
#pragma unroll
        for (int q = 0; q < 12; ++q) {
            const int step = s0 + q, n = d == 0 ? step : (step < 4 ? 3 - step : 135 - step);
            kvr[q] = *(const uint2*)(base + (size_t)n * 8192); dec[q] = *(const f32x4*)(decb + n * 64);
        }
#pragma unroll
        for (int q = 0; q < 12; ++q) {
            const int step = s0 + q, n = d == 0 ? step : (step < 4 ? 3 - step : 135 - step);
            if (n >= 4) store_bf4(base + (size_t)n * 8192, S);
            f32x4 kv; kv[0] = bflo(kvr[q].x); kv[1] = bfhi(kvr[q].x); kv[2] = bflo(kvr[q].y); kv[3] = bfhi(kvr[q].y);
            S = dec[q] * S + kv;
        }
    }
}

__device__ __forceinline__ void gla_c_item(const Params& P, int item, unsigned char* smem) {
    float* sGLR = (float*)smem;
    float* sPart = (float*)(smem + 8192);
    bf16_t* sQD = (bf16_t*)(smem + 10240);
    bf16_t* sKD = (bf16_t*)(smem + 10240 + 9216);
    bf16_t* sQG = (bf16_t*)(smem + 10240 + 2 * 9216);
    bf16_t* sP = (bf16_t*)(smem + 10240 + 2 * 9216 + 17408);
    bf16_t* sVt = (bf16_t*)(smem + 10240 + 3 * 9216 + 17408);
    const int m = item & 127, h = (item >> 7) & 3, b = item >> 9;
    const int rowbase = b * 8192 + m * 64;
    const bf16_t* Q = (const bf16_t*)(P.ws + OFF_Q); const bf16_t* Kb = (const bf16_t*)(P.ws + OFF_K);
    bf16_t* V = (bf16_t*)(P.ws + OFF_V); const bf16_t* R = (const bf16_t*)(P.ws + OFF_R); const bf16_t* GLR = (const bf16_t*)(P.ws + OFF_GLR);
    const int tid = threadIdx.x & 255, lane = tid & 63, w = tid >> 6, fr = lane & 15, fq = lane >> 4, dk = tid & 63, part = tid >> 6;
    const VRegs vr = load_v_regs(V + (size_t)rowbase * 512 + h * 128, tid);
    const uint4 gl8 = *(const uint4*)(GLR + (size_t)(rowbase + (tid >> 2)) * 32 + (tid & 3) * 8);
    float qq[16], kk[16];
#pragma unroll
    for (int ii = 0; ii < 16; ++ii) { qq[ii] = bf2f(Q[(size_t)(rowbase + part * 16 + ii) * 256 + h * 64 + dk]); kk[ii] = bf2f(Kb[(size_t)(rowbase + part * 16 + ii) * 256 + h * 64 + dk]); }
    {
        float* gp = sGLR + (tid >> 2) * 32 + (tid & 3) * 8;
        *(f32x4*)gp = (f32x4){bflo(gl8.x), bfhi(gl8.x), bflo(gl8.y), bfhi(gl8.y)};
        *(f32x4*)(gp + 4) = (f32x4){bflo(gl8.z), bfhi(gl8.z), bflo(gl8.w), bfhi(gl8.w)};
    }
    store_vt(vr, sVt, tid);
    __syncthreads();
    float gc0[16], gc1[16];
    { const float tot0 = gate_prefix(P, sGLR, 32, 0, h, dk, part, gc0); const float tot1 = gate_prefix(P, sGLR + 16, 32, 1, h, dk, part, gc1);
      sPart[part * 64 + dk] = tot0; sPart[256 + part * 64 + dk] = tot1; }
    __syncthreads();
    float gref0, gref1;
    {
        const float a0 = sPart[dk], a1 = sPart[64 + dk], a2 = sPart[128 + dk];
        const float c1 = sPart[256 + 64 + dk], c2 = sPart[256 + 128 + dk], c3 = sPart[256 + 192 + dk];
        const float off0 = part == 0 ? 0.f : (part == 1 ? a0 : (part == 2 ? a0 + a1 : a0 + a1 + a2));
        const float off1 = part == 3 ? 0.f : (part == 2 ? c3 : (part == 1 ? c3 + c2 : c3 + c2 + c1));
        gref0 = a0 + a1; gref1 = c3 + c2;
#pragma unroll
        for (int ii = 0; ii < 16; ++ii) { gc0[ii] += off0; gc1[ii] += off1; }
    }
    f32x4 pacc[4];
#pragma unroll
    for (int jt = 0; jt < 4; ++jt) pacc[jt] = (f32x4){0.f, 0.f, 0.f, 0.f};
#pragma unroll
    for (int d = 0; d < 2; ++d) {
        const float gref = d == 0 ? gref0 : gref1;
#pragma unroll
        for (int ii = 0; ii < 16; ++ii) {
            const int i = part * 16 + ii;
            const float gc = d == 0 ? gc0[ii] : gc1[ii];
            sQD[i * LROW + dk] = f2bf(qq[ii] * __expf(gc - gref));
            sKD[i * LROW + dk] = f2bf(kk[ii] * __expf(gref - gc));
            sQG[i * 136 + d * 64 + dk] = f2bf(qq[ii] * __expf(gc));
        }
        __syncthreads();
#pragma unroll
        for (int jt = 0; jt < 4; ++jt) {
            f32x4 sc = (f32x4){0.f, 0.f, 0.f, 0.f};
#pragma unroll
            for (int ks = 0; ks < 2; ++ks) {
                const bf16x8 a = *(const bf16x8*)(sQD + (16 * w + fr) * LROW + ks * 32 + fq * 8);
                const bf16x8 bb = *(const bf16x8*)(sKD + (jt * 16 + fr) * LROW + ks * 32 + fq * 8);
                sc = __builtin_amdgcn_mfma_f32_16x16x32_bf16(a, bb, sc, 0, 0, 0);
            }
#pragma unroll
            for (int r = 0; r < 4; ++r) {
                const int i = 16 * w + fq * 4 + r, j = jt * 16 + fr;
                const bool keep = d == 0 ? (j <= i) : (j >= i);
                pacc[jt][r] += keep ? sc[r] : 0.f;
            }
        }
        if (d == 0) __syncthreads();
    }
#pragma unroll
    for (int jt = 0; jt < 4; ++jt)
#pragma unroll
        for (int r = 0; r < 4; ++r) sP[(16 * w + fq * 4 + r) * LROW + jt * 16 + fr] = f2bf(pacc[jt][r]);
    const bf16_t* SS0 = (const bf16_t*)(P.ws + OFF_H) + ((size_t)(((b * 4 + h) * 2 + 0) * 132 + 4 + m)) * 8192;
    const bf16_t* SS1 = (const bf16_t*)(P.ws + OFF_H) + ((size_t)(((b * 4 + h) * 2 + 1) * 132 + 4 + m)) * 8192;
    const int i_out = 16 * w + fr;
    const int tok_out = b * 8192 + ((m & 1) * 64 + i_out) * 64 + (m >> 1);
    bf16_t* YB = (bf16_t*)(P.ws + OFF_YB);
    uint2 rgr[8];
#pragma unroll
    for (int dvt = 0; dvt < 8; ++dvt) rgr[dvt] = *(const uint2*)(R + (size_t)(rowbase + i_out) * 512 + h * 128 + dvt * 16 + fq * 4);
    __syncthreads();
    f32x4 oacc[8];
#pragma unroll
    for (int dvt = 0; dvt < 8; ++dvt) oacc[dvt] = (f32x4){0.f, 0.f, 0.f, 0.f};
#pragma unroll
    for (int ks = 0; ks < 4; ++ks) {
        const bf16x8 qb = *(const bf16x8*)(sQG + (16 * w + fr) * 136 + ks * 32 + fq * 8);
        const bf16_t* SS = (ks >> 1) ? SS1 : SS0;
#pragma unroll
        for (int dvt = 0; dvt < 8; ++dvt) {
            const bf16x8 sa = *(const bf16x8*)(SS + (size_t)(dvt * 16 + fr) * 64 + (ks & 1) * 32 + fq * 8);
            oacc[dvt] = __builtin_amdgcn_mfma_f32_16x16x32_bf16(sa, qb, oacc[dvt], 0, 0, 0);
        }
    }
#pragma unroll
    for (int ks = 0; ks < 2; ++ks) {
        const bf16x8 pb = *(const bf16x8*)(sP + (16 * w + fr) * LROW + ks * 32 + fq * 8);
#pragma unroll
        for (int dvt = 0; dvt < 8; ++dvt) {
            const bf16x8 va = *(const bf16x8*)(sVt + (dvt * 16 + fr) * LROW + ks * 32 + fq * 8);
            oacc[dvt] = __builtin_amdgcn_mfma_f32_16x16x32_bf16(va, pb, oacc[dvt], 0, 0, 0);
        }
    }
    float ss = 0.f;
#pragma unroll
    for (int dvt = 0; dvt < 8; ++dvt)
#pragma unroll
        for (int r = 0; r < 4; ++r) ss += oacc[dvt][r] * oacc[dvt][r];
    ss += __shfl_xor(ss, 16); ss += __shfl_xor(ss, 32);
    const float rinv = rsqrtf(ss * (1.f / 128.f) + 1e-6f);
#pragma unroll
    for (int dvt = 0; dvt < 8; ++dvt) {
        const int dv = dvt * 16 + fq * 4;
        const float rg[4] = {bflo(rgr[dvt].x), bfhi(rgr[dvt].x), bflo(rgr[dvt].y), bfhi(rgr[dvt].y)};
        const f32x4 ng = *(const f32x4*)(P.in[25] + h * 128 + dv);
        f32x4 o;
#pragma unroll
        for (int r = 0; r < 4; ++r) o[r] = oacc[dvt][r] * rinv * ng[r] * siluf_(rg[r]);
        store_bf4(YB + (size_t)tok_out * 512 + h * 128 + dv, o);
    }
    __syncthreads();
}

struct EpiE : pg8::EpiNoMid {
    float* E;
    __device__ __forceinline__ void operator()(const AccT& acc, const Unit& u, int wr, int wc, int fr, int fq) const {
        EPI_LOOP
            if (m < 1056) *(f32x4*)(E + ((size_t)u.g * 1056 + m) * 256 + n) = v;
        EPI_LOOP_END
    }
};
__device__ __forceinline__ void phase6(const Params& P, unsigned char* smem) {
    const int hb = threadIdx.x >> 8;
    for (int base = blockIdx.x * 2; base < 4224; base += gridDim.x * 2) gla_a_item(P, base + hb, smem + hb * HALF_LDS);
    GemmD g{}; g.A = (const bf16_t*)(P.ws + OFF_U); g.Bt = (const bf16_t*)(P.ws + OFF_WE); g.lda = 768; g.ldb = 512; g.K = 512; g.nM = 5; g.nN = 1; g.nG = 32;
    g.gsA = (size_t)UROWS * 768; g.gsB = (size_t)256 * 512;
    EpiE E; E.E = (float*)(P.ws + OFF_E);
    pg8::gemm_phase((PG8_LAS unsigned char*)smem, g, E);
}
__device__ __forceinline__ void s5_carry_item(const Params& P, int item) {
    const int id = item * NTHR + threadIdx.x, p = id & 63, d = (id >> 6) & 1, b = (id >> 7) & 3, g = id >> 9;
    const float2 lamT = ((const float2*)(P.ws + OFF_LP))[((d * 32 + g) * 33 + 32) * 64 + p];
    const float* Eg = (const float*)(P.ws + OFF_E) + (size_t)g * 1056 * 256;
    bf16_t* Ug = (bf16_t*)(P.ws + OFF_U) + (size_t)g * UROWS * 768;
    const int cre = d * 128 + p, cim = d * 128 + 64 + p;
    float2 hh = make_float2(0.f, 0.f);
    {
        float2 e[8];
#pragma unroll
        for (int s = 0; s < 8; ++s) { const int n = d == 0 ? s : 7 - s, row = 1024 + b * 8 + n; e[s] = make_float2(Eg[(size_t)row * 256 + cre], Eg[(size_t)row * 256 + cim]); }
#pragma unroll
        for (int s = 0; s < 8; ++s) { const float2 t = cmul(lamT, hh); hh = make_float2(t.x + e[s].x, t.y + e[s].y); }
    }
    for (int s0 = 0; s0 < 256; s0 += 16) {
        float2 e[16];
#pragma unroll
        for (int q = 0; q < 16; ++q) { const int s = s0 + q, n = d == 0 ? s : 255 - s, row = b * 256 + n; e[q] = make_float2(Eg[(size_t)row * 256 + cre], Eg[(size_t)row * 256 + cim]); }
#pragma unroll
        for (int q = 0; q < 16; ++q) {
            const int s = s0 + q, n = d == 0 ? s : 255 - s, row = b * 256 + n;
            Ug[(size_t)row * 768 + 512 + cre] = f2bf(hh.x); Ug[(size_t)row * 768 + 512 + cim] = f2bf(hh.y);
            const float2 t = cmul(lamT, hh); hh = make_float2(t.x + e[q].x, t.y + e[q].y);
        }
    }
}
__device__ __forceinline__ void phase7(const Params& P) {
    for (int it = blockIdx.x; it < 32 + 128; it += gridDim.x) {
        if (it < 32) s5_carry_item(P, it); else gla_scan_item(P, it - 32);
    }
}
struct EpiY : pg8::EpiNoMid {
    static constexpr bool PERM = true;
    const bf16_t* U; const float* dskip; bf16_t* YG;
    __device__ __forceinline__ void operator()(const AccT& acc, const Unit& u, int wr, int wc, int fr, int fq) const {
        const int nb = 256 * u.pn + 32 * wc + 8 * fq, c0 = 8 * (fq & 1);
        const f32x4 ds0 = *(const f32x4*)(dskip + u.g * 16 + c0), ds1 = *(const f32x4*)(dskip + u.g * 16 + c0 + 4);
#pragma unroll
        for (int ai = 0; ai < 2; ++ai) {
            const int mb = 256 * u.pm + 128 * ai + 64 * wr + fr;
            uint4 ur[4][2];
#pragma unroll
            for (int mm = 0; mm < 4; ++mm)
#pragma unroll
                for (int bj = 0; bj < 2; ++bj) ur[mm][bj] = *(const uint4*)(U + ((size_t)u.g * UROWS + mb + 16 * mm) * 768 + nb + 128 * bj);
#pragma unroll
            for (int mm = 0; mm < 4; ++mm)
#pragma unroll
                for (int bj = 0; bj < 2; ++bj) {
                    const int m = mb + 16 * mm, n = nb + 128 * bj;
                    const int b = m >> 8, nch = m & 255, t = n >> 4;
                    const uint4 uu = ur[mm][bj];
                    const f32x4 v0 = acc[ai][bj][mm][0], v1 = acc[ai][bj][mm][1];
                    const f32x4 o0 = {gelu_tanh(v0[0] + ds0[0] * bflo(uu.x)), gelu_tanh(v0[1] + ds0[1] * bfhi(uu.x)), gelu_tanh(v0[2] + ds0[2] * bflo(uu.y)), gelu_tanh(v0[3] + ds0[3] * bfhi(uu.y))};
                    const f32x4 o1 = {gelu_tanh(v1[0] + ds1[0] * bflo(uu.z)), gelu_tanh(v1[1] + ds1[1] * bfhi(uu.z)), gelu_tanh(v1[2] + ds1[2] * bflo(uu.w)), gelu_tanh(v1[3] + ds1[3] * bfhi(uu.w))};
                    *(uint4*)(YG + ((size_t)(b * 8192 + nch * 32 + t)) * 512 + u.g * 16 + c0) = pack8(o0, o1);
                }
        }
    }
};
__device__ __forceinline__ void phase8(const Params& P, unsigned char* smem) {
    const int hb = threadIdx.x >> 8;
    for (int base = blockIdx.x * 2; base < 2048; base += gridDim.x * 2) gla_c_item(P, base + hb, smem + hb * HALF_LDS);
    GemmD g{}; g.A = (const bf16_t*)(P.ws + OFF_U); g.Bt = (const bf16_t*)(P.ws + OFF_WY); g.lda = 768; g.ldb = 768; g.K = 768; g.nM = 4; g.nN = 2; g.nG = 32;
    g.gsA = (size_t)UROWS * 768; g.gsB = (size_t)512 * 768;
    EpiY E; E.U = (const bf16_t*)(P.ws + OFF_U); E.dskip = P.in[19]; E.YG = (bf16_t*)(P.ws + OFF_E);
    pg8::gemm_phase((PG8_LAS unsigned char*)smem, g, E);
}

struct EpiGlu : pg8::EpiNoMid {
    static constexpr bool PERM = true;
    const bf16_t* YG; const float* bias; bf16_t* YA;
    __device__ __forceinline__ void operator()(const AccT& acc, const Unit& u, int wr, int wc, int fr, int fq) const {
        const int nb = 256 * u.pn + 32 * wc + 8 * fq;
        f32x4 bb[2][2];
#pragma unroll
        for (int bj = 0; bj < 2; ++bj)
#pragma unroll
            for (int nn = 0; nn < 2; ++nn) bb[bj][nn] = *(const f32x4*)(bias + nb + 128 * bj + 4 * nn);
#pragma unroll
        for (int ai = 0; ai < 2; ++ai) {
            const size_t rb = (size_t)(256 * u.pm + 128 * ai + 64 * wr + fr) * 512 + nb;
            uint4 yr[4][2];
#pragma unroll
            for (int mm = 0; mm < 4; ++mm)
#pragma unroll
                for (int bj = 0; bj < 2; ++bj) yr[mm][bj] = *(const uint4*)(YG + rb + (size_t)mm * 16 * 512 + 128 * bj);
#pragma unroll
            for (int mm = 0; mm < 4; ++mm)
#pragma unroll
                for (int bj = 0; bj < 2; ++bj) {
                    const uint4 y = yr[mm][bj]; const f32x4 v0 = acc[ai][bj][mm][0] + bb[bj][0], v1 = acc[ai][bj][mm][1] + bb[bj][1];
                    const f32x4 o0 = {bflo(y.x) * sigm(v0[0]), bfhi(y.x) * sigm(v0[1]), bflo(y.y) * sigm(v0[2]), bfhi(y.y) * sigm(v0[3])};
                    const f32x4 o1 = {bflo(y.z) * sigm(v1[0]), bfhi(y.z) * sigm(v1[1]), bflo(y.w) * sigm(v1[2]), bfhi(y.w) * sigm(v1[3])};
                    *(uint4*)(YA + rb + (size_t)mm * 16 * 512 + 128 * bj) = pack8(o0, o1);
                }
        }
    }
};
__device__ __forceinline__ void phase9(const Params& P, PG8_LAS unsigned char* lds) {
    GemmD g{}; g.A = (const bf16_t*)(P.ws + OFF_E); g.Bt = (const bf16_t*)(P.ws + OFF_WGLU); g.lda = 512; g.ldb = 512; g.K = 512; g.nM = NL >> 8; g.nN = 2; g.nG = 1;
    EpiGlu E; E.YG = (const bf16_t*)(P.ws + OFF_E); E.bias = P.in[21]; E.YA = (bf16_t*)(P.ws + OFF_U);
    pg8::gemm_phase(lds, g, E);
}
struct EpiMerge {
    static constexpr bool PERM = true;
    const bf16_t* GA; const bf16_t* GB; bf16_t* H;
    __device__ __forceinline__ void mid(f32x4 (&acc)[2][2][4][2], const Unit& u, int wr, int wc, int fr, int fq) const {
        const int nb = 256 * u.pn + 32 * wc + 8 * fq;
#pragma unroll
        for (int ai = 0; ai < 2; ++ai) {
            const size_t rb = (size_t)(256 * u.pm + 128 * ai + 64 * wr + fr) * 1024 + nb;
            uint4 br[4][2];
#pragma unroll
            for (int mm = 0; mm < 4; ++mm)
#pragma unroll
                for (int bj = 0; bj < 2; ++bj) br[mm][bj] = *(const uint4*)(GB + rb + (size_t)mm * 16 * 1024 + 128 * bj);
#pragma unroll
            for (int mm = 0; mm < 4; ++mm)
#pragma unroll
                for (int bj = 0; bj < 2; ++bj) {
                    const uint4 b4 = br[mm][bj];
                    f32x4& v0 = acc[ai][bj][mm][0]; f32x4& v1 = acc[ai][bj][mm][1];
                    v0[0] *= bflo(b4.x); v0[1] *= bfhi(b4.x); v0[2] *= bflo(b4.y); v0[3] *= bfhi(b4.y);
                    v1[0] *= bflo(b4.z); v1[1] *= bfhi(b4.z); v1[2] *= bflo(b4.w); v1[3] *= bfhi(b4.w);
                }
        }
    }
    __device__ __forceinline__ void operator()(const AccT& acc, const Unit& u, int wr, int wc, int fr, int fq) const {
        const int nb = 256 * u.pn + 32 * wc + 8 * fq;
#pragma unroll
        for (int ai = 0; ai < 2; ++ai) {
            const size_t rb = (size_t)(256 * u.pm + 128 * ai + 64 * wr + fr) * 1024 + nb;
            uint4 gr[4][2];
#pragma unroll
            for (int mm = 0; mm < 4; ++mm)
#pragma unroll
                for (int bj = 0; bj < 2; ++bj) gr[mm][bj] = *(const uint4*)(GA + rb + (size_t)mm * 16 * 1024 + 128 * bj);
#pragma unroll
            for (int mm = 0; mm < 4; ++mm)
#pragma unroll
                for (int bj = 0; bj < 2; ++bj) {
                    const uint4 g4 = gr[mm][bj]; const f32x4 v0 = acc[ai][bj][mm][0], v1 = acc[ai][bj][mm][1];
                    uint4 o;
                    o.x = pk2(bflo(g4.x) * v0[0], bfhi(g4.x) * v0[1]); o.y = pk2(bflo(g4.y) * v0[2], bfhi(g4.y) * v0[3]);
                    o.z = pk2(bflo(g4.z) * v1[0], bfhi(g4.z) * v1[1]); o.w = pk2(bflo(g4.w) * v1[2], bfhi(g4.w) * v1[3]);
                    *(uint4*)(H + rb + (size_t)mm * 16 * 1024 + 128 * bj) = o;
                }
        }
    }
};
__device__ __forceinline__ void phase10(const Params& P, PG8_LAS unsigned char* lds) {
    GemmD g{}; g.A = (const bf16_t*)(P.ws + OFF_YB); g.Bt = (const bf16_t*)(P.ws + OFF_WGLO); g.A2 = (const bf16_t*)(P.ws + OFF_U); g.Bt2 = (const bf16_t*)(P.ws + OFF_WS5O); g.dual = 1;
    g.lda = 512; g.ldb = 512; g.K = 512; g.nM = NL >> 8; g.nN = 4; g.nG = 1;
    EpiMerge E; E.GA = (const bf16_t*)P.out; E.GB = E.GA + (size_t)NL * 1024; E.H = (bf16_t*)(P.ws + OFF_H);
    pg8::gemm_phase(lds, g, E);
}
__device__ __forceinline__ void phase11(const Params& P, PG8_LAS unsigned char* lds) {
    GemmD g{}; g.A = (const bf16_t*)(P.ws + OFF_H); g.Bt = (const bf16_t*)(P.ws + OFF_WWO); g.lda = 1024; g.ldb = 1024; g.K = 1024; g.nM = NL >> 8; g.nN = 4; g.nG = 1;
    EpiRes<1> E; E.x = nullptr; E.XRb = (bf16_t*)(P.ws + OFF_XR); E.out = nullptr; E.Hn = (bf16_t*)P.out; E.mod = (const float*)(P.ws + OFF_MOD);
    E.gnext = P.in[28]; E.ss = (float*)(P.ws + OFF_SS) + NT;
    pg8::gemm_phase(lds, g, E);
}

__device__ __forceinline__ void phase_ffn_up13(const Params& P, PG8_LAS unsigned char* lds) {
    GemmD g{}; g.A = (const bf16_t*)P.out; g.Bt = (const bf16_t*)(P.ws + OFF_WGU2); g.lda = 1024; g.ldb = 1024; g.K = 1024; g.nM = NL >> 8; g.nN = 22; g.nG = 1;
    EpiFfnUp<1> E; E.HID = (bf16_t*)(P.ws + OFF_HID); E.ss = (const float*)(P.ws + OFF_SS) + NT; E.BW = (const float*)(P.ws + OFF_BW) + 5 * 4352;
    pg8::gemm_phase(lds, g, E);
}

#define XB_TMO      128
#define XB_XCNT(j)  (256  + 64 * (j))
#define XB_XSUB(j)  (1280 + 64 * (j))
#define XB_XGEN(j)  (2304 + 64 * (j))
#define XB_TOP      3328
#define XB_TOPGEN   3392
#define XCD_BAR_WORDS 3456
#define XB_SPIN_CAP (1u << 18)
#define LAS3 __attribute__((address_space(3)))
__device__ __forceinline__ unsigned xb_ld(unsigned* p)              { return __hip_atomic_load(p, __ATOMIC_RELAXED, __HIP_MEMORY_SCOPE_AGENT); }
__device__ __forceinline__ unsigned xb_add(unsigned* p, unsigned v) { return __hip_atomic_fetch_add(p, v, __ATOMIC_RELAXED, __HIP_MEMORY_SCOPE_AGENT); }
__device__ __forceinline__ unsigned xb_xcc_id() { return (unsigned)__builtin_amdgcn_s_getreg((3 << 11) | 20) & 0xFu; }
#define XB_SPIN(cond, bar) do { unsigned _sp = 0; while (cond) { __builtin_amdgcn_s_sleep(1); \
    if ((++_sp & 255u) == 0u) { if (xb_ld(&(bar)[XB_TMO])) break; if (_sp > XB_SPIN_CAP) { atomicAdd(&(bar)[XB_TMO], 1u); break; } } } } while (0)
struct XcdBarrier { unsigned* bar; unsigned x; volatile LAS3 unsigned* st; };
__device__ __forceinline__ XcdBarrier xcd_barrier_post(unsigned* bar, volatile LAS3 unsigned* st) {
    XcdBarrier b; b.bar = bar; b.x = xb_xcc_id(); b.st = st;
    if (threadIdx.x == 0) (void)xb_add(&bar[XB_XCNT(b.x)], 1u);
    return b;
}
__device__ __forceinline__ void xcd_barrier_complete(unsigned* bar, unsigned x, unsigned& nloc, unsigned& nx) {
    const unsigned G = gridDim.x * gridDim.y * gridDim.z;
    unsigned sum, cnt, mine, sp = 0u;
    for (;;) {
        sum = 0u; cnt = 0u; mine = 0u;
#pragma unroll
        for (unsigned j = 0; j < 16; ++j) { const unsigned c = xb_ld(&bar[XB_XCNT(j)]); sum += c; cnt += (c > 0u) ? 1u : 0u; mine = (j == x) ? c : mine; }
        if (sum == G) break;
        __builtin_amdgcn_s_sleep(1);
        if ((++sp & 255u) == 0u) { if (xb_ld(&bar[XB_TMO])) break; if (sp > XB_SPIN_CAP) { atomicAdd(&bar[XB_TMO], 1u); break; } }
    }
    nloc = mine > 0u ? mine : 1u; nx = cnt > 0u ? cnt : 1u;
}
__device__ __forceinline__ void xcd_barrier(const XcdBarrier& b) {
    asm volatile("s_waitcnt vmcnt(0)" ::: "memory");
    __syncthreads();
    if (threadIdx.x == 0) {
        unsigned* bar = b.bar;
        __builtin_amdgcn_s_waitcnt(0);
        unsigned nloc = b.st[0], nx = b.st[1];
        if (nloc == 0u) { xcd_barrier_complete(bar, b.x, nloc, nx); b.st[0] = nloc; b.st[1] = nx; }
        const unsigned old = xb_add(&bar[XB_XSUB(b.x)], 1u);
        const unsigned gen = old / nloc;
        if (old + 1u == (gen + 1u) * nloc) {
            __builtin_amdgcn_fence(__ATOMIC_RELEASE, "agent");
            asm volatile("s_waitcnt vmcnt(0)" ::: "memory");
            const unsigned og = xb_add(&bar[XB_TOP], 1u);
            const unsigned tg = og / nx;
            if (og + 1u == (tg + 1u) * nx) xb_add(&bar[XB_TOPGEN], 1u);
            else XB_SPIN(xb_ld(&bar[XB_TOPGEN]) == tg, bar);
            __builtin_amdgcn_fence(__ATOMIC_ACQUIRE, "agent");
            xb_add(&bar[XB_XGEN(b.x)], 1u);
            asm volatile("s_waitcnt vmcnt(0)" ::: "memory");
        } else {
            XB_SPIN(xb_ld(&bar[XB_XGEN(b.x)]) == gen, bar);
            __builtin_amdgcn_fence(__ATOMIC_ACQUIRE, "agent");
            asm volatile("s_waitcnt vmcnt(0)" ::: "memory");
        }
    }
    __syncthreads();
}

__global__ void __launch_bounds__(512, 2) mega(Params P) {
    extern __shared__ __attribute__((aligned(16))) unsigned char smem[];
    cg::grid_group grid = cg::this_grid();
    PG8_LAS unsigned char* lds = (PG8_LAS unsigned char*)smem;
    __shared__ uint4 xb_words;
    unsigned* bar = (unsigned*)(P.ws + OFF_BAR);
    if (threadIdx.x == 0) xb_words = make_uint4(0u, 0u, 0u, 0u);
    if (blockIdx.x == 0 && P.ph_lo == 0) { for (int i = threadIdx.x; i < XCD_BAR_WORDS; i += NTHR) bar[i] = 0u; }
    __syncthreads();
    XcdBarrier xb; xb.bar = bar; xb.x = 0; xb.st = (volatile LAS3 unsigned*)&xb_words;
#ifndef PHMASK
#define PHMASK 0xFFFF
#endif
#define PHOK(n) ((PHMASK >> n) & 1)
#define RUN(n, call) if (PHOK(n) && P.ph_lo <= n && n < P.ph_hi) { call; if (n + 1 < P.ph_hi) { if (n == 0) { grid.sync(); xb = xcd_barrier_post(bar, (volatile LAS3 unsigned*)&xb_words); } else xcd_barrier(xb); } }
    RUN(0, phase0(P, smem))
    RUN(1, phase1(P))
    RUN(2, phase_ffn_up<0>(P, lds, OFF_WGU1, NT))
    RUN(3, phase_ffn_down<1>(P, lds, OFF_WDN1))
    RUN(4, phase4(P))
    RUN(5, phase5(P, lds))
    RUN(6, phase6(P, smem))
    RUN(7, phase7(P))
    RUN(8, phase8(P, smem))
    RUN(9, phase9(P, lds))
    RUN(10, phase10(P, lds))
    RUN(11, phase11(P, lds))
    RUN(13, phase_ffn_up13(P, lds))
    RUN(14, phase_ffn_down<0>(P, lds, OFF_WDN2))
    RUN(15, phase15(P))
}

extern "C" void kernel_launch(void* const* d_in, const int* in_sizes, int n_in, void* d_out, int out_size, void* d_ws, size_t ws_size, hipStream_t stream) {
    static int grid_blocks = 0;
    if (grid_blocks == 0) {
        if (n_in != 33 || ws_size < WS_END) { fprintf(stderr, "kernel_launch: unexpected n_in %d / ws_size %zu (need %zu)\n", n_in, ws_size, (size_t)WS_END); grid_blocks = -1; return; }
        int dev = 0, cus = 0, per_cu = 0;
        hipGetDevice(&dev);
        hipDeviceGetAttribute(&cus, hipDeviceAttributeMultiprocessorCount, dev);
        hipFuncSetAttribute((const void*)mega, hipFuncAttributeMaxDynamicSharedMemorySize, LDS_BYTES);
        hipOccupancyMaxActiveBlocksPerMultiprocessor(&per_cu, (const void*)mega, NTHR, LDS_BYTES);
        if (per_cu < 1) per_cu = 1;
        if (per_cu > 1) per_cu = 1;
        grid_blocks = cus * per_cu;
        fprintf(stderr, "kernel_launch: cus %d per_cu %d grid %d\n", cus, per_cu, grid_blocks);
    }
    if (grid_blocks < 0) return;
    Params p{};
    for (int i = 0; i < 33; ++i) p.in[i] = (const float*)d_in[i];
    p.out = (float*)d_out; p.ws = (unsigned char*)d_ws;
#if N_LAUNCH_PER_PHASE
    for (int ph = 0; ph < NPHASE; ++ph) {
        p.ph_lo = ph; p.ph_hi = ph + 1;
        void* args[] = {&p};
        hipError_t e = hipLaunchCooperativeKernel((const void*)mega, dim3(grid_blocks), dim3(NTHR), args, LDS_BYTES, stream);
        if (e != hipSuccess) { fprintf(stderr, "cooperative launch failed: %s\n", hipGetErrorString(e)); break; }
    }
#else
    p.ph_lo = 0; p.ph_hi = NPHASE;
    void* args[] = {&p};
    hipError_t e = hipLaunchCooperativeKernel((const void*)mega, dim3(grid_blocks), dim3(NTHR), args, LDS_BYTES, stream);
    if (e != hipSuccess) fprintf(stderr, "cooperative launch failed: %s\n", hipGetErrorString(e));
#endif
}
```

```cpp
#include <hip/hip_runtime.h>
#include <hip/hip_cooperative_groups.h>
#include <cstdio>
namespace cg = cooperative_groups;

#ifndef N_LAUNCH_PER_PHASE
#define N_LAUNCH_PER_PHASE 0
#endif

typedef unsigned short bf16_t;
typedef short bf16x8 __attribute__((ext_vector_type(8)));
typedef float f32x4 __attribute__((ext_vector_type(4)));

constexpr int NL = 32768, NC = 1024, NT = 33792, D = 1024, FF = 2816;
constexpr int NPHASE = 16;
constexpr int HALF_LDS = 79872;
constexpr int LDS_BYTES = 2 * HALF_LDS;
constexpr int NTHR = 512;
constexpr int UROWS = 1280;

constexpr size_t SZ_WGU = (size_t)5632 * 1024 * 2, SZ_WDN = (size_t)1024 * 2816 * 2;
constexpr size_t OFF_WGU1 = 0;
constexpr size_t OFF_WDN1 = OFF_WGU1 + SZ_WGU;
constexpr size_t OFF_WGU2 = OFF_WDN1 + SZ_WDN;
constexpr size_t OFF_WDN2 = OFF_WGU2 + SZ_WGU;
constexpr size_t OFF_WIN = OFF_WDN2 + SZ_WDN;
constexpr size_t OFF_WGLU = OFF_WIN + (size_t)4352 * 1024 * 2;
constexpr size_t OFF_WS5O = OFF_WGLU + (size_t)512 * 512 * 2;
constexpr size_t OFF_WGLO = OFF_WS5O + (size_t)1024 * 512 * 2;
constexpr size_t OFF_WWO = OFF_WGLO + (size_t)1024 * 512 * 2;
constexpr size_t OFF_WE = OFF_WWO + (size_t)1024 * 1024 * 2;
constexpr size_t OFF_WY = OFF_WE + (size_t)32 * 256 * 512 * 2;
constexpr size_t OFF_KD = OFF_WY + (size_t)32 * 512 * 768 * 2;
constexpr size_t OFF_LP = OFF_KD + (size_t)2 * 32 * 32 * 256 * 4;
constexpr size_t OFF_BB = OFF_LP + (size_t)2 * 32 * 33 * 64 * 8;
constexpr size_t OFF_MOD = OFF_BB + (size_t)2 * 32 * 64 * 16 * 8;
constexpr size_t OFF_DEC = OFF_MOD + (size_t)5 * 9216 * 4;
constexpr size_t OFF_H = OFF_DEC + (size_t)4224 * 64 * 4;
constexpr size_t OFF_HID = OFF_H + (size_t)NT * 1024 * 2;
constexpr size_t OFF_U = OFF_HID;
constexpr size_t OFF_Q = OFF_U + (size_t)32 * UROWS * 768 * 2;
constexpr size_t OFF_K = OFF_Q + (size_t)NT * 256 * 2;
constexpr size_t OFF_V = OFF_K + (size_t)NT * 256 * 2;
constexpr size_t OFF_R = OFF_V + (size_t)NT * 512 * 2;
constexpr size_t OFF_GLR = OFF_R + (size_t)NT * 512 * 2;
constexpr size_t OFF_XR = OFF_HID + (size_t)NT * 2816 * 2;
constexpr size_t OFF_YB = OFF_XR + (size_t)NT * 1024 * 2;
constexpr size_t OFF_E = OFF_XR + (size_t)NT * 1024 * 4;
constexpr size_t OFF_BAR = OFF_E + (size_t)32 * 1056 * 256 * 4;
constexpr size_t OFF_SS = OFF_BAR + 16384;
constexpr size_t OFF_BW = OFF_SS + 401408;
constexpr size_t WS_END = OFF_BW + 204800;
static_assert(WS_END <= (size_t)536870912, "workspace");
static_assert(OFF_GLR + (size_t)NT * 32 * 2 <= OFF_XR, "alias overflow");

struct Params { const float* in[33]; float* out; unsigned char* ws; int ph_lo, ph_hi; };

typedef float f32x2_t __attribute__((ext_vector_type(2)));
typedef __bf16 bf16x2_t __attribute__((ext_vector_type(2)));
__device__ __forceinline__ unsigned pk2(float a, float b) { const f32x2_t v = {a, b}; const bf16x2_t r = __builtin_convertvector(v, bf16x2_t); return __builtin_bit_cast(unsigned, r); }
__device__ __forceinline__ bf16_t f2bf(float f) { return (bf16_t)(pk2(f, f) & 0xffffu); }
__device__ __forceinline__ float bf2f(bf16_t h) { return __uint_as_float(((unsigned)h) << 16); }
__device__ __forceinline__ float bflo(unsigned u) { return __uint_as_float(u << 16); }
__device__ __forceinline__ float bfhi(unsigned u) { return __uint_as_float(u & 0xffff0000u); }
__device__ __forceinline__ float rcpf_(float x) { return __builtin_amdgcn_rcpf(x); }
__device__ __forceinline__ float sigm(float x) { return rcpf_(1.f + __expf(-x)); }
__device__ __forceinline__ float siluf_(float x) { return x * sigm(x); }
__device__ __forceinline__ float gelu_tanh(float x) { float y = 0.7978845608028654f * (x + 0.044715f * x * x * x); float t = 1.f - 2.f * rcpf_(1.f + __expf(2.f * y)); return 0.5f * x * (1.f + t); }
__device__ __forceinline__ float wave_sum(float v) {
#pragma unroll
    for (int o = 1; o < 64; o <<= 1) v += __shfl_xor(v, o);
    return v;
}
__device__ __forceinline__ void store_bf4(bf16_t* p, f32x4 v) { uint2 o; o.x = pk2(v[0], v[1]); o.y = pk2(v[2], v[3]); *(uint2*)p = o; }
__device__ __forceinline__ f32x4 load_bf4(const bf16_t* p) { uint2 u = *(const uint2*)p; f32x4 v; v[0] = bflo(u.x); v[1] = bfhi(u.x); v[2] = bflo(u.y); v[3] = bfhi(u.y); return v; }

constexpr int LROW = 72;
namespace pg8 {
#define PG8_LAS __attribute__((address_space(3)))
constexpr int BM = 256, BK = 64, HALF = 128, HTB = HALF * BK * 2, STAGE_BYTES = 8 * HTB;
__device__ __forceinline__ int lds_byte(int r, int c) { const int st = (r >> 4) * 2 + (c >> 5), rr = r & 15, cc = c & 31, ob = rr * 64 + cc * 2; return st * 1024 + (ob ^ (((ob >> 9) & 1) << 5)); }
__device__ __forceinline__ void stage_rc(int b, int& R, int& C) { const int st = b / 1024, sb = b % 1024, swz = sb ^ (((sb >> 9) & 1) << 5); R = (st >> 1) * 16 + swz / 64; C = (st & 1) * 32 + (swz % 64) / 2; }
struct Unit { int pm, pn, g, part; };
struct GemmD { const bf16_t* A; const bf16_t* Bt; int lda, ldb, K, nM, nN, nG; size_t gsA, gsB; int permA; const bf16_t* A2; const bf16_t* Bt2; int dual; };
__device__ __forceinline__ int perm32(int rho) { const int n = rho >> 4, i = rho & 15; return 8 * (i >> 2) + 4 * n + (i & 3); }
struct EpiNoMid { static constexpr bool PERM = false; __device__ __forceinline__ void mid(f32x4 (&)[2][2][4][2], const Unit&, int, int, int, int) const {} };
__device__ __forceinline__ bool unit_at(const GemmD& d, int i, Unit& u) {
    const long L = (long)(d.dual ? (i >> 1) : i) * gridDim.x + blockIdx.x; const int per = d.nM * d.nN;
    u.part = d.dual ? (i & 1) : 0;
    if (L >= (long)per * d.nG) return false;
    if (d.nG == 1) {
        int wgid = (int)L; const int nwg = per;
        { const int q = nwg / 8, r = nwg % 8, xcd = wgid % 8, off = wgid / 8; wgid = (xcd < r ? xcd * (q + 1) : r * (q + 1) + (xcd - r) * q) + off; }
        const int nig = 8 * d.nN, gid = wgid / nig, fm = gid * 8, gsz = (d.nM - fm) < 8 ? (d.nM - fm) : 8;
        u.pm = fm + ((wgid % nig) % gsz); u.pn = (wgid % nig) / gsz; u.g = 0;
    } else if ((d.nG & 7) == 0) {
        const int x = (int)(L & 7), j = (int)(L >> 3), gpx = d.nG >> 3;
        u.g = x * gpx + j / per; const int w = j % per; u.pm = w / d.nN; u.pn = w % d.nN;
    } else { u.g = (int)(L / per); const int w = (int)(L % per); u.pm = w / d.nN; u.pn = w % d.nN; }
    return true;
}
__device__ __forceinline__ const char* a_base(const GemmD& d, const Unit& u) {
    const size_t row0 = d.permA ? (size_t)(((u.pm >> 5) << 13) + 4 * (u.pm & 31)) : (size_t)u.pm * 256;
    return (const char*)(((d.dual && u.part) ? d.A2 : d.A) + (size_t)u.g * d.gsA + row0 * d.lda);
}
__device__ __forceinline__ const char* b_base(const GemmD& d, const Unit& u) { return (const char*)(((d.dual && u.part) ? d.Bt2 : d.Bt) + (size_t)u.g * d.gsB + (size_t)u.pn * 256 * d.ldb); }

template <class Epi>
__device__ __forceinline__ void gemm_phase(PG8_LAS unsigned char* lds, const GemmD g, const Epi& E) {
    const int tid = threadIdx.x, wid = __builtin_amdgcn_readfirstlane(tid >> 6), lane = tid & 63, wr = wid >> 2, wc = wid & 3, fr = lane & 15, fq = lane >> 4;
    const int K = g.K, nt = K / BK;
    unsigned voffA[2], voffB[2];
#pragma unroll
    for (int i = 0; i < 2; ++i) { int R, C; stage_rc(tid * 16 + i * 8192, R, C);
        const int Ra = g.permA ? (((R & 63) << 7) + (R >> 6)) : R;
        const int Rb = Epi::PERM ? ((R & ~31) + perm32(R & 31)) : R;
        voffA[i] = (unsigned)(Ra * g.lda + C) * 2u; voffB[i] = (unsigned)(Rb * g.ldb + C) * 2u; }
    const size_t kstep = (size_t)(BK * 2);
    const size_t hstepA = g.permA ? (size_t)2 * g.lda * 2 : (size_t)HALF * g.lda * 2;
    const size_t hstepB = (size_t)HALF * g.ldb * 2;
    const unsigned ldsw = (unsigned)wid * 1024u;
    const int aoff = lds_byte(wr * 64 + fr, fq * 8), boff = lds_byte(wc * 32 + fr, fq * 8);
#define PG8_SA(b, h) (((b) * 2 + (h)) * HTB)
#define PG8_SB(b, h) ((4 + (b) * 2 + (h)) * HTB)
#define PG8_STAGE(bufoff, gbase, voff) do { _Pragma("unroll") for (int _i = 0; _i < 2; ++_i) \
        __builtin_amdgcn_global_load_lds((const unsigned*)((const char*)(gbase) + (voff)[_i]), (PG8_LAS unsigned*)(lds + (bufoff) + ldsw + _i * 8192), 16, 0, 0); } while (0)
#define PG8_LDA(dst, b, h) do { _Pragma("unroll") for (int m = 0; m < 4; ++m) _Pragma("unroll") for (int k = 0; k < 2; ++k) dst[m][k] = *(const PG8_LAS bf16x8*)(lds + PG8_SA(b, h) + aoff + m * 2048 + k * 1024); } while (0)
#define PG8_LDB(dst, b, h) do { _Pragma("unroll") for (int n = 0; n < 2; ++n) _Pragma("unroll") for (int k = 0; k < 2; ++k) dst[n][k] = *(const PG8_LAS bf16x8*)(lds + PG8_SB(b, h) + boff + n * 2048 + k * 1024); } while (0)
#define PG8_MMA(ai, bj, At, Bt) do { __builtin_amdgcn_s_setprio(1); _Pragma("unroll") for (int m = 0; m < 4; ++m) _Pragma("unroll") for (int n = 0; n < 2; ++n) _Pragma("unroll") for (int k = 0; k < 2; ++k) \
        acc[ai][bj][m][n] = __builtin_amdgcn_mfma_f32_16x16x32_bf16(Bt[n][k], At[m][k], acc[ai][bj][m][n], 0, 0, 0); __builtin_amdgcn_s_setprio(0); } while (0)
#define PG8_WAIT_V(n) asm volatile("s_waitcnt vmcnt(" #n ")" ::: "memory")
#define PG8_WAIT_L(n) asm volatile("s_waitcnt lgkmcnt(" #n ")" ::: "memory")
#define PG8_BAR __builtin_amdgcn_s_barrier()
#define PG8_SCHED __builtin_amdgcn_sched_barrier(0)
    Unit cur, nxt; int ui = 0;
    if (!unit_at(g, 0, cur)) return;
    f32x4 acc[2][2][4][2];
#pragma unroll
    for (int a = 0; a < 2; ++a)
#pragma unroll
        for (int b = 0; b < 2; ++b)
#pragma unroll
            for (int m = 0; m < 4; ++m)
#pragma unroll
                for (int n = 0; n < 2; ++n) acc[a][b][m][n] = (f32x4){0.f, 0.f, 0.f, 0.f};
    bf16x8 At[4][2], B0[2][2], B1[2][2];
    const char* cA = a_base(g, cur); const char* cB = b_base(g, cur);
    PG8_STAGE(PG8_SB(0, 0), cB, voffB); PG8_STAGE(PG8_SA(0, 0), cA, voffA); PG8_STAGE(PG8_SB(0, 1), cB + hstepB, voffB); PG8_STAGE(PG8_SA(0, 1), cA + hstepA, voffA);
    if (wr == 1) PG8_BAR;
    PG8_WAIT_V(4); PG8_BAR;
    PG8_STAGE(PG8_SB(1, 0), cB + kstep, voffB); PG8_STAGE(PG8_SA(1, 0), cA + kstep, voffA); PG8_STAGE(PG8_SB(1, 1), cB + hstepB + kstep, voffB);
    PG8_WAIT_V(6); PG8_BAR;
    for (;;) {
        const bool has_next = unit_at(g, ui + 1, nxt);
        const char* nA = has_next ? a_base(g, nxt) : cA; const char* nB = has_next ? b_base(g, nxt) : cB;
        for (int t = 0; t < nt; t += 2) {
            const bool last = (t == nt - 2);
            const char* a1 = cA + (size_t)(t + 1) * kstep;
            const char* a2 = last ? nA : cA + (size_t)(t + 2) * kstep; const char* b2 = last ? nB : cB + (size_t)(t + 2) * kstep;
            const char* a3 = a2 + kstep; const char* b3 = b2 + kstep;
            PG8_LDB(B0, 0, 0); PG8_SCHED; PG8_LDA(At, 0, 0); PG8_STAGE(PG8_SA(1, 1), a1 + hstepA, voffA);
            PG8_WAIT_L(8); PG8_BAR; PG8_WAIT_L(0); PG8_MMA(0, 0, At, B0); PG8_BAR; PG8_SCHED;
            PG8_LDB(B1, 0, 1); PG8_STAGE(PG8_SB(0, 0), b2, voffB);
            PG8_BAR; PG8_WAIT_L(0); PG8_MMA(0, 1, At, B1); PG8_BAR;
            PG8_LDA(At, 0, 1); PG8_STAGE(PG8_SA(0, 0), a2, voffA);
            PG8_BAR; PG8_WAIT_L(0); PG8_MMA(1, 0, At, B0); PG8_BAR; PG8_SCHED;
            PG8_STAGE(PG8_SB(0, 1), b2 + hstepB, voffB);
            PG8_WAIT_V(6); PG8_BAR; PG8_MMA(1, 1, At, B1); PG8_BAR;
            PG8_LDB(B0, 1, 0); PG8_SCHED; PG8_LDA(At, 1, 0); PG8_STAGE(PG8_SA(0, 1), a2 + hstepA, voffA);
            PG8_WAIT_L(8); PG8_BAR; PG8_WAIT_L(0); PG8_MMA(0, 0, At, B0); PG8_BAR; PG8_SCHED;
            PG8_LDB(B1, 1, 1); PG8_STAGE(PG8_SB(1, 0), b3, voffB);
            PG8_BAR; PG8_WAIT_L(0); PG8_MMA(0, 1, At, B1); PG8_BAR;
            PG8_LDA(At, 1, 1); PG8_STAGE(PG8_SA(1, 0), a3, voffA);
            PG8_BAR; PG8_WAIT_L(0); PG8_MMA(1, 0, At, B0); PG8_BAR; PG8_SCHED;
            PG8_STAGE(PG8_SB(1, 1), b3 + hstepB, voffB);
            PG8_WAIT_V(6); PG8_BAR; PG8_MMA(1, 1, At, B1); PG8_BAR;
        }
        const bool midp = g.dual && cur.part == 0;
        if (midp) E.mid(acc, cur, wr, wc, fr, fq); else E(acc, cur, wr, wc, fr, fq);
        if (!has_next) break;
        if (!midp)
#pragma unroll
        for (int a = 0; a < 2; ++a)
#pragma unroll
            for (int b = 0; b < 2; ++b)
#pragma unroll
                for (int m = 0; m < 4; ++m)
#pragma unroll
                    for (int n = 0; n < 2; ++n) acc[a][b][m][n] = (f32x4){0.f, 0.f, 0.f, 0.f};
        cur = nxt; cA = nA; cB = nB; ++ui;
    }
    PG8_WAIT_V(0);
    if (wr == 0) PG8_BAR;
    PG8_BAR;
#undef PG8_SA
#undef PG8_SB
#undef PG8_STAGE
#undef PG8_LDA
#undef PG8_LDB
#undef PG8_MMA
#undef PG8_WAIT_V
#undef PG8_WAIT_L
#undef PG8_BAR
#undef PG8_SCHED
}
}
using pg8::Unit; using pg8::GemmD;
typedef f32x4 AccT[2][2][4][2];
#define EPI_LOOP _Pragma("unroll") for (int ai = 0; ai < 2; ++ai) _Pragma("unroll") for (int bj = 0; bj < 2; ++bj) _Pragma("unroll") for (int mm = 0; mm < 4; ++mm) _Pragma("unroll") for (int nn = 0; nn < 2; ++nn) { \
    const int m = 256 * u.pm + 128 * ai + 64 * wr + 16 * mm + fr; const int n = 256 * u.pn + 128 * bj + 32 * wc + 16 * nn + 4 * fq; const f32x4 v = acc[ai][bj][mm][nn];
#define EPI_LOOP_END }
#define EPI_LOOP_NV _Pragma("unroll") for (int ai = 0; ai < 2; ++ai) _Pragma("unroll") for (int bj = 0; bj < 2; ++bj) _Pragma("unroll") for (int mm = 0; mm < 4; ++mm) _Pragma("unroll") for (int nn = 0; nn < 2; ++nn) { \
    const int m = 256 * u.pm + 128 * ai + 64 * wr + 16 * mm + fr; const int n = 256 * u.pn + 128 * bj + 32 * wc + 16 * nn + 4 * fq;

__device__ __forceinline__ int map_row(int mode, int n) {
    if (mode == 1) return ((n >> 7) << 8) + (n & 127);
    if (mode == 2) return ((n >> 7) << 8) + 128 + (n & 127);
    if (mode == 3) {
        if (n < 2048) return n;
        if (n < 2080) return 4096 + (n - 2048);
        if (n < 3104) { const int j = n - 2080; return 2048 + ((j >> 4) << 5) + (((j >> 2) & 3) << 3) + (j & 3); }
        { const int j = n - 3104; return 2048 + ((j >> 4) << 5) + (((j >> 2) & 3) << 3) + 4 + (j & 3); }
    }
    return n;
}
struct TItem { const float* src; bf16_t* dst; int K, mode, n0; };
__device__ __forceinline__ void transpose_load(const TItem& t, int N, float (&v)[8]) {
#pragma unroll
    for (int i = 0; i < 8; ++i) v[i] = t.src[(size_t)(8 * i) * N];
}
__device__ __forceinline__ void transpose_store(const TItem& t, const float (&v)[8], float* scr) {
    const int tid = threadIdx.x & 255;
#pragma unroll
    for (int i = 0; i < 8; ++i) scr[((tid >> 5) + 8 * i) * 33 + (tid & 31)] = v[i];
    __syncthreads();
    const int n = tid >> 3, kc = (tid & 7) * 8;
    const float* s = scr + kc * 33 + n;
    uint4 o; o.x = pk2(s[0], s[33]); o.y = pk2(s[66], s[99]); o.z = pk2(s[132], s[165]); o.w = pk2(s[198], s[231]);
    const int nd = map_row(t.mode, t.n0 + n);
    *(uint4*)(t.dst + (size_t)nd * t.K) = o;
    __syncthreads();
}
__device__ __forceinline__ void ada_item(const Params& P, int item, float* sm) {
    float* sv = sm; float* red = sm + 5 * 1024;
    const int tid = threadIdx.x & 255;
    for (int e = tid; e < 5 * 1024; e += 256) { const int r = e >> 10, k = e & 1023; const float c = r < 4 ? P.in[1][r * 1024 + k] : P.in[3][k]; sv[e] = siluf_(c); }
    __syncthreads();
    const int cgp = tid & 15, kg = tid >> 4, n0 = item * 64;
    f32x4 a[5];
#pragma unroll
    for (int r = 0; r < 5; ++r) a[r] = (f32x4){0.f, 0.f, 0.f, 0.f};
    const float* wp = P.in[4] + (size_t)(kg * 64) * 9216 + n0 + cgp * 4;
#pragma unroll 16
    for (int kk = 0; kk < 64; ++kk) {
        const f32x4 w4 = *(const f32x4*)(wp + (size_t)kk * 9216);
#pragma unroll
        for (int r = 0; r < 5; ++r) { const float s = sv[r * 1024 + kg * 64 + kk]; a[r] += w4 * s; }
    }
#pragma unroll
    for (int r = 0; r < 5; ++r) *(f32x4*)(red + (kg * 5 + r) * 64 + cgp * 4) = a[r];
    __syncthreads();
    for (int e = tid; e < 320; e += 256) {
        const int r = e >> 6, col = e & 63; float s = P.in[5][n0 + col];
#pragma unroll
        for (int g = 0; g < 16; ++g) s += red[(g * 5 + r) * 64 + col];
        ((float*)(P.ws + OFF_MOD))[r * 9216 + n0 + col] = s;
    }
    __syncthreads();
}

__device__ __forceinline__ float2 cmul(float2 a, float2 b) { return make_float2(a.x * b.x - a.y * b.y, a.x * b.y + a.y * b.x); }

__device__ __forceinline__ void phase0(const Params& P, unsigned char* smem) {
    const int hb = threadIdx.x >> 8;
    float* scr = (float*)(smem + hb * HALF_LDS);
    struct TW { int in; int K, N; size_t off; int mode; };
    const TW tw[13] = {
        {7, 1024, 2816, OFF_WGU1, 1}, {8, 1024, 2816, OFF_WGU1, 2}, {9, 2816, 1024, OFF_WDN1, 0},
        {29, 1024, 2816, OFF_WGU2, 1}, {30, 1024, 2816, OFF_WGU2, 2}, {31, 2816, 1024, OFF_WDN2, 0},
        {11, 1024, 4128, OFF_WIN, 3}, {20, 512, 512, OFF_WGLU, 0}, {22, 512, 1024, OFF_WS5O, 0}, {26, 512, 1024, OFF_WGLO, 0}, {27, 1024, 1024, OFF_WWO, 0},
        {0, 0, 0, 0, 0}, {0, 0, 0, 0, 0}};
    int total = 0;
#pragma unroll
    for (int i = 0; i < 11; ++i) total += (tw[i].K >> 6) * (tw[i].N >> 5);
    const int n_ada = 144;
    for (int base = blockIdx.x * 2; base < n_ada; base += gridDim.x * 2) ada_item(P, base + hb, scr);
    auto lookup = [&](int it, TItem& t, int& N) {
        int r = it < total ? it : total - 1;
        t.src = nullptr; t.dst = nullptr; t.K = 0; t.mode = 0; t.n0 = 0; N = 0;
#pragma unroll
        for (int i = 0; i < 11; ++i) {
            const int cnt = (tw[i].K >> 6) * (tw[i].N >> 5);
            if (r >= 0 && r < cnt) {
                const int nblk = tw[i].N >> 5, kb = r / nblk, nb = r - kb * nblk, k0 = kb * 64, n0 = nb * 32, tid = threadIdx.x & 255;
                N = tw[i].N; t.K = tw[i].K; t.mode = tw[i].mode; t.n0 = n0;
                t.src = P.in[tw[i].in] + (size_t)(k0 + (tid >> 5)) * tw[i].N + n0 + (tid & 31);
                t.dst = (bf16_t*)(P.ws + tw[i].off) + k0 + (tid & 7) * 8;
            }
            r -= cnt;
        }
    };
    {
        const int stride = gridDim.x * 2;
        int it = blockIdx.x * 2 + hb;
        TItem cur, nxt; int Nc = 0, Nn = 0; float vn[8];
        if (blockIdx.x * 2 < total) { lookup(it, nxt, Nn); transpose_load(nxt, Nn, vn); }
        for (int base = blockIdx.x * 2; base < total; base += stride) {
            float v[8];
#pragma unroll
            for (int i = 0; i < 8; ++i) v[i] = vn[i];
            cur = nxt; Nc = Nn;
            if (base + stride < total) { lookup(it + stride, nxt, Nn); transpose_load(nxt, Nn, vn); }
            transpose_store(cur, v, scr);
            it += stride;
        }
    }
    const int gtid = blockIdx.x * NTHR + threadIdx.x, gsz = gridDim.x * NTHR;
    for (int e = gtid; e < NT + 2 * NL; e += gsz) ((float*)(P.ws + OFF_SS))[e] = 0.f;
    float2* LP = (float2*)(P.ws + OFF_LP); float2* BB = (float2*)(P.ws + OFF_BB);
    for (int e = gtid; e < 2 * 32 * 33 * 64; e += gsz) {
        const int p = e & 63, tau = (e >> 6) % 33, dg = e / (33 * 64);
        const float lre = fminf(P.in[12][dg * 64 + p], -1e-4f), lim = P.in[13][dg * 64 + p], dt = expf(P.in[14][dg]);
        const float mag = expf(lre * dt * (float)tau), ang = (lim * dt) * (float)tau;
        float sn, cs; sincosf(ang, &sn, &cs);
        LP[e] = make_float2(mag * cs, mag * sn);
    }
    for (int e = gtid; e < 2 * 32 * 64 * 16; e += gsz) {
        const int dgp = e >> 4;
        const int dg = dgp >> 6;
        const float lre = fminf(P.in[12][dgp], -1e-4f), lim = P.in[13][dgp], dt = expf(P.in[14][dg]);
        const float mag = expf(lre * dt), ang = lim * dt;
        float sn, cs; sincosf(ang, &sn, &cs);
        const float ar = mag * cs - 1.f, ai = mag * sn;
        const float den = lre * lre + lim * lim;
        const float qr = (ar * lre + ai * lim) / den, qi = (ai * lre - ar * lim) / den;
        BB[e] = cmul(make_float2(qr, qi), make_float2(P.in[15][e], P.in[16][e]));
    }
}

__device__ __forceinline__ void norm_row_pre(const f32x4 (&v)[4], const float* __restrict__ g, const float* __restrict__ shift, const float* __restrict__ scale, bf16_t* __restrict__ dst, int lane) {
    float ss = 0.f;
#pragma unroll
    for (int j = 0; j < 4; ++j) ss += v[j][0] * v[j][0] + v[j][1] * v[j][1] + v[j][2] * v[j][2] + v[j][3] * v[j][3];
    ss = wave_sum(ss);
    const float rstd = rsqrtf(ss * (1.f / 1024.f) + 1e-6f);
#pragma unroll
    for (int j = 0; j < 4; ++j) {
        const int c4 = lane + 64 * j;
        const f32x4 g4 = ((const f32x4*)g)[c4], sh = ((const f32x4*)shift)[c4], sc = ((const f32x4*)scale)[c4];
        f32x4 h = (v[j] * rstd) * g4; h = h * (sc + 1.f) + sh;
        store_bf4(dst + c4 * 4, h);
    }
}
__device__ __forceinline__ void norm_row(const float* __restrict__ src, const float* __restrict__ g, const float* __restrict__ shift, const float* __restrict__ scale, bf16_t* __restrict__ dst, int lane) {
    f32x4 v[4]; float ss = 0.f;
#pragma unroll
    for (int j = 0; j < 4; ++j) { v[j] = ((const f32x4*)src)[lane + 64 * j]; ss += v[j][0] * v[j][0] + v[j][1] * v[j][1] + v[j][2] * v[j][2] + v[j][3] * v[j][3]; }
    ss = wave_sum(ss);
    const float rstd = rsqrtf(ss * (1.f / 1024.f) + 1e-6f);
#pragma unroll
    for (int j = 0; j < 4; ++j) {
        const int c4 = lane + 64 * j;
        const f32x4 g4 = ((const f32x4*)g)[c4], sh = ((const f32x4*)shift)[c4], sc = ((const f32x4*)scale)[c4];
        f32x4 h = (v[j] * rstd) * g4; h = h * (sc + 1.f) + sh;
        store_bf4(dst + c4 * 4, h);
    }
}

__device__ __forceinline__ void phase1(const Params& P) {
    const int lane = threadIdx.x & 63, w = threadIdx.x >> 6;
    const float* mod = (const float*)(P.ws + OFF_MOD);
    bf16_t* H = (bf16_t*)(P.ws + OFF_H);
    {
        const int stride = gridDim.x * 8;
        int row = blockIdx.x * 8 + w;
        f32x4 vn[4];
        if (row < NT) { const float* src = row < NL ? P.in[0] + (size_t)row * 1024 : P.in[2] + (size_t)(row - NL) * 1024;
#pragma unroll
            for (int j = 0; j < 4; ++j) vn[j] = ((const f32x4*)src)[lane + 64 * j]; }
        while (row < NT) {
            f32x4 v[4];
#pragma unroll
            for (int j = 0; j < 4; ++j) v[j] = vn[j];
            const int nrow = row + stride;
            if (nrow < NT) { const float* src = nrow < NL ? P.in[0] + (size_t)nrow * 1024 : P.in[2] + (size_t)(nrow - NL) * 1024;
#pragma unroll
                for (int j = 0; j < 4; ++j) vn[j] = ((const f32x4*)src)[lane + 64 * j]; }
            const int mr = row < NL ? (row >> 13) : 4;
            norm_row_pre(v, P.in[6], mod + mr * 9216 + 0, mod + mr * 9216 + 1024, H + (size_t)row * 1024, lane);
            if (row >= NL) {
#pragma unroll
                for (int j = 0; j < 4; ++j) ((f32x4*)((float*)(P.ws + OFF_E) + (size_t)(row - NL) * 1024))[lane + 64 * j] = v[j];
            }
            row = nrow;
        }
    }
    for (int r0 = blockIdx.x * 32 + w * 4; r0 < 4352 + 5632; r0 += gridDim.x * 32) {
        const bool first = r0 < 4352;
        const bf16_t* wt = first ? (const bf16_t*)(P.ws + OFF_WIN) + (size_t)r0 * 1024 : (const bf16_t*)(P.ws + OFF_WGU2) + (size_t)(r0 - 4352) * 1024;
        const float* sh = mod + (first ? 3 : 6) * 1024 + lane * 16;
        uint4 wq[4][2];
#pragma unroll
        for (int i = 0; i < 4; ++i) { wq[i][0] = *(const uint4*)(wt + (size_t)i * 1024 + lane * 16); wq[i][1] = *(const uint4*)(wt + (size_t)i * 1024 + lane * 16 + 8); }
        f32x4 s4[5][4];
#pragma unroll
        for (int mr = 0; mr < 5; ++mr)
#pragma unroll
            for (int q = 0; q < 4; ++q) s4[mr][q] = *(const f32x4*)(sh + mr * 9216 + q * 4);
        float* BW = (float*)(P.ws + OFF_BW);
#pragma unroll
        for (int i = 0; i < 4; ++i) {
            const uint4 w0 = wq[i][0], w1 = wq[i][1];
            const float wv[16] = {bflo(w0.x), bfhi(w0.x), bflo(w0.y), bfhi(w0.y), bflo(w0.z), bfhi(w0.z), bflo(w0.w), bfhi(w0.w),
                                  bflo(w1.x), bfhi(w1.x), bflo(w1.y), bfhi(w1.y), bflo(w1.z), bfhi(w1.z), bflo(w1.w), bfhi(w1.w)};
            const int r = r0 + i;
#pragma unroll
            for (int mr = 0; mr < 5; ++mr) {
                float a = 0.f;
#pragma unroll
                for (int q = 0; q < 4; ++q) a += s4[mr][q][0] * wv[q * 4] + s4[mr][q][1] * wv[q * 4 + 1] + s4[mr][q][2] * wv[q * 4 + 2] + s4[mr][q][3] * wv[q * 4 + 3];
                a = wave_sum(a);
                if (lane == 0) { if (first) BW[mr * 4352 + r] = a; else BW[5 * 4352 + mr * 5632 + (r - 4352)] = a; }
            }
        }
    }
    const int gtid = blockIdx.x * NTHR + threadIdx.x, gsz = gridDim.x * NTHR;
    const float2* LP = (const float2*)(P.ws + OFF_LP); const float2* BB = (const float2*)(P.ws + OFF_BB);
    float* KD = (float*)(P.ws + OFF_KD);
    {
        constexpr int N = 2 * 32 * 32 * 256;
        int e0 = gtid;
        for (; e0 + 3 * gsz < N; e0 += 4 * gsz) {
            float sacc[4] = {0.f, 0.f, 0.f, 0.f};
#pragma unroll 2
            for (int p = 0; p < 64; ++p) {
#pragma unroll
                for (int q = 0; q < 4; ++q) {
                    const int e = e0 + q * gsz;
                    const int cp = e & 15, c = (e >> 4) & 15, tau = (e >> 8) & 31, dg = e >> 13;
                    const float2 C = make_float2(P.in[17][(dg * 16 + c) * 64 + p], P.in[18][(dg * 16 + c) * 64 + p]);
                    const float2 z = cmul(LP[(dg * 33 + tau) * 64 + p], BB[(dg * 64 + p) * 16 + cp]);
                    sacc[q] += C.x * z.x - C.y * z.y;
                }
            }
#pragma unroll
            for (int q = 0; q < 4; ++q) KD[e0 + q * gsz] = sacc[q];
        }
        for (; e0 < N; e0 += gsz) {
            const int e = e0, cp = e & 15, c = (e >> 4) & 15, tau = (e >> 8) & 31, dg = e >> 13;
            float sa = 0.f;
            for (int p = 0; p < 64; ++p) {
                const float2 C = make_float2(P.in[17][(dg * 16 + c) * 64 + p], P.in[18][(dg * 16 + c) * 64 + p]);
                const float2 z = cmul(LP[(dg * 33 + tau) * 64 + p], BB[(dg * 64 + p) * 16 + cp]);
                sa += C.x * z.x - C.y * z.y;
            }
            KD[e] = sa;
        }
    }
    bf16_t* WE = (bf16_t*)(P.ws + OFF_WE);
    auto we_val = [&](int e) -> float {
        const int k = e & 511, n = (e >> 9) & 255, g = e >> 17;
        const int s = k >> 4, cp = k & 15, d = n >> 7, ri = (n >> 6) & 1, p = n & 63, dg = d * 32 + g;
        const int tau = d == 0 ? 31 - s : s;
        const float2 z = cmul(LP[(dg * 33 + tau) * 64 + p], BB[(dg * 64 + p) * 16 + cp]);
        return ri ? z.y : z.x;
    };
    {
        constexpr int N = 32 * 256 * 512;
        int e0 = gtid;
        for (; e0 + 3 * gsz < N; e0 += 4 * gsz) {
            float val[4];
#pragma unroll
            for (int q = 0; q < 4; ++q) val[q] = we_val(e0 + q * gsz);
#pragma unroll
            for (int q = 0; q < 4; ++q) WE[e0 + q * gsz] = f2bf(val[q]);
        }
        for (; e0 < N; e0 += gsz) WE[e0] = f2bf(we_val(e0));
    }
    bf16_t* WY = (bf16_t*)(P.ws + OFF_WY);
    auto po_val = [&](int e) -> float {
        const int kk = e & 255, n = (e >> 8) & 511, g = e >> 17;
        const int t = n >> 4, c = n & 15, d = kk >> 7, ri = (kk >> 6) & 1, p = kk & 63, dg = d * 32 + g;
        const int tau = d == 0 ? t + 1 : 32 - t;
        const float2 C = make_float2(P.in[17][(dg * 16 + c) * 64 + p], P.in[18][(dg * 16 + c) * 64 + p]);
        const float2 z = cmul(C, LP[(dg * 33 + tau) * 64 + p]);
        return ri ? -z.y : z.x;
    };
    auto po_idx = [&](int e) -> size_t { const int kk = e & 255, n = (e >> 8) & 511, g = e >> 17; return ((size_t)g * 512 + n) * 768 + 512 + kk; };
    {
        constexpr int N = 32 * 512 * 256;
        int e0 = gtid;
        for (; e0 + 3 * gsz < N; e0 += 4 * gsz) {
            float val[4];
#pragma unroll
            for (int q = 0; q < 4; ++q) val[q] = po_val(e0 + q * gsz);
#pragma unroll
            for (int q = 0; q < 4; ++q) WY[po_idx(e0 + q * gsz)] = f2bf(val[q]);
        }
        for (; e0 < N; e0 += gsz) WY[po_idx(e0)] = f2bf(po_val(e0));
    }
}

__device__ __forceinline__ void phase4(const Params& P) {
    const int lane = threadIdx.x & 63, w = threadIdx.x >> 6;
    const float* mod = (const float*)(P.ws + OFF_MOD);
    bf16_t* H = (bf16_t*)(P.ws + OFF_H);
    const float* XRC = (const float*)(P.ws + OFF_E);
    float* ss2 = (float*)(P.ws + OFF_SS);
    for (int r0 = blockIdx.x * 32 + w * 4; r0 < NC; r0 += gridDim.x * 32)
    for (int r = r0; r < r0 + 4; ++r) {
        const float* src = XRC + (size_t)r * 1024;
        float ss = 0.f;
#pragma unroll
        for (int j = 0; j < 4; ++j) {
            const int c4 = lane + 64 * j;
            const f32x4 v = ((const f32x4*)src)[c4];
            ss += v[0] * v[0] + v[1] * v[1] + v[2] * v[2] + v[3] * v[3];
            const f32x4 g4 = ((const f32x4*)P.in[10])[c4], sc = ((const f32x4*)(mod + 4 * 9216 + 4 * 1024))[c4];
            store_bf4(H + (size_t)(NL + r) * 1024 + c4 * 4, v * (g4 * (sc + 1.f)));
        }
        ss = wave_sum(ss);
        if (lane == 0) ss2[NL + r] = ss;
    }
    const bool split = gridDim.x > 64;
    if (split && blockIdx.x < 32) return;
    const int gtid = (split ? (int)blockIdx.x - 32 : (int)blockIdx.x) * NTHR + threadIdx.x, gsz = (split ? (int)gridDim.x - 32 : (int)gridDim.x) * NTHR;
    const float* KD = (const float*)(P.ws + OFF_KD);
    bf16_t* WY = (bf16_t*)(P.ws + OFF_WY);
    auto kf_val = [&](int e) -> float {
        const int k = e & 511, n = (e >> 9) & 511, g = e >> 18;
        const int t = n >> 4, c = n & 15, s = k >> 4, cp = k & 15;
        const int d0 = t - s, d1 = s - t;
        const float a0 = KD[(((0 * 32 + g) * 32 + (d0 > 0 ? d0 : 0)) * 16 + c) * 16 + cp];
        const float a1 = KD[(((1 * 32 + g) * 32 + (d1 > 0 ? d1 : 0)) * 16 + c) * 16 + cp];
        return (s <= t ? a0 : 0.f) + (s >= t ? a1 : 0.f);
    };
    auto kf_idx = [&](int e) -> size_t { const int k = e & 511, n = (e >> 9) & 511, g = e >> 18; return ((size_t)g * 512 + n) * 768 + k; };
    {
        constexpr int N = 32 * 512 * 512;
        int e0 = gtid;
        for (; e0 + 3 * gsz < N; e0 += 4 * gsz) {
            float val[4];
#pragma unroll
            for (int q = 0; q < 4; ++q) val[q] = kf_val(e0 + q * gsz);
#pragma unroll
            for (int q = 0; q < 4; ++q) WY[kf_idx(e0 + q * gsz)] = f2bf(val[q]);
        }
        for (; e0 < N; e0 += gsz) WY[kf_idx(e0)] = f2bf(kf_val(e0));
    }
}

__device__ __forceinline__ void phase15(const Params& P) {
    const int lane = threadIdx.x & 63, w = threadIdx.x >> 6;
    const float* ss4 = (const float*)(P.ws + OFF_SS) + NT + NL;
    const int stride = gridDim.x * 8;
    int row = blockIdx.x * 8 + w;
    f32x4 vn[4]; float sn = 0.f;
    if (row < NL) { sn = ss4[row];
#pragma unroll
        for (int j = 0; j < 4; ++j) vn[j] = ((const f32x4*)(P.out + (size_t)row * 1024))[lane + 64 * j]; }
    f32x4 fn[4];
#pragma unroll
    for (int j = 0; j < 4; ++j) fn[j] = ((const f32x4*)P.in[32])[lane + 64 * j];
    while (row < NL) {
        f32x4 v[4]; const float sc = sn;
#pragma unroll
        for (int j = 0; j < 4; ++j) v[j] = vn[j];
        const int nrow = row + stride;
        if (nrow < NL) { sn = ss4[nrow];
#pragma unroll
            for (int j = 0; j < 4; ++j) vn[j] = ((const f32x4*)(P.out + (size_t)nrow * 1024))[lane + 64 * j]; }
        const float rstd = rsqrtf(sc * (1.f / 1024.f) + 1e-6f);
        f32x4* o = (f32x4*)(P.out + (size_t)row * 1024);
#pragma unroll
        for (int j = 0; j < 4; ++j) o[lane + 64 * j] = (v[j] * rstd) * fn[j];
        row = nrow;
    }
}

template <int NORM> struct EpiFfnUp : pg8::EpiNoMid {
    static constexpr bool PERM = true;
    bf16_t* HID; const float* ss; const float* BW;
    __device__ __forceinline__ void operator()(const AccT& acc, const Unit& u, int wr, int wc, int fr, int fq) const {
        f32x4 bwg[2], bwu[2]; float rstd[2][4];
        if (NORM) {
            const float* bw = BW + ((256 * u.pm) >> 13) * 5632 + 256 * u.pn + 32 * wc + 8 * fq;
#pragma unroll
            for (int nn = 0; nn < 2; ++nn) { bwg[nn] = *(const f32x4*)(bw + 4 * nn); bwu[nn] = *(const f32x4*)(bw + 128 + 4 * nn); }
#pragma unroll
            for (int ai = 0; ai < 2; ++ai)
#pragma unroll
                for (int mm = 0; mm < 4; ++mm) rstd[ai][mm] = rsqrtf(ss[256 * u.pm + 128 * ai + 64 * wr + 16 * mm + fr] * (1.f / 1024.f) + 1e-6f);
        }
        const int oc = 128 * u.pn + 32 * wc + 8 * fq;
#pragma unroll
        for (int ai = 0; ai < 2; ++ai)
#pragma unroll
            for (int mm = 0; mm < 4; ++mm) {
                const int m = 256 * u.pm + 128 * ai + 64 * wr + 16 * mm + fr;
                f32x4 o[2];
#pragma unroll
                for (int nn = 0; nn < 2; ++nn) {
                    f32x4 g = acc[ai][0][mm][nn], uu = acc[ai][1][mm][nn];
                    if (NORM) { g = g * rstd[ai][mm] + bwg[nn]; uu = uu * rstd[ai][mm] + bwu[nn]; }
#pragma unroll
                    for (int r = 0; r < 4; ++r) o[nn][r] = siluf_(g[r]) * uu[r];
                }
                *(uint4*)(HID + (size_t)m * FF + oc) = make_uint4(pk2(o[0][0], o[0][1]), pk2(o[0][2], o[0][3]), pk2(o[1][0], o[1][1]), pk2(o[1][2], o[1][3]));
            }
    }
};
template <int MODE> struct EpiRes : pg8::EpiNoMid {
    static constexpr bool PERM = true;
    const float* x; bf16_t* XRb; float* out; bf16_t* Hn; const float* mod; const float* gnext; float* ss;
    __device__ __forceinline__ void operator()(const AccT& acc, const Unit& u, int wr, int wc, int fr, int fq) const {
        constexpr int GJ = MODE == 0 ? 2 : (MODE == 1 ? 5 : 8), SJ = MODE == 0 ? 4 : 7;
        constexpr float COEF = MODE == 1 ? 1.f : 0.5f;
        const float* mb = mod + ((256 * u.pm) >> 13) * 9216;
        const int nb = 256 * u.pn + 32 * wc + 8 * fq;
        f32x4 gate[2][2]; uint2 gmp[2][2];
#pragma unroll
        for (int bj = 0; bj < 2; ++bj)
#pragma unroll
            for (int nn = 0; nn < 2; ++nn) {
                const int n = nb + 128 * bj + 4 * nn;
                gate[bj][nn] = *(const f32x4*)(mb + GJ * 1024 + n) * COEF;
                if (MODE < 2) { const f32x4 t = *(const f32x4*)(gnext + n) * (*(const f32x4*)(mb + SJ * 1024 + n) + 1.f); gmp[bj][nn] = make_uint2(pk2(t[0], t[1]), pk2(t[2], t[3])); }
            }
#pragma unroll
        for (int ai = 0; ai < 2; ++ai)
#pragma unroll
        for (int mh = 0; mh < 2; ++mh) {
            const size_t rb = (size_t)(256 * u.pm + 128 * ai + 64 * wr + 32 * mh + fr) * 1024 + nb;
            f32x4 xf[MODE == 0 ? 2 : 1][2][2]; uint4 xh[MODE == 0 ? 1 : 2][2];
#pragma unroll
            for (int mm = 0; mm < 2; ++mm)
#pragma unroll
                for (int bj = 0; bj < 2; ++bj) {
                    const size_t idx = rb + (size_t)mm * 16 * 1024 + 128 * bj;
                    if (MODE == 0) { xf[mm][bj][0] = *(const f32x4*)(x + idx); xf[mm][bj][1] = *(const f32x4*)(x + idx + 4); }
                    else xh[mm][bj] = *(const uint4*)(XRb + idx);
                }
#pragma unroll
            for (int mm = 0; mm < 2; ++mm) {
                float part = 0.f;
#pragma unroll
                for (int bj = 0; bj < 2; ++bj) {
                    const size_t idx = rb + (size_t)mm * 16 * 1024 + 128 * bj;
                    f32x4 x0, x1;
                    if (MODE == 0) { x0 = xf[mm][bj][0]; x1 = xf[mm][bj][1]; }
                    else { const uint4 h4 = xh[mm][bj]; x0 = (f32x4){bflo(h4.x), bfhi(h4.x), bflo(h4.y), bfhi(h4.y)}; x1 = (f32x4){bflo(h4.z), bfhi(h4.z), bflo(h4.w), bfhi(h4.w)}; }
                    const f32x4 n0 = x0 + gate[bj][0] * acc[ai][bj][2 * mh + mm][0], n1 = x1 + gate[bj][1] * acc[ai][bj][2 * mh + mm][1];
                    part += (n0[0] * n0[0] + n0[1] * n0[1] + n0[2] * n0[2] + n0[3] * n0[3]) + (n1[0] * n1[0] + n1[1] * n1[1] + n1[2] * n1[2] + n1[3] * n1[3]);
                    if (MODE < 2) {
                        *(uint4*)(XRb + idx) = make_uint4(pk2(n0[0], n0[1]), pk2(n0[2], n0[3]), pk2(n1[0], n1[1]), pk2(n1[2], n1[3]));
                        const f32x4 g0 = {bflo(gmp[bj][0].x), bfhi(gmp[bj][0].x), bflo(gmp[bj][0].y), bfhi(gmp[bj][0].y)}, g1 = {bflo(gmp[bj][1].x), bfhi(gmp[bj][1].x), bflo(gmp[bj][1].y), bfhi(gmp[bj][1].y)};
                        const f32x4 h0 = n0 * g0, h1 = n1 * g1;
                        *(uint4*)(Hn + idx) = make_uint4(pk2(h0[0], h0[1]), pk2(h0[2], h0[3]), pk2(h1[0], h1[1]), pk2(h1[2], h1[3]));
                    } else { *(f32x4*)(out + idx) = n0; *(f32x4*)(out + idx + 4) = n1; }
                }
                part += __shfl_xor(part, 16); part += __shfl_xor(part, 32);
                if (fq == 0) (void)__hip_atomic_fetch_add(ss + 256 * u.pm + 128 * ai + 64 * wr + 32 * mh + 16 * mm + fr, part, __ATOMIC_RELAXED, __HIP_MEMORY_SCOPE_AGENT);
            }
        }
    }
};
template <int NORM>
__device__ __forceinline__ void phase_ffn_up(const Params& P, PG8_LAS unsigned char* lds, size_t off_w, int M) {
    GemmD g{}; g.A = (const bf16_t*)(P.ws + OFF_H); g.Bt = (const bf16_t*)(P.ws + off_w); g.lda = 1024; g.ldb = 1024; g.K = 1024; g.nM = M >> 8; g.nN = 22; g.nG = 1;
    EpiFfnUp<NORM> E; E.HID = (bf16_t*)(P.ws + OFF_HID); E.ss = (const float*)(P.ws + OFF_SS) + NT; E.BW = (const float*)(P.ws + OFF_BW) + 5 * 4352;
    pg8::gemm_phase(lds, g, E);
}
struct EpiFfnDownCtx : pg8::EpiNoMid {
    float* XR; const float* mod;
    __device__ __forceinline__ void operator()(const AccT& acc, const Unit& u, int wr, int wc, int fr, int fq) const {
#pragma unroll
        for (int bj = 0; bj < 2; ++bj)
#pragma unroll
            for (int nn = 0; nn < 2; ++nn) {
                const int n = 256 * u.pn + 128 * bj + 32 * wc + 16 * nn + 4 * fq;
                const f32x4 gt = *(const f32x4*)(mod + 4 * 9216 + 2 * 1024 + n) * 0.5f;
                float* xb = XR + (size_t)(256 * u.pm + 64 * wr + fr) * 1024 + n;
#pragma unroll
                for (int ai = 0; ai < 2; ++ai)
#pragma unroll
                    for (int mm = 0; mm < 4; ++mm) {
                        float* xp = xb + (size_t)(128 * ai + 16 * mm) * 1024;
                        const f32x4 v = acc[ai][bj][mm][nn] * gt;
#pragma unroll
                        for (int r = 0; r < 4; ++r) (void)__hip_atomic_fetch_add(xp + r, v[r], __ATOMIC_RELAXED, __HIP_MEMORY_SCOPE_AGENT);
                    }
                asm volatile("" ::: "memory");
            }
    }
};
template <int FIRST>
__device__ __forceinline__ void phase_ffn_down(const Params& P, PG8_LAS unsigned char* lds, size_t off_w) {
    GemmD g{}; g.A = (const bf16_t*)(P.ws + OFF_HID); g.Bt = (const bf16_t*)(P.ws + off_w); g.lda = FF; g.ldb = FF; g.K = FF; g.nM = NL >> 8; g.nN = 4; g.nG = 1;
    EpiRes<FIRST ? 0 : 2> E; E.x = P.in[0]; E.XRb = (bf16_t*)(P.ws + OFF_XR); E.out = P.out; E.Hn = (bf16_t*)(P.ws + OFF_H); E.mod = (const float*)(P.ws + OFF_MOD);
    E.gnext = P.in[10]; E.ss = (float*)(P.ws + OFF_SS) + (FIRST ? 0 : NT + NL);
    pg8::gemm_phase(lds, g, E);
    if (FIRST) {
        GemmD c{}; c.A = (const bf16_t*)(P.ws + OFF_HID) + (size_t)NL * FF; c.Bt = g.Bt; c.lda = FF; c.ldb = FF; c.K = 256; c.nM = 4; c.nN = 4; c.nG = 11; c.gsA = 256; c.gsB = 256;
        EpiFfnDownCtx EC; EC.XR = (float*)(P.ws + OFF_E); EC.mod = E.mod;
        pg8::gemm_phase(lds, c, EC);
    }
}
__device__ __forceinline__ uint4 pack8(f32x4 a, f32x4 b) { return make_uint4(pk2(a[0], a[1]), pk2(a[2], a[3]), pk2(b[0], b[1]), pk2(b[2], b[3])); }
struct EpiWin : pg8::EpiNoMid {
    static constexpr bool PERM = true;
    bf16_t *U, *Q, *Kb, *V, *R, *GLR, *GA, *GB; const float* ss; const float* BW;
    __device__ __forceinline__ void operator()(const AccT& acc, const Unit& u, int wr, int wc, int fr, int fq) const {
        f32x4 bias[2][2]; float rstd[2][4];
        const int m0 = 256 * u.pm, nb = 256 * u.pn + 32 * wc + 8 * fq;
        {
            const float* bw = BW + (m0 < NL ? (m0 >> 13) : 4) * 4352 + nb;
#pragma unroll
            for (int bj = 0; bj < 2; ++bj)
#pragma unroll
                for (int nn = 0; nn < 2; ++nn) bias[bj][nn] = *(const f32x4*)(bw + 128 * bj + 4 * nn);
#pragma unroll
            for (int ai = 0; ai < 2; ++ai)
#pragma unroll
                for (int mm = 0; mm < 4; ++mm) rstd[ai][mm] = rsqrtf(ss[m0 + 128 * ai + 64 * wr + 16 * mm + fr] * (1.f / 1024.f) + 1e-6f);
        }
#pragma unroll
        for (int ai = 0; ai < 2; ++ai)
#pragma unroll
            for (int mm = 0; mm < 4; ++mm) {
                const int m = m0 + 128 * ai + 64 * wr + 16 * mm + fr;
                const bool lat = m < NL;
                const int b = lat ? (m >> 13) : ((m - NL) >> 8), l = lat ? (m & 8191) : ((m - NL) & 255);
                const int rcm = lat ? (b << 13) + ((l & 63) << 7) + (l >> 6) : m;
#pragma unroll
                for (int bj = 0; bj < 2; ++bj) {
                    const int n = nb + 128 * bj;
                    const f32x4 v0 = acc[ai][bj][mm][0] * rstd[ai][mm] + bias[bj][0], v1 = acc[ai][bj][mm][1] * rstd[ai][mm] + bias[bj][1];
                    if (n < 512) {
                        const int g = n >> 4, urow = lat ? (b << 8) + (l >> 5) : 1024 + (b << 3) + (l >> 5), t = l & 31;
                        *(uint4*)(U + ((size_t)g * UROWS + urow) * 768 + t * 16 + (n & 15)) = pack8(v0, v1);
                    } else if (n < 768) { *(uint4*)(Q + (size_t)rcm * 256 + (n - 512)) = pack8(v0 * 0.125f, v1 * 0.125f); }
                    else if (n < 1024) { *(uint4*)(Kb + (size_t)rcm * 256 + (n - 768)) = pack8(v0, v1); }
                    else if (n < 1536) { *(uint4*)(V + (size_t)rcm * 512 + (n - 1024)) = pack8(v0, v1); }
                    else if (n < 2048) { *(uint4*)(R + (size_t)rcm * 512 + (n - 1536)) = pack8(v0, v1); }
                    else if (n < 4096) {
                        if (lat) {
                            const int j0 = ((256 * u.pn + 128 * bj + 32 * wc - 2048) >> 1) + 4 * fq;
                            f32x4 sa, rt;
#pragma unroll
                            for (int r = 0; r < 4; ++r) { const float ea = 1.f + __expf(-v0[r]), eb = 1.f + __expf(-v1[r]); sa[r] = rcpf_(ea); rt[r] = ea * rcpf_(eb); }
                            store_bf4(GA + (size_t)m * 1024 + j0, sa);
                            store_bf4(GB + (size_t)m * 1024 + j0, rt);
                        }
                    }
                    else if (n < 4128) { *(uint4*)(GLR + (size_t)rcm * 32 + (n - 4096)) = pack8(v0, v1); }
                }
            }
    }
};
__device__ __forceinline__ void phase5(const Params& P, PG8_LAS unsigned char* lds) {
    GemmD g{}; g.A = (const bf16_t*)(P.ws + OFF_H); g.Bt = (const bf16_t*)(P.ws + OFF_WIN); g.lda = 1024; g.ldb = 1024; g.K = 1024; g.nM = NT >> 8; g.nN = 17; g.nG = 1;
    EpiWin E; E.U = (bf16_t*)(P.ws + OFF_U); E.Q = (bf16_t*)(P.ws + OFF_Q); E.Kb = (bf16_t*)(P.ws + OFF_K); E.V = (bf16_t*)(P.ws + OFF_V); E.R = (bf16_t*)(P.ws + OFF_R);
    E.GLR = (bf16_t*)(P.ws + OFF_GLR); E.GA = (bf16_t*)P.out; E.GB = E.GA + (size_t)NL * 1024; E.ss = (const float*)(P.ws + OFF_SS); E.BW = (const float*)(P.ws + OFF_BW);
    pg8::gemm_phase(lds, g, E);
}

__device__ __forceinline__ float logsig(float z) { return fminf(z, 0.f) - __logf(1.f + __expf(-fabsf(z))); }

struct VRegs { uint4 a0, a1, b0, b1; };
__device__ __forceinline__ VRegs load_v_regs(const bf16_t* __restrict__ Vg, int t) {
    const int ip = t & 31, c = t >> 5; VRegs r;
    const bf16_t* p = Vg + (size_t)(2 * ip) * 512 + c * 16;
    r.a0 = *(const uint4*)p; r.a1 = *(const uint4*)(p + 8); r.b0 = *(const uint4*)(p + 512); r.b1 = *(const uint4*)(p + 520);
    return r;
}
__device__ __forceinline__ void store_vt(const VRegs& r, bf16_t* sVt, int t) {
    const int ip = t & 31, c = t >> 5;
    const unsigned ua[8] = {r.a0.x, r.a0.y, r.a0.z, r.a0.w, r.a1.x, r.a1.y, r.a1.z, r.a1.w};
    const unsigned ub[8] = {r.b0.x, r.b0.y, r.b0.z, r.b0.w, r.b1.x, r.b1.y, r.b1.z, r.b1.w};
    unsigned* base = (unsigned*)(sVt + (c * 16) * LROW + 2 * ip);
#pragma unroll
    for (int e = 0; e < 8; ++e) {
        base[(2 * e) * (LROW / 2)] = (ua[e] & 0xffffu) | (ub[e] << 16);
        base[(2 * e + 1) * (LROW / 2)] = (ua[e] >> 16) | (ub[e] & 0xffff0000u);
    }
}
struct GateW { float gu[16]; float gb; };
__device__ __forceinline__ GateW load_gate_w(const Params& P, int d, int h, int dk) {
    GateW g;
#pragma unroll
    for (int j = 0; j < 16; ++j) g.gu[j] = P.in[23][(d * 16 + j) * 256 + h * 64 + dk];
    g.gb = P.in[24][d * 256 + h * 64 + dk];
    return g;
}
__device__ __forceinline__ float gate_prefix(const GateW& gw, const float* sGLRd  , int stride, int d, int part, float (&pre)[16]) {
    const float (&gu)[16] = gw.gu; const float gb = gw.gb;
#pragma unroll
    for (int ii = 0; ii < 16; ++ii) {
        const float* gl = sGLRd + (part * 16 + ii) * stride;
        float z = gb;
#pragma unroll
        for (int j4 = 0; j4 < 4; ++j4) { const f32x4 x = *(const f32x4*)(gl + j4 * 4); z += x[0] * gu[j4 * 4] + x[1] * gu[j4 * 4 + 1] + x[2] * gu[j4 * 4 + 2] + x[3] * gu[j4 * 4 + 3]; }
        pre[ii] = logsig(z) * (1.f / 16.f);
    }
    if (d == 0) {
#pragma unroll
        for (int ii = 1; ii < 16; ++ii) pre[ii] += pre[ii - 1];
        return pre[15];
    } else {
#pragma unroll
        for (int ii = 14; ii >= 0; --ii) pre[ii] += pre[ii + 1];
        return pre[0];
    }
}

__device__ __forceinline__ void gla_a_item(const Params& P, int item, unsigned char* smem) {
    float* sGLR = (float*)smem;
    float* sPart = (float*)(smem + 4096);
    bf16_t* sKDt = (bf16_t*)(smem + 5120);
    bf16_t* sVt = (bf16_t*)(smem + 5120 + 9216);
    const int n = item % 132, d = (item / 132) & 1, h = (item / 264) & 3, b = item / 1056;
    const int rowbase = n < 4 ? NL + b * 256 + n * 64 : b * 8192 + (n - 4) * 64;
    const bf16_t* Kb = (const bf16_t*)(P.ws + OFF_K); const bf16_t* V = (const bf16_t*)(P.ws + OFF_V); const bf16_t* GLR = (const bf16_t*)(P.ws + OFF_GLR);
    const int tid = threadIdx.x & 255, lane = tid & 63, w = tid >> 6, dk = tid & 63, part = tid >> 6;
    const VRegs vr = load_v_regs(V + (size_t)rowbase * 512 + h * 128, tid);
    const f32x4 gl4 = load_bf4(GLR + (size_t)(rowbase + (tid >> 2)) * 32 + d * 16 + (tid & 3) * 4);
    float kk[16];
#pragma unroll
    for (int ii = 0; ii < 16; ++ii) kk[ii] = bf2f(Kb[(size_t)(rowbase + part * 16 + ii) * 256 + h * 64 + dk]);
    const GateW gw = load_gate_w(P, d, h, dk);
    *(f32x4*)(sGLR + (tid >> 2) * 16 + (tid & 3) * 4) = gl4;
    store_vt(vr, sVt, tid);
    __syncthreads();
    float pre[16];
    const float tot = gate_prefix(gw, sGLR, 16, d, part, pre);
    sPart[part * 64 + dk] = tot;
    __syncthreads();
    const float t0 = sPart[dk], t1 = sPart[64 + dk], t2 = sPart[128 + dk], t3 = sPart[192 + dk];
    const float gtot = (t0 + t1) + (t2 + t3);
    float off;
    if (d == 0) off = part == 0 ? 0.f : (part == 1 ? t0 : (part == 2 ? t0 + t1 : t0 + t1 + t2));
    else off = part == 3 ? 0.f : (part == 2 ? t3 : (part == 1 ? t3 + t2 : t3 + t2 + t1));
    unsigned pk[8];
#pragma unroll
    for (int e = 0; e < 8; ++e) pk[e] = pk2(kk[2 * e] * __expf(gtot - (off + pre[2 * e])), kk[2 * e + 1] * __expf(gtot - (off + pre[2 * e + 1])));
    *(uint4*)(sKDt + dk * LROW + part * 16) = make_uint4(pk[0], pk[1], pk[2], pk[3]);
    *(uint4*)(sKDt + dk * LROW + part * 16 + 8) = make_uint4(pk[4], pk[5], pk[6], pk[7]);
    if (part == 0) ((float*)(P.ws + OFF_DEC))[(size_t)item * 64 + dk] = __expf(gtot);
    __syncthreads();
    bf16_t* KVt = (bf16_t*)(P.ws + OFF_H) + (size_t)item * 8192;
    const int fr = lane & 15, fq = lane >> 4;
#pragma unroll
    for (int dvt = 0; dvt < 2; ++dvt) {
        f32x4 acc[4];
#pragma unroll
        for (int dkt = 0; dkt < 4; ++dkt) acc[dkt] = (f32x4){0.f, 0.f, 0.f, 0.f};
#pragma unroll
        for (int ks = 0; ks < 2; ++ks) {
            const bf16x8 vb = *(const bf16x8*)(sVt + (w * 32 + dvt * 16 + fr) * LROW + ks * 32 + fq * 8);
#pragma unroll
            for (int dkt = 0; dkt < 4; ++dkt) {
                const bf16x8 ka = *(const bf16x8*)(sKDt + (dkt * 16 + fr) * LROW + ks * 32 + fq * 8);
                acc[dkt] = __builtin_amdgcn_mfma_f32_16x16x32_bf16(ka, vb, acc[dkt], 0, 0, 0);
            }
        }
#pragma unroll
        for (int dkt = 0; dkt < 4; ++dkt) store_bf4(KVt + (size_t)(w * 32 + dvt * 16 + fr) * 64 + dkt * 16 + fq * 4, acc[dkt]);
    }
    __syncthreads();
}

__device__ __forceinline__ void gla_scan_item(const Params& P, int item) {
    const int gid = item * NTHR + threadIdx.x, seq = gid >> 11, e = gid & 2047, dv = e >> 4, dk4 = (e & 15) * 4, d = seq & 1;
    bf16_t* base = (bf16_t*)(P.ws + OFF_H) + (size_t)seq * 132 * 8192 + dv * 64 + dk4;
    const float* decb = (const float*)(P.ws + OFF_DEC) + (size_t)seq * 132 * 64 + dk4;
    f32x4 S = (f32x4){0.f, 0.f, 0.f, 0.f};
    for (int s0 = 0; s0 < 132; s0 += 12) {
        uint2 kvr[12]; f32x4 dec[12];
#pragma unroll
        for (int q = 0; q < 12; ++q) {
            const int step = s0 + q, n = d == 0 ? step : (step < 4 ? 3 - step : 135 - step);
            kvr[q] = *(const uint2*)(base + (size_t)n * 8192); dec[q] = *(const f32x4*)(decb + n * 64);
        }
#pragma unroll
        for (int q = 0; q < 12; ++q) {
            const int step = s0 + q, n = d == 0 ? step : (step < 4 ? 3 - step : 135 - step);
            if (n >= 4) store_bf4(base + (size_t)n * 8192, S);
            f32x4 kv; kv[0] = bflo(kvr[q].x); kv[1] = bfhi(kvr[q].x); kv[2] = bflo(kvr[q].y); kv[3] = bfhi(kvr[q].y);
            S = dec[q] * S + kv;
        }
    }
}

__device__ __forceinline__ void gla_c_item(const Params& P, int item, unsigned char* smem) {
    float* sGLR = (float*)smem;
    float* sPart = (float*)(smem + 8192);
    bf16_t* sQD = (bf16_t*)(smem + 10240);
    bf16_t* sKD = (bf16_t*)(smem + 10240 + 9216);
    bf16_t* sQG = (bf16_t*)(smem + 10240 + 2 * 9216);
    bf16_t* sP = (bf16_t*)(smem + 10240 + 2 * 9216 + 17408);
    bf16_t* sVt = (bf16_t*)(smem + 10240 + 3 * 9216 + 17408);
    const int m = item & 127, h = (item >> 7) & 3, b = item >> 9;
    const int rowbase = b * 8192 + m * 64;
    const bf16_t* Q = (const bf16_t*)(P.ws + OFF_Q); const bf16_t* Kb = (const bf16_t*)(P.ws + OFF_K);
    bf16_t* V = (bf16_t*)(P.ws + OFF_V); const bf16_t* R = (const bf16_t*)(P.ws + OFF_R); const bf16_t* GLR = (const bf16_t*)(P.ws + OFF_GLR);
    const int tid = threadIdx.x & 255, lane = tid & 63, w = tid >> 6, fr = lane & 15, fq = lane >> 4, dk = tid & 63, part = tid >> 6;
    const VRegs vr = load_v_regs(V + (size_t)rowbase * 512 + h * 128, tid);
    const uint4 gl8 = *(const uint4*)(GLR + (size_t)(rowbase + (tid >> 2)) * 32 + (tid & 3) * 8);
    float qq[16], kk[16];
#pragma unroll
    for (int ii = 0; ii < 16; ++ii) { qq[ii] = bf2f(Q[(size_t)(rowbase + part * 16 + ii) * 256 + h * 64 + dk]); kk[ii] = bf2f(Kb[(size_t)(rowbase + part * 16 + ii) * 256 + h * 64 + dk]); }
    const GateW gw0 = load_gate_w(P, 0, h, dk), gw1 = load_gate_w(P, 1, h, dk);
    {
        float* gp = sGLR + (tid >> 2) * 32 + (tid & 3) * 8;
        *(f32x4*)gp = (f32x4){bflo(gl8.x), bfhi(gl8.x), bflo(gl8.y), bfhi(gl8.y)};
        *(f32x4*)(gp + 4) = (f32x4){bflo(gl8.z), bfhi(gl8.z), bflo(gl8.w), bfhi(gl8.w)};
    }
    store_vt(vr, sVt, tid);
    __syncthreads();
    float gc0[16], gc1[16];
    { const float tot0 = gate_prefix(gw0, sGLR, 32, 0, part, gc0); const float tot1 = gate_prefix(gw1, sGLR + 16, 32, 1, part, gc1);
      sPart[part * 64 + dk] = tot0; sPart[256 + part * 64 + dk] = tot1; }
    __syncthreads();
    float gref0, gref1;
    {
        const float a0 = sPart[dk], a1 = sPart[64 + dk], a2 = sPart[128 + dk];
        const float c1 = sPart[256 + 64 + dk], c2 = sPart[256 + 128 + dk], c3 = sPart[256 + 192 + dk];
        const float off0 = part == 0 ? 0.f : (part == 1 ? a0 : (part == 2 ? a0 + a1 : a0 + a1 + a2));
        const float off1 = part == 3 ? 0.f : (part == 2 ? c3 : (part == 1 ? c3 + c2 : c3 + c2 + c1));
        gref0 = a0 + a1; gref1 = c3 + c2;
#pragma unroll
        for (int ii = 0; ii < 16; ++ii) { gc0[ii] += off0; gc1[ii] += off1; }
    }
    f32x4 pacc[4];
#pragma unroll
    for (int jt = 0; jt < 4; ++jt) pacc[jt] = (f32x4){0.f, 0.f, 0.f, 0.f};
#pragma unroll
    for (int d = 0; d < 2; ++d) {
        const float gref = d == 0 ? gref0 : gref1;
#pragma unroll
        for (int ii = 0; ii < 16; ++ii) {
            const int i = part * 16 + ii;
            const float gc = d == 0 ? gc0[ii] : gc1[ii];
            sQD[i * LROW + dk] = f2bf(qq[ii] * __expf(gc - gref));
            sKD[i * LROW + dk] = f2bf(kk[ii] * __expf(gref - gc));
            sQG[i * 136 + d * 64 + dk] = f2bf(qq[ii] * __expf(gc));
        }
        __syncthreads();
#pragma unroll
        for (int jt = 0; jt < 4; ++jt) {
            f32x4 sc = (f32x4){0.f, 0.f, 0.f, 0.f};
#pragma unroll
            for (int ks = 0; ks < 2; ++ks) {
                const bf16x8 a = *(const bf16x8*)(sQD + (16 * w + fr) * LROW + ks * 32 + fq * 8);
                const bf16x8 bb = *(const bf16x8*)(sKD + (jt * 16 + fr) * LROW + ks * 32 + fq * 8);
                sc = __builtin_amdgcn_mfma_f32_16x16x32_bf16(a, bb, sc, 0, 0, 0);
            }
#pragma unroll
            for (int r = 0; r < 4; ++r) {
                const int i = 16 * w + fq * 4 + r, j = jt * 16 + fr;
                const bool keep = d == 0 ? (j <= i) : (j >= i);
                pacc[jt][r] += keep ? sc[r] : 0.f;
            }
        }
        if (d == 0) __syncthreads();
    }
#pragma unroll
    for (int jt = 0; jt < 4; ++jt)
#pragma unroll
        for (int r = 0; r < 4; ++r) sP[(16 * w + fq * 4 + r) * LROW + jt * 16 + fr] = f2bf(pacc[jt][r]);
    const bf16_t* SS0 = (const bf16_t*)(P.ws + OFF_H) + ((size_t)(((b * 4 + h) * 2 + 0) * 132 + 4 + m)) * 8192;
    const bf16_t* SS1 = (const bf16_t*)(P.ws + OFF_H) + ((size_t)(((b * 4 + h) * 2 + 1) * 132 + 4 + m)) * 8192;
    const int i_out = 16 * w + fr;
    const int tok_out = b * 8192 + ((m & 1) * 64 + i_out) * 64 + (m >> 1);
    bf16_t* YB = (bf16_t*)(P.ws + OFF_YB);
    uint2 rgr[8];
#pragma unroll
    for (int dvt = 0; dvt < 8; ++dvt) rgr[dvt] = *(const uint2*)(R + (size_t)(rowbase + i_out) * 512 + h * 128 + dvt * 16 + fq * 4);
    __syncthreads();
    f32x4 oacc[8];
#pragma unroll
    for (int dvt = 0; dvt < 8; ++dvt) oacc[dvt] = (f32x4){0.f, 0.f, 0.f, 0.f};
#pragma unroll
    for (int ks = 0; ks < 4; ++ks) {
        const bf16x8 qb = *(const bf16x8*)(sQG + (16 * w + fr) * 136 + ks * 32 + fq * 8);
        const bf16_t* SS = (ks >> 1) ? SS1 : SS0;
#pragma unroll
        for (int dvt = 0; dvt < 8; ++dvt) {
            const bf16x8 sa = *(const bf16x8*)(SS + (size_t)(dvt * 16 + fr) * 64 + (ks & 1) * 32 + fq * 8);
            oacc[dvt] = __builtin_amdgcn_mfma_f32_16x16x32_bf16(sa, qb, oacc[dvt], 0, 0, 0);
        }
    }
#pragma unroll
    for (int ks = 0; ks < 2; ++ks) {
        const bf16x8 pb = *(const bf16x8*)(sP + (16 * w + fr) * LROW + ks * 32 + fq * 8);
#pragma unroll
        for (int dvt = 0; dvt < 8; ++dvt) {
            const bf16x8 va = *(const bf16x8*)(sVt + (dvt * 16 + fr) * LROW + ks * 32 + fq * 8);
            oacc[dvt] = __builtin_amdgcn_mfma_f32_16x16x32_bf16(va, pb, oacc[dvt], 0, 0, 0);
        }
    }
    float ss = 0.f;
#pragma unroll
    for (int dvt = 0; dvt < 8; ++dvt)
#pragma unroll
        for (int r = 0; r < 4; ++r) ss += oacc[dvt][r] * oacc[dvt][r];
    ss += __shfl_xor(ss, 16); ss += __shfl_xor(ss, 32);
    const float rinv = rsqrtf(ss * (1.f / 128.f) + 1e-6f);
#pragma unroll
    for (int dvt = 0; dvt < 8; ++dvt) {
        const int dv = dvt * 16 + fq * 4;
        const float rg[4] = {bflo(rgr[dvt].x), bfhi(rgr[dvt].x), bflo(rgr[dvt].y), bfhi(rgr[dvt].y)};
        const f32x4 ng = *(const f32x4*)(P.in[25] + h * 128 + dv);
        f32x4 o;
#pragma unroll
        for (int r = 0; r < 4; ++r) o[r] = oacc[dvt][r] * rinv * ng[r] * siluf_(rg[r]);
        store_bf4(YB + (size_t)tok_out * 512 + h * 128 + dv, o);
    }
    __syncthreads();
}

struct EpiE : pg8::EpiNoMid {
    float* E;
    __device__ __forceinline__ void operator()(const AccT& acc, const Unit& u, int wr, int wc, int fr, int fq) const {
        EPI_LOOP
            if (m < 1056) *(f32x4*)(E + ((size_t)u.g * 1056 + m) * 256 + n) = v;
        EPI_LOOP_END
    }
};
__device__ __forceinline__ void phase6(const Params& P, unsigned char* smem) {
    const int hb = threadIdx.x >> 8;
    for (int base = blockIdx.x * 2; base < 4224; base += gridDim.x * 2) gla_a_item(P, base + hb, smem + hb * HALF_LDS);
    GemmD g{}; g.A = (const bf16_t*)(P.ws + OFF_U); g.Bt = (const bf16_t*)(P.ws + OFF_WE); g.lda = 768; g.ldb = 512; g.K = 512; g.nM = 5; g.nN = 1; g.nG = 32;
    g.gsA = (size_t)UROWS * 768; g.gsB = (size_t)256 * 512;
    EpiE E; E.E = (float*)(P.ws + OFF_E);
    pg8::gemm_phase((PG8_LAS unsigned char*)smem, g, E);
}
__device__ __forceinline__ void s5_carry_item(const Params& P, int item) {
    const int id = item * NTHR + threadIdx.x, p = id & 63, d = (id >> 6) & 1, b = (id >> 7) & 3, g = id >> 9;
    const float2 lamT = ((const float2*)(P.ws + OFF_LP))[((d * 32 + g) * 33 + 32) * 64 + p];
    const float* Eg = (const float*)(P.ws + OFF_E) + (size_t)g * 1056 * 256;
    bf16_t* Ug = (bf16_t*)(P.ws + OFF_U) + (size_t)g * UROWS * 768;
    const int cre = d * 128 + p, cim = d * 128 + 64 + p;
    float2 hh = make_float2(0.f, 0.f);
    {
        float2 e[8];
#pragma unroll
        for (int s = 0; s < 8; ++s) { const int n = d == 0 ? s : 7 - s, row = 1024 + b * 8 + n; e[s] = make_float2(Eg[(size_t)row * 256 + cre], Eg[(size_t)row * 256 + cim]); }
#pragma unroll
        for (int s = 0; s < 8; ++s) { const float2 t = cmul(lamT, hh); hh = make_float2(t.x + e[s].x, t.y + e[s].y); }
    }
    for (int s0 = 0; s0 < 256; s0 += 16) {
        float2 e[16];
#pragma unroll
        for (int q = 0; q < 16; ++q) { const int s = s0 + q, n = d == 0 ? s : 255 - s, row = b * 256 + n; e[q] = make_float2(Eg[(size_t)row * 256 + cre], Eg[(size_t)row * 256 + cim]); }
#pragma unroll
        for (int q = 0; q < 16; ++q) {
            const int s = s0 + q, n = d == 0 ? s : 255 - s, row = b * 256 + n;
            Ug[(size_t)row * 768 + 512 + cre] = f2bf(hh.x); Ug[(size_t)row * 768 + 512 + cim] = f2bf(hh.y);
            const float2 t = cmul(lamT, hh); hh = make_float2(t.x + e[q].x, t.y + e[q].y);
        }
    }
}
__device__ __forceinline__ void phase7(const Params& P) {
    for (int it = blockIdx.x; it < 32 + 128; it += gridDim.x) {
        if (it < 32) s5_carry_item(P, it); else gla_scan_item(P, it - 32);
    }
}
struct EpiY : pg8::EpiNoMid {
    static constexpr bool PERM = true;
    const bf16_t* U; const float* dskip; bf16_t* YG;
    __device__ __forceinline__ void operator()(const AccT& acc, const Unit& u, int wr, int wc, int fr, int fq) const {
        const int nb = 256 * u.pn + 32 * wc + 8 * fq, c0 = 8 * (fq & 1);
        const f32x4 ds0 = *(const f32x4*)(dskip + u.g * 16 + c0), ds1 = *(const f32x4*)(dskip + u.g * 16 + c0 + 4);
#pragma unroll
        for (int ai = 0; ai < 2; ++ai) {
            const int mb = 256 * u.pm + 128 * ai + 64 * wr + fr;
            uint4 ur[4][2];
#pragma unroll
            for (int mm = 0; mm < 4; ++mm)
#pragma unroll
                for (int bj = 0; bj < 2; ++bj) ur[mm][bj] = *(const uint4*)(U + ((size_t)u.g * UROWS + mb + 16 * mm) * 768 + nb + 128 * bj);
#pragma unroll
            for (int mm = 0; mm < 4; ++mm)
#pragma unroll
                for (int bj = 0; bj < 2; ++bj) {
                    const int m = mb + 16 * mm, n = nb + 128 * bj;
                    const int b = m >> 8, nch = m & 255, t = n >> 4;
                    const uint4 uu = ur[mm][bj];
                    const f32x4 v0 = acc[ai][bj][mm][0], v1 = acc[ai][bj][mm][1];
                    const f32x4 o0 = {gelu_tanh(v0[0] + ds0[0] * bflo(uu.x)), gelu_tanh(v0[1] + ds0[1] * bfhi(uu.x)), gelu_tanh(v0[2] + ds0[2] * bflo(uu.y)), gelu_tanh(v0[3] + ds0[3] * bfhi(uu.y))};
                    const f32x4 o1 = {gelu_tanh(v1[0] + ds1[0] * bflo(uu.z)), gelu_tanh(v1[1] + ds1[1] * bfhi(uu.z)), gelu_tanh(v1[2] + ds1[2] * bflo(uu.w)), gelu_tanh(v1[3] + ds1[3] * bfhi(uu.w))};
                    *(uint4*)(YG + ((size_t)(b * 8192 + nch * 32 + t)) * 512 + u.g * 16 + c0) = pack8(o0, o1);
                }
        }
    }
};
__device__ __forceinline__ void phase8(const Params& P, unsigned char* smem) {
    const int hb = threadIdx.x >> 8;
    for (int base = blockIdx.x * 2; base < 2048; base += gridDim.x * 2) gla_c_item(P, base + hb, smem + hb * HALF_LDS);
    GemmD g{}; g.A = (const bf16_t*)(P.ws + OFF_U); g.Bt = (const bf16_t*)(P.ws + OFF_WY); g.lda = 768; g.ldb = 768; g.K = 768; g.nM = 4; g.nN = 2; g.nG = 32;
    g.gsA = (size_t)UROWS * 768; g.gsB = (size_t)512 * 768;
    EpiY E; E.U = (const bf16_t*)(P.ws + OFF_U); E.dskip = P.in[19]; E.YG = (bf16_t*)(P.ws + OFF_E);
    pg8::gemm_phase((PG8_LAS unsigned char*)smem, g, E);
}

struct EpiGlu : pg8::EpiNoMid {
    static constexpr bool PERM = true;
    const bf16_t* YG; const float* bias; bf16_t* YA;
    __device__ __forceinline__ void operator()(const AccT& acc, const Unit& u, int wr, int wc, int fr, int fq) const {
        const int nb = 256 * u.pn + 32 * wc + 8 * fq;
        f32x4 bb[2][2];
#pragma unroll
        for (int bj = 0; bj < 2; ++bj)
#pragma unroll
            for (int nn = 0; nn < 2; ++nn) bb[bj][nn] = *(const f32x4*)(bias + nb + 128 * bj + 4 * nn);
#pragma unroll
        for (int ai = 0; ai < 2; ++ai) {
            const size_t rb = (size_t)(256 * u.pm + 128 * ai + 64 * wr + fr) * 512 + nb;
            uint4 yr[4][2];
#pragma unroll
            for (int mm = 0; mm < 4; ++mm)
#pragma unroll
                for (int bj = 0; bj < 2; ++bj) yr[mm][bj] = *(const uint4*)(YG + rb + (size_t)mm * 16 * 512 + 128 * bj);
#pragma unroll
            for (int mm = 0; mm < 4; ++mm)
#pragma unroll
                for (int bj = 0; bj < 2; ++bj) {
                    const uint4 y = yr[mm][bj]; const f32x4 v0 = acc[ai][bj][mm][0] + bb[bj][0], v1 = acc[ai][bj][mm][1] + bb[bj][1];
                    const f32x4 o0 = {bflo(y.x) * sigm(v0[0]), bfhi(y.x) * sigm(v0[1]), bflo(y.y) * sigm(v0[2]), bfhi(y.y) * sigm(v0[3])};
                    const f32x4 o1 = {bflo(y.z) * sigm(v1[0]), bfhi(y.z) * sigm(v1[1]), bflo(y.w) * sigm(v1[2]), bfhi(y.w) * sigm(v1[3])};
                    *(uint4*)(YA + rb + (size_t)mm * 16 * 512 + 128 * bj) = pack8(o0, o1);
                }
        }
    }
};
__device__ __forceinline__ void phase9(const Params& P, PG8_LAS unsigned char* lds) {
    GemmD g{}; g.A = (const bf16_t*)(P.ws + OFF_E); g.Bt = (const bf16_t*)(P.ws + OFF_WGLU); g.lda = 512; g.ldb = 512; g.K = 512; g.nM = NL >> 8; g.nN = 2; g.nG = 1;
    EpiGlu E; E.YG = (const bf16_t*)(P.ws + OFF_E); E.bias = P.in[21]; E.YA = (bf16_t*)(P.ws + OFF_U);
    pg8::gemm_phase(lds, g, E);
}
struct EpiMerge {
    static constexpr bool PERM = true;
    const bf16_t* GA; const bf16_t* GB; bf16_t* H;
    __device__ __forceinline__ void mid(f32x4 (&acc)[2][2][4][2], const Unit& u, int wr, int wc, int fr, int fq) const {
        const int nb = 256 * u.pn + 32 * wc + 8 * fq;
#pragma unroll
        for (int ai = 0; ai < 2; ++ai) {
            const size_t rb = (size_t)(256 * u.pm + 128 * ai + 64 * wr + fr) * 1024 + nb;
            uint4 br[4][2];
#pragma unroll
            for (int mm = 0; mm < 4; ++mm)
#pragma unroll
                for (int bj = 0; bj < 2; ++bj) br[mm][bj] = *(const uint4*)(GB + rb + (size_t)mm * 16 * 1024 + 128 * bj);
#pragma unroll
            for (int mm = 0; mm < 4; ++mm)
#pragma unroll
                for (int bj = 0; bj < 2; ++bj) {
                    const uint4 b4 = br[mm][bj];
                    f32x4& v0 = acc[ai][bj][mm][0]; f32x4& v1 = acc[ai][bj][mm][1];
                    v0[0] *= bflo(b4.x); v0[1] *= bfhi(b4.x); v0[2] *= bflo(b4.y); v0[3] *= bfhi(b4.y);
                    v1[0] *= bflo(b4.z); v1[1] *= bfhi(b4.z); v1[2] *= bflo(b4.w); v1[3] *= bfhi(b4.w);
                }
        }
    }
    __device__ __forceinline__ void operator()(const AccT& acc, const Unit& u, int wr, int wc, int fr, int fq) const {
        const int nb = 256 * u.pn + 32 * wc + 8 * fq;
#pragma unroll
        for (int ai = 0; ai < 2; ++ai) {
            const size_t rb = (size_t)(256 * u.pm + 128 * ai + 64 * wr + fr) * 1024 + nb;
            uint4 gr[4][2];
#pragma unroll
            for (int mm = 0; mm < 4; ++mm)
#pragma unroll
                for (int bj = 0; bj < 2; ++bj) gr[mm][bj] = *(const uint4*)(GA + rb + (size_t)mm * 16 * 1024 + 128 * bj);
#pragma unroll
            for (int mm = 0; mm < 4; ++mm)
#pragma unroll
                for (int bj = 0; bj < 2; ++bj) {
                    const uint4 g4 = gr[mm][bj]; const f32x4 v0 = acc[ai][bj][mm][0], v1 = acc[ai][bj][mm][1];
                    uint4 o;
                    o.x = pk2(bflo(g4.x) * v0[0], bfhi(g4.x) * v0[1]); o.y = pk2(bflo(g4.y) * v0[2], bfhi(g4.y) * v0[3]);
                    o.z = pk2(bflo(g4.z) * v1[0], bfhi(g4.z) * v1[1]); o.w = pk2(bflo(g4.w) * v1[2], bfhi(g4.w) * v1[3]);
                    *(uint4*)(H + rb + (size_t)mm * 16 * 1024 + 128 * bj) = o;
                }
        }
    }
};
__device__ __forceinline__ void phase10(const Params& P, PG8_LAS unsigned char* lds) {
    GemmD g{}; g.A = (const bf16_t*)(P.ws + OFF_YB); g.Bt = (const bf16_t*)(P.ws + OFF_WGLO); g.A2 = (const bf16_t*)(P.ws + OFF_U); g.Bt2 = (const bf16_t*)(P.ws + OFF_WS5O); g.dual = 1;
    g.lda = 512; g.ldb = 512; g.K = 512; g.nM = NL >> 8; g.nN = 4; g.nG = 1;
    EpiMerge E; E.GA = (const bf16_t*)P.out; E.GB = E.GA + (size_t)NL * 1024; E.H = (bf16_t*)(P.ws + OFF_H);
    pg8::gemm_phase(lds, g, E);
}
__device__ __forceinline__ void phase11(const Params& P, PG8_LAS unsigned char* lds) {
    GemmD g{}; g.A = (const bf16_t*)(P.ws + OFF_H); g.Bt = (const bf16_t*)(P.ws + OFF_WWO); g.lda = 1024; g.ldb = 1024; g.K = 1024; g.nM = NL >> 8; g.nN = 4; g.nG = 1;
    EpiRes<1> E; E.x = nullptr; E.XRb = (bf16_t*)(P.ws + OFF_XR); E.out = nullptr; E.Hn = (bf16_t*)P.out; E.mod = (const float*)(P.ws + OFF_MOD);
    E.gnext = P.in[28]; E.ss = (float*)(P.ws + OFF_SS) + NT;
    pg8::gemm_phase(lds, g, E);
}

__device__ __forceinline__ void phase_ffn_up13(const Params& P, PG8_LAS unsigned char* lds) {
    GemmD g{}; g.A = (const bf16_t*)P.out; g.Bt = (const bf16_t*)(P.ws + OFF_WGU2); g.lda = 1024; g.ldb = 1024; g.K = 1024; g.nM = NL >> 8; g.nN = 22; g.nG = 1;
    EpiFfnUp<1> E; E.HID = (bf16_t*)(P.ws + OFF_HID); E.ss = (const float*)(P.ws + OFF_SS) + NT; E.BW = (const float*)(P.ws + OFF_BW) + 5 * 4352;
    pg8::gemm_phase(lds, g, E);
}

#define XB_TMO      128
#define XB_XCNT(j)  (256  + 64 * (j))
#define XB_XSUB(j)  (1280 + 64 * (j))
#define XB_XGEN(j)  (2304 + 64 * (j))
#define XB_TOP      3328
#define XB_TOPGEN   3392
#define XCD_BAR_WORDS 3456
#define XB_SPIN_CAP (1u << 18)
#define LAS3 __attribute__((address_space(3)))
__device__ __forceinline__ unsigned xb_ld(unsigned* p)              { return __hip_atomic_load(p, __ATOMIC_RELAXED, __HIP_MEMORY_SCOPE_AGENT); }
__device__ __forceinline__ unsigned xb_add(unsigned* p, unsigned v) { return __hip_atomic_fetch_add(p, v, __ATOMIC_RELAXED, __HIP_MEMORY_SCOPE_AGENT); }
__device__ __forceinline__ unsigned xb_xcc_id() { return (unsigned)__builtin_amdgcn_s_getreg((3 << 11) | 20) & 0xFu; }
#define XB_SPIN(cond, bar) do { unsigned _sp = 0; while (cond) { __builtin_amdgcn_s_sleep(1); \
    if ((++_sp & 255u) == 0u) { if (xb_ld(&(bar)[XB_TMO])) break; if (_sp > XB_SPIN_CAP) { atomicAdd(&(bar)[XB_TMO], 1u); break; } } } } while (0)
struct XcdBarrier { unsigned* bar; unsigned x; volatile LAS3 unsigned* st; };
__device__ __forceinline__ XcdBarrier xcd_barrier_post(unsigned* bar, volatile LAS3 unsigned* st) {
    XcdBarrier b; b.bar = bar; b.x = xb_xcc_id(); b.st = st;
    if (threadIdx.x == 0) (void)xb_add(&bar[XB_XCNT(b.x)], 1u);
    return b;
}
__device__ __forceinline__ void xcd_barrier_complete(unsigned* bar, unsigned x, unsigned& nloc, unsigned& nx) {
    const unsigned G = gridDim.x * gridDim.y * gridDim.z;
    unsigned sum, cnt, mine, sp = 0u;
    for (;;) {
        sum = 0u; cnt = 0u; mine = 0u;
#pragma unroll
        for (unsigned j = 0; j < 16; ++j) { const unsigned c = xb_ld(&bar[XB_XCNT(j)]); sum += c; cnt += (c > 0u) ? 1u : 0u; mine = (j == x) ? c : mine; }
        if (sum == G) break;
        __builtin_amdgcn_s_sleep(1);
        if ((++sp & 255u) == 0u) { if (xb_ld(&bar[XB_TMO])) break; if (sp > XB_SPIN_CAP) { atomicAdd(&bar[XB_TMO], 1u); break; } }
    }
    nloc = mine > 0u ? mine : 1u; nx = cnt > 0u ? cnt : 1u;
}
__device__ __forceinline__ void xcd_barrier(const XcdBarrier& b) {
    asm volatile("s_waitcnt vmcnt(0)" ::: "memory");
    __syncthreads();
    if (threadIdx.x == 0) {
        unsigned* bar = b.bar;
        __builtin_amdgcn_s_waitcnt(0);
        unsigned nloc = b.st[0], nx = b.st[1];
        if (nloc == 0u) { xcd_barrier_complete(bar, b.x, nloc, nx); b.st[0] = nloc; b.st[1] = nx; }
        const unsigned old = xb_add(&bar[XB_XSUB(b.x)], 1u);
        const unsigned gen = old / nloc;
        if (old + 1u == (gen + 1u) * nloc) {
            __builtin_amdgcn_fence(__ATOMIC_RELEASE, "agent");
            asm volatile("s_waitcnt vmcnt(0)" ::: "memory");
            const unsigned og = xb_add(&bar[XB_TOP], 1u);
            const unsigned tg = og / nx;
            if (og + 1u == (tg + 1u) * nx) xb_add(&bar[XB_TOPGEN], 1u);
            else XB_SPIN(xb_ld(&bar[XB_TOPGEN]) == tg, bar);
            __builtin_amdgcn_fence(__ATOMIC_ACQUIRE, "agent");
            xb_add(&bar[XB_XGEN(b.x)], 1u);
            asm volatile("s_waitcnt vmcnt(0)" ::: "memory");
        } else {
            XB_SPIN(xb_ld(&bar[XB_XGEN(b.x)]) == gen, bar);
            __builtin_amdgcn_fence(__ATOMIC_ACQUIRE, "agent");
            asm volatile("s_waitcnt vmcnt(0)" ::: "memory");
        }
    }
    __syncthreads();
}

__global__ void __launch_bounds__(512, 2) mega(Params P) {
    extern __shared__ __attribute__((aligned(16))) unsigned char smem[];
    cg::grid_group grid = cg::this_grid();
    PG8_LAS unsigned char* lds = (PG8_LAS unsigned char*)smem;
    __shared__ uint4 xb_words;
    unsigned* bar = (unsigned*)(P.ws + OFF_BAR);
    if (threadIdx.x == 0) xb_words = make_uint4(0u, 0u, 0u, 0u);
    if (blockIdx.x == 0 && P.ph_lo == 0) { for (int i = threadIdx.x; i < XCD_BAR_WORDS; i += NTHR) bar[i] = 0u; }
    __syncthreads();
    XcdBarrier xb; xb.bar = bar; xb.x = 0; xb.st = (volatile LAS3 unsigned*)&xb_words;
#ifndef PHMASK
#define PHMASK 0xFFFF
#endif
#define PHOK(n) ((PHMASK >> n) & 1)
#define RUN(n, call) if (PHOK(n) && P.ph_lo <= n && n < P.ph_hi) { call; if (n + 1 < P.ph_hi) { if (n == 0) { grid.sync(); xb = xcd_barrier_post(bar, (volatile LAS3 unsigned*)&xb_words); } else xcd_barrier(xb); } }
    RUN(0, phase0(P, smem))
    RUN(1, phase1(P))
    RUN(2, phase_ffn_up<0>(P, lds, OFF_WGU1, NT))
    RUN(3, phase_ffn_down<1>(P, lds, OFF_WDN1))
    RUN(4, phase4(P))
    RUN(5, phase5(P, lds))
    RUN(6, phase6(P, smem))
    RUN(7, phase7(P))
    RUN(8, phase8(P, smem))
    RUN(9, phase9(P, lds))
    RUN(10, phase10(P, lds))
    RUN(11, phase11(P, lds))
    RUN(13, phase_ffn_up13(P, lds))
    RUN(14, phase_ffn_down<0>(P, lds, OFF_WDN2))
    RUN(15, phase15(P))
}

extern "C" void kernel_launch(void* const* d_in, const int* in_sizes, int n_in, void* d_out, int out_size, void* d_ws, size_t ws_size, hipStream_t stream) {
    static int grid_blocks = 0;
    if (grid_blocks == 0) {
        if (n_in != 33 || ws_size < WS_END) { fprintf(stderr, "kernel_launch: unexpected n_in %d / ws_size %zu (need %zu)\n", n_in, ws_size, (size_t)WS_END); grid_blocks = -1; return; }
        int dev = 0, cus = 0, per_cu = 0;
        hipGetDevice(&dev);
        hipDeviceGetAttribute(&cus, hipDeviceAttributeMultiprocessorCount, dev);
        hipFuncSetAttribute((const void*)mega, hipFuncAttributeMaxDynamicSharedMemorySize, LDS_BYTES);
        hipOccupancyMaxActiveBlocksPerMultiprocessor(&per_cu, (const void*)mega, NTHR, LDS_BYTES);
        if (per_cu < 1) per_cu = 1;
        if (per_cu > 1) per_cu = 1;
        grid_blocks = cus * per_cu;
        fprintf(stderr, "kernel_launch: cus %d per_cu %d grid %d\n", cus, per_cu, grid_blocks);
    }
    if (grid_blocks < 0) return;
    Params p{};
    for (int i = 0; i < 33; ++i) p.in[i] = (const float*)d_in[i];
    p.out = (float*)d_out; p.ws = (unsigned char*)d_ws;
#if N_LAUNCH_PER_PHASE
    for (int ph = 0; ph < NPHASE; ++ph) {
        p.ph_lo = ph; p.ph_hi = ph + 1;
        void* args[] = {&p};
        hipError_t e = hipLaunchCooperativeKernel((const void*)mega, dim3(grid_blocks), dim3(NTHR), args, LDS_BYTES, stream);
        if (e != hipSuccess) { fprintf(stderr, "cooperative launch failed: %s\n", hipGetErrorString(e)); break; }
    }
#else
    p.ph_lo = 0; p.ph_hi = NPHASE;
    void* args[] = {&p};
    hipError_t e = hipLaunchCooperativeKernel((const void*)mega, dim3(grid_blocks), dim3(NTHR), args, LDS_BYTES, stream);
    if (e != hipSuccess) fprintf(stderr, "cooperative launch failed: %s\n", hipGetErrorString(e));
#endif
}
```
